# Optimizing an MI355X kernel written in HIP

```python
import math
import jax, jax.numpy as jnp
from jax import lax
import numpy as np

D_MODEL = 2048
BATCH = 4
SEQ = 2048
DEPTH = 4

N_MIXERS = 4
HEAD_DIM = 64
N_HEADS = D_MODEL // HEAD_DIM
N_KV_HEADS = N_HEADS // 4
GQA_GROUP = N_HEADS // N_KV_HEADS
WINDOW = 128
Q_BLOCK = 128
DIFF_HEADS = D_MODEL // (2 * HEAD_DIM)
DIFF_V_DIM = 2 * HEAD_DIM
HGRN_HEAD_DIM = 128
HGRN_HEADS = D_MODEL // HGRN_HEAD_DIM
HGRN_CHUNK = 64
IDX_HEADS = 16
IDX_DIM = 64
TOPK_MAX = 256
D_FF = 5632
CONV_WIDTH = 3
NUM_BUCKETS = 32
MAX_DISTANCE = 128
RMS_EPS = 1e-6
N_SWA = len(range(0, DEPTH, N_MIXERS))
N_DIFF = len(range(1, DEPTH, N_MIXERS))
N_HGRN = len(range(2, DEPTH, N_MIXERS))
N_DSA = len(range(3, DEPTH, N_MIXERS))
SWA_SPLITS = (N_HEADS * HEAD_DIM, N_KV_HEADS * HEAD_DIM, N_KV_HEADS * HEAD_DIM)
SWA_IN = sum(SWA_SPLITS)
DIFF_SPLITS = (DIFF_HEADS * 2 * HEAD_DIM, DIFF_HEADS * 2 * HEAD_DIM, DIFF_HEADS * DIFF_V_DIM)
DIFF_IN = sum(DIFF_SPLITS)
HGRN_IN = 4 * HGRN_HEADS * HGRN_HEAD_DIM
DSA_SPLITS = (N_HEADS * HEAD_DIM, N_KV_HEADS * HEAD_DIM, N_KV_HEADS * HEAD_DIM,
              IDX_HEADS * IDX_DIM, IDX_DIM, IDX_HEADS)
DSA_IN = sum(DSA_SPLITS)

kernel_name = 'hybrid_swa_diff_hgrn2_dsa_convffn'


def split_cols(z, sizes):
    return jnp.split(z, [int(c) for c in np.cumsum(sizes)[:-1]], axis=-1)


def rms_norm(x, g):
    xf = x.astype(jnp.float32)
    y = xf * lax.rsqrt(jnp.mean(xf * xf, axis=-1, keepdims=True) + RMS_EPS)
    return (y * g.astype(jnp.float32)).astype(x.dtype)


def rel_position_bias(dist, table):
    n = jnp.maximum(dist, 0)
    max_exact = NUM_BUCKETS // 2
    log_ratio = jnp.log(jnp.maximum(n, 1).astype(jnp.float32) / max_exact) / math.log(MAX_DISTANCE / max_exact)
    large = jnp.minimum(max_exact + (log_ratio * (NUM_BUCKETS - max_exact)).astype(jnp.int32), NUM_BUCKETS - 1)
    bucket = jnp.where(n < max_exact, n, large)
    return table.astype(jnp.float32)[bucket]


def swa_sink_attention(h, w_in, w_out, sinks, bias_table):
    B, S, _ = h.shape
    nb = S // Q_BLOCK
    q, k, v = split_cols(h @ w_in, SWA_SPLITS)
    q = q.reshape(B, nb, Q_BLOCK, N_KV_HEADS, GQA_GROUP, HEAD_DIM)
    pad = ((0, 0), (Q_BLOCK, 0), (0, 0))
    kp = jnp.pad(k, pad).reshape(B, nb + 1, Q_BLOCK, N_KV_HEADS, HEAD_DIM)
    vp = jnp.pad(v, pad).reshape(B, nb + 1, Q_BLOCK, N_KV_HEADS, HEAD_DIM)
    kb = jnp.concatenate([kp[:, :-1], kp[:, 1:]], axis=2)
    vb = jnp.concatenate([vp[:, :-1], vp[:, 1:]], axis=2)
    qi = jnp.arange(Q_BLOCK)
    kj = jnp.arange(2 * Q_BLOCK) - Q_BLOCK
    dist = qi[:, None] - kj[None, :]
    in_band = (dist >= 0) & (dist < WINDOW)
    key_exists = (jnp.arange(nb)[:, None] > 0) | (kj[None, :] >= 0)
    mask = in_band[None] & key_exists[:, None, :]
    bias = rel_position_bias(dist, bias_table).transpose(2, 0, 1).reshape(
        N_KV_HEADS, GQA_GROUP, Q_BLOCK, 2 * Q_BLOCK)
    s = jnp.einsum('bnqhgd,bnshd->bnhgqs', q, kb).astype(jnp.float32) * HEAD_DIM ** -0.5 + bias
    s = jnp.where(mask[None, :, None, None], s, -jnp.inf)
    sink = jnp.broadcast_to(sinks.astype(jnp.float32).reshape(N_KV_HEADS, GQA_GROUP, 1, 1),
                            s.shape[:-1] + (1,))
    p = jax.nn.softmax(jnp.concatenate([s, sink], axis=-1), axis=-1)[..., :-1]
    o = jnp.einsum('bnhgqs,bnshd->bnqhgd', p.astype(vb.dtype), vb)
    return o.reshape(B, S, N_HEADS * HEAD_DIM) @ w_out


def diff_attention(h, w_in, w_out, lambdas, subln_g, bias_table, layer_idx):
    B, S, _ = h.shape
    nb = S // Q_BLOCK
    q, k, v = split_cols(h @ w_in, DIFF_SPLITS)
    q = q.reshape(B, nb, Q_BLOCK, DIFF_HEADS, 2, HEAD_DIM).transpose(1, 0, 2, 3, 4, 5)
    k = k.reshape(B, S, DIFF_HEADS, 2, HEAD_DIM)
    v = v.reshape(B, S, DIFF_HEADS, DIFF_V_DIM)
    lam_init = 0.8 - 0.6 * math.exp(-0.3 * layer_idx)
    lf = lambdas.astype(jnp.float32)
    lam = jnp.exp(jnp.sum(lf[0] * lf[1])) - jnp.exp(jnp.sum(lf[2] * lf[3])) + lam_init
    kpos = jnp.arange(S)

    def block(args):
        qb, start = args
        dist = (start + jnp.arange(Q_BLOCK))[:, None] - kpos[None, :]
        bias = rel_position_bias(dist, bias_table).reshape(Q_BLOCK, S, DIFF_HEADS, 2).transpose(2, 3, 0, 1)
        s = jnp.einsum('bqhmd,bshmd->bhmqs', qb, k).astype(jnp.float32) * HEAD_DIM ** -0.5 + bias
        p = jax.nn.softmax(jnp.where(dist >= 0, s, -jnp.inf), axis=-1)
        a = p[:, :, 0] - lam * p[:, :, 1]
        return jnp.einsum('bhqs,bshe->bqhe', a.astype(v.dtype), v)

    o = lax.map(block, (q, jnp.arange(nb) * Q_BLOCK))
    o = o.transpose(1, 0, 2, 3, 4).reshape(B, S, DIFF_HEADS, DIFF_V_DIM)
    o = rms_norm(o, subln_g) * (1.0 - lam_init)
    return o.reshape(B, S, DIFF_HEADS * DIFF_V_DIM) @ w_out


def hgrn2_recurrence(h, w_in, w_out, lb, norm_g):
    B, S, _ = h.shape
    nc = S // HGRN_CHUNK
    f32 = jnp.float32
    q, fz, i, g = jnp.split(h @ w_in, 4, axis=-1)

    def chunks(t):
        return t.astype(f32).reshape(B, nc, HGRN_CHUNK, HGRN_HEADS, HGRN_HEAD_DIM).transpose(1, 0, 3, 2, 4)

    lbf = lb.astype(f32)
    log_f = jnp.logaddexp(jnp.log(lbf), jnp.log1p(-lbf) + jax.nn.log_sigmoid(fz.astype(f32)))
    key = -jnp.expm1(log_f)
    qs, ks, vs, gs = chunks(jax.nn.silu(q.astype(f32))), chunks(key), chunks(i), chunks(log_f)
    causal = jnp.tril(jnp.ones((HGRN_CHUNK, HGRN_CHUNK), dtype=bool))

    def step(state, inp):
        qc, kc, vc, gc = inp
        b = jnp.cumsum(gc, axis=2)
        o_inter = jnp.einsum('bhtk,bhkv->bhtv', qc * jnp.exp(b), state)
        rel = jnp.where(causal[:, :, None], b[:, :, :, None, :] - b[:, :, None, :, :], -jnp.inf)
        att = jnp.einsum('bhtsk,bhsk->bhts', qc[:, :, :, None, :] * jnp.exp(rel), kc)
        o_intra = jnp.einsum('bhts,bhsv->bhtv', att, vc)
        b_end = b[:, :, -1:, :]
        state = state * jnp.exp(b_end[:, :, 0, :, None]) + jnp.einsum(
            'bhsk,bhsv->bhkv', kc * jnp.exp(b_end - b), vc)
        return state, o_inter + o_intra

    state0 = jnp.zeros((B, HGRN_HEADS, HGRN_HEAD_DIM, HGRN_HEAD_DIM), f32)
    _, o = lax.scan(step, state0, (qs, ks, vs, gs))
    o = o.transpose(1, 0, 3, 2, 4).reshape(B, S, HGRN_HEADS, HGRN_HEAD_DIM)
    gate = jax.nn.silu(g.astype(f32)).reshape(B, S, HGRN_HEADS, HGRN_HEAD_DIM)
    o = (rms_norm(o, norm_g) * gate).astype(h.dtype)
    return o.reshape(B, S, HGRN_HEADS * HGRN_HEAD_DIM) @ w_out


def dsa_sparse_attention(h, w_in, w_out, bias_table):
    B, S, _ = h.shape
    nb = S // Q_BLOCK
    n_sel = min(TOPK_MAX, S // 4)
    f32 = jnp.float32
    q, k, v, qi, ki, wi = split_cols(h @ w_in, DSA_SPLITS)
    q = q.reshape(B, nb, Q_BLOCK, N_KV_HEADS, GQA_GROUP, HEAD_DIM).transpose(1, 0, 2, 3, 4, 5)
    qi = qi.reshape(B, nb, Q_BLOCK, IDX_HEADS, IDX_DIM).transpose(1, 0, 2, 3, 4)
    wi = wi.reshape(B, nb, Q_BLOCK, IDX_HEADS).transpose(1, 0, 2, 3)
    k = k.reshape(B, S, N_KV_HEADS, HEAD_DIM)
    v = v.reshape(B, S, N_KV_HEADS, HEAD_DIM)
    kpos = jnp.arange(S)
    gather = jax.vmap(lambda t, idx: t[idx])

    def block(args):
        qb, qib, wib, start = args
        qpos = start + jnp.arange(Q_BLOCK)
        logits = jnp.einsum('bqhd,bsd->bqhs', qib, ki).astype(f32) * IDX_DIM ** -0.5
        score = jnp.einsum('bqh,bqhs->bqs', wib.astype(f32) * IDX_HEADS ** -0.5, jax.nn.relu(logits))
        score = jnp.where(qpos[:, None] >= kpos[None, :], score, -jnp.inf)
        _, idx = lax.top_k(score, n_sel)
        valid = idx <= qpos[None, :, None]
        kg, vg = gather(k, idx), gather(v, idx)
        s = jnp.einsum('bqhgd,bqkhd->bhgqk', qb, kg).astype(f32) * HEAD_DIM ** -0.5
        bias = rel_position_bias(qpos[None, :, None] - idx, bias_table).transpose(0, 3, 1, 2).reshape(
            B, N_KV_HEADS, GQA_GROUP, Q_BLOCK, n_sel)
        s = jnp.where(valid[:, None, None], s + bias, -jnp.inf)
        p = jax.nn.softmax(s, axis=-1)
        return jnp.einsum('bhgqk,bqkhd->bqhgd', p.astype(vg.dtype), vg)

    o = lax.map(block, (q, qi, wi, jnp.arange(nb) * Q_BLOCK))
    return o.transpose(1, 0, 2, 3, 4, 5).reshape(B, S, N_HEADS * HEAD_DIM) @ w_out


def conv_ffn(h, w_up, conv_w, w_down):
    S = h.shape[1]
    u = h @ w_up
    up = jnp.pad(u, ((0, 0), (CONV_WIDTH - 1, 0), (0, 0)))
    c = conv_w[0] * up[:, 0:S]
    for j in range(1, CONV_WIDTH):
        c = c + conv_w[j] * up[:, j:j + S]
    gate, val = jnp.split(c, 2, axis=-1)
    return (jax.nn.silu(gate) * val) @ w_down


def setup_inputs(seed: int = 0) -> dict:
    key = jax.random.key(seed)
    ks = jax.random.split(key, 20)
    f32 = jnp.float32

    def dense(k, shape, fan_in):
        return jax.random.normal(k, shape, f32) * fan_in ** -0.5

    return {
        'x': jax.random.normal(ks[0], (BATCH, SEQ, D_MODEL), f32),
        'rel_bias_table': 0.3 * jax.random.normal(ks[1], (NUM_BUCKETS, N_HEADS), f32),
        'hgrn_lb_logits': 0.5 * jax.random.normal(ks[2], (DEPTH, HGRN_HEADS * HGRN_HEAD_DIM), f32),
        'norm_g': 1.0 + 0.02 * jax.random.normal(ks[3], (DEPTH, 4, D_MODEL), f32),
        'ffn_w_up': dense(ks[4], (DEPTH, D_MODEL, 2 * D_FF), D_MODEL),
        'ffn_conv': dense(ks[5], (DEPTH, CONV_WIDTH, 2 * D_FF), CONV_WIDTH),
        'ffn_w_down': dense(ks[6], (DEPTH, D_FF, D_MODEL), D_FF),
        'swa_w_in': dense(ks[7], (N_SWA, D_MODEL, SWA_IN), D_MODEL),
        'swa_w_out': dense(ks[8], (N_SWA, N_HEADS * HEAD_DIM, D_MODEL), N_HEADS * HEAD_DIM),
        'swa_sinks': 0.5 * jax.random.normal(ks[9], (N_SWA, N_HEADS), f32),
        'diff_w_in': dense(ks[10], (N_DIFF, D_MODEL, DIFF_IN), D_MODEL),
        'diff_w_out': dense(ks[11], (N_DIFF, DIFF_HEADS * DIFF_V_DIM, D_MODEL), DIFF_HEADS * DIFF_V_DIM),
        'diff_lambda': 0.1 * jax.random.normal(ks[12], (N_DIFF, 4, HEAD_DIM), f32),
        'diff_subln_g': 1.0 + 0.02 * jax.random.normal(ks[13], (N_DIFF, DIFF_V_DIM), f32),
        'hgrn_w_in': dense(ks[14], (N_HGRN, D_MODEL, HGRN_IN), D_MODEL),
        'hgrn_w_out': dense(ks[15], (N_HGRN, HGRN_HEADS * HGRN_HEAD_DIM, D_MODEL), HGRN_HEADS * HGRN_HEAD_DIM),
        'hgrn_norm_g': 1.0 + 0.02 * jax.random.normal(ks[16], (N_HGRN, HGRN_HEAD_DIM), f32),
        'dsa_w_in': dense(ks[17], (N_DSA, D_MODEL, DSA_IN), D_MODEL),
        'dsa_w_out': dense(ks[18], (N_DSA, N_HEADS * HEAD_DIM, D_MODEL), N_HEADS * HEAD_DIM),
    }


def reference(x, rel_bias_table, hgrn_lb_logits, norm_g, ffn_w_up, ffn_conv, ffn_w_down,
              swa_w_in, swa_w_out, swa_sinks, diff_w_in, diff_w_out, diff_lambda, diff_subln_g,
              hgrn_w_in, hgrn_w_out, hgrn_norm_g, dsa_w_in, dsa_w_out):
    lb_soft = jax.nn.softmax(hgrn_lb_logits.astype(jnp.float32), axis=0)
    lb_all = jnp.cumsum(lb_soft, axis=0) - lb_soft[0]
    for i in range(DEPTH):
        kind, j = i % N_MIXERS, i // N_MIXERS
        h = rms_norm(x, norm_g[i, 0])
        if kind == 0:
            m = swa_sink_attention(h, swa_w_in[j], swa_w_out[j], swa_sinks[j], rel_bias_table)
        elif kind == 1:
            m = diff_attention(h, diff_w_in[j], diff_w_out[j], diff_lambda[j], diff_subln_g[j],
                               rel_bias_table, i)
        elif kind == 2:
            m = hgrn2_recurrence(h, hgrn_w_in[j], hgrn_w_out[j], lb_all[i], hgrn_norm_g[j])
        else:
            m = dsa_sparse_attention(h, dsa_w_in[j], dsa_w_out[j], rel_bias_table)
        x = x + rms_norm(m, norm_g[i, 1])
        h = rms_norm(x, norm_g[i, 2])
        x = x + rms_norm(conv_ffn(h, ffn_w_up[i], ffn_conv[i], ffn_w_down[i]), norm_g[i, 3])
    return x
```

```cpp
#define MODE 0
#include <hip/hip_runtime.h>
#include <stdint.h>
#include <stdio.h>
#include <math.h>

#ifndef MODE
#define MODE 1
#endif

namespace cfg {
constexpr int B = 4, S = 2048, D = 2048, M = B * S, DFF = 5632, NUP = 2 * DFF, TOPK = 256;
constexpr int SWA_IN = 3072, DIFF_IN = 6144, HGRN_IN = 8192, DSA_IN = 4176, DSA_PAD = 4352;
constexpr float RMS_EPS = 1e-6f;
}
__constant__ unsigned char BUCKET_LUT[128] = {0,1,2,3,4,5,6,7,8,9,10,11,12,13,14,15,16,16,16,17,17,18,18,18,19,19,19,20,20,20,20,21,21,21,21,22,22,22,22,22,23,23,23,23,23,23,24,24,24,24,24,24,25,25,25,25,25,25,25,26,26,26,26,26,26,26,26,27,27,27,27,27,27,27,27,27,27,28,28,28,28,28,28,28,28,28,28,29,29,29,29,29,29,29,29,29,29,29,29,30,30,30,30,30,30,30,30,30,30,30,30,30,30,31,31,31,31,31,31,31,31,31,31,31,31,31,31,31};
#if MODE != 0
namespace orc {
using namespace cfg;

__device__ __forceinline__ float sigm(float x) { return 1.f / (1.f + expf(-x)); }
__device__ __forceinline__ int bucket(int n) { return n < 128 ? (int)BUCKET_LUT[n] : 31; }

__device__ __forceinline__ float wave_sum(float v) {
#pragma unroll
    for (int o = 32; o >= 1; o >>= 1) v += __shfl_xor(v, o);
    return v;
}
__device__ __forceinline__ float wave_max(float v) {
#pragma unroll
    for (int o = 32; o >= 1; o >>= 1) v = fmaxf(v, __shfl_xor(v, o));
    return v;
}
__device__ __forceinline__ float block_sum(float v, float* red) {
    v = wave_sum(v);
    const int w = threadIdx.x >> 6, nw = blockDim.x >> 6;
    __syncthreads();
    if ((threadIdx.x & 63) == 0) red[w] = v;
    __syncthreads();
    float r = 0.f;
    for (int i = 0; i < nw; ++i) r += red[i];
    return r;
}
__device__ __forceinline__ float block_max(float v, float* red) {
    v = wave_max(v);
    const int w = threadIdx.x >> 6, nw = blockDim.x >> 6;
    __syncthreads();
    if ((threadIdx.x & 63) == 0) red[w] = v;
    __syncthreads();
    float r = red[0];
    for (int i = 1; i < nw; ++i) r = fmaxf(r, red[i]);
    return r;
}

__global__ void __launch_bounds__(256) o_gemm(const float* __restrict__ A, int lda, const float* __restrict__ W, int ldw,
                                              float* __restrict__ C, int ldc, int N, int K) {
    __shared__ float As[16][132];
    __shared__ float Ws[16][132];
    const int tid = threadIdx.x, tx = tid & 15, ty = tid >> 4;
    const int m0 = blockIdx.y * 128, n0 = blockIdx.x * 128;
    float acc[8][8];
#pragma unroll
    for (int i = 0; i < 8; ++i)
#pragma unroll
        for (int j = 0; j < 8; ++j) acc[i][j] = 0.f;
    for (int k0 = 0; k0 < K; k0 += 16) {
#pragma unroll
        for (int i = 0; i < 8; ++i) { const int idx = tid + i * 256, r = idx >> 4, c = idx & 15; As[c][r] = A[(size_t)(m0 + r) * lda + k0 + c]; }
#pragma unroll
        for (int i = 0; i < 8; ++i) { const int idx = tid + i * 256, r = idx >> 7, c = idx & 127; Ws[r][c] = (n0 + c < N) ? W[(size_t)(k0 + r) * ldw + n0 + c] : 0.f; }
        __syncthreads();
#pragma unroll
        for (int kk = 0; kk < 16; ++kk) {
            float a[8], b[8];
#pragma unroll
            for (int i = 0; i < 8; ++i) { a[i] = As[kk][ty * 8 + i]; b[i] = Ws[kk][tx * 8 + i]; }
#pragma unroll
            for (int i = 0; i < 8; ++i)
#pragma unroll
                for (int j = 0; j < 8; ++j) acc[i][j] = fmaf(a[i], b[j], acc[i][j]);
        }
        __syncthreads();
    }
#pragma unroll
    for (int i = 0; i < 8; ++i)
#pragma unroll
        for (int j = 0; j < 8; ++j) { const int n = n0 + tx * 8 + j; if (n < N) C[(size_t)(m0 + ty * 8 + i) * ldc + n] = acc[i][j]; }
}

template <bool ADD>
__global__ void __launch_bounds__(256) o_rmsnorm(const float* __restrict__ in, const float* __restrict__ g, float* __restrict__ out) {
    __shared__ float red[16];
    const size_t row = blockIdx.x;
    const float* x = in + row * D;
    float ss = 0.f;
    for (int c = threadIdx.x; c < D; c += 256) ss += x[c] * x[c];
    ss = block_sum(ss, red);
    const float r = rsqrtf(ss / (float)D + RMS_EPS);
    for (int c = threadIdx.x; c < D; c += 256) { const float y = x[c] * r * g[c]; if (ADD) out[row * D + c] += y; else out[row * D + c] = y; }
}

__global__ void __launch_bounds__(128) o_swa(const float* __restrict__ Z, const float* __restrict__ bias, const float* __restrict__ sinks, float* __restrict__ O, int b0) {
    __shared__ float qs[64], ps[128], red[16];
    const int t = blockIdx.x, h = blockIdx.y, bl = blockIdx.z, kvh = h >> 2, tid = threadIdx.x;
    const size_t zr = (size_t)bl * S + t;
    const float* zq = Z + zr * 3072;
    if (tid < 64) qs[tid] = zq[h * 64 + tid];
    __syncthreads();
    const int j = tid, s = t - j;
    float sc = -INFINITY;
    if (s >= 0) {
        const float* kp = Z + (zr - j) * 3072 + 2048 + kvh * 64;
        float d = 0.f;
        for (int e = 0; e < 64; ++e) d = fmaf(qs[e], kp[e], d);
        sc = d * 0.125f + bias[bucket(j) * 32 + h];
    }
    const float sink = sinks[h];
    const float mx = fmaxf(block_max(sc, red), sink);
    const float p = (s >= 0) ? expf(sc - mx) : 0.f;
    const float den = block_sum(p, red) + expf(sink - mx);
    ps[j] = p / den;
    __syncthreads();
    if (tid < 64) {
        float o = 0.f;
        const int nj = t < 127 ? t + 1 : 128;
        for (int jj = 0; jj < nj; ++jj) o = fmaf(ps[jj], Z[(zr - jj) * 3072 + 2560 + kvh * 64 + tid], o);
        O[((size_t)(b0 + bl) * S + t) * D + h * 64 + tid] = o;
    }
}

__global__ void __launch_bounds__(256) o_diff(const float* __restrict__ Z, const float* __restrict__ bias, const float* __restrict__ lambdas, const float* __restrict__ subg,
                                              float* __restrict__ O, int b0, float lam_init) {
    __shared__ float qs[128], sc[2][2048], part[256], red[16];
    const int t = blockIdx.x, h = blockIdx.y, bl = blockIdx.z, tid = threadIdx.x;
    const size_t zr0 = (size_t)bl * S;
    const float* zq = Z + (zr0 + t) * 6144;
    if (tid < 128) qs[tid] = zq[h * 128 + tid];
    float l1 = 0.f, l2 = 0.f;
    if (tid < 64) { l1 = lambdas[tid] * lambdas[64 + tid]; l2 = lambdas[128 + tid] * lambdas[192 + tid]; }
    l1 = block_sum(l1, red); l2 = block_sum(l2, red);
    const float lam = expf(l1) - expf(l2) + lam_init;
    float mx[2], sm[2];
    for (int m = 0; m < 2; ++m) {
        float lmx = -INFINITY;
        for (int s = tid; s <= t; s += 256) {
            const float* kp = Z + (zr0 + s) * 6144 + 2048 + h * 128 + m * 64;
            float d = 0.f;
            for (int e = 0; e < 64; ++e) d = fmaf(qs[m * 64 + e], kp[e], d);
            const float v = d * 0.125f + bias[bucket(t - s) * 32 + h * 2 + m];
            sc[m][s] = v; lmx = fmaxf(lmx, v);
        }
        mx[m] = block_max(lmx, red);
        float ls = 0.f;
        for (int s = tid; s <= t; s += 256) ls += expf(sc[m][s] - mx[m]);
        sm[m] = block_sum(ls, red);
    }
    for (int s = tid; s <= t; s += 256) sc[0][s] = expf(sc[0][s] - mx[0]) / sm[0] - lam * (expf(sc[1][s] - mx[1]) / sm[1]);
    __syncthreads();
    const int e = tid & 127, half = tid >> 7;
    float o = 0.f;
    for (int s = half; s <= t; s += 2) o = fmaf(sc[0][s], Z[(zr0 + s) * 6144 + 4096 + h * 128 + e], o);
    part[tid] = o;
    __syncthreads();
    float ov = 0.f, ss = 0.f;
    if (tid < 128) { ov = part[tid] + part[tid + 128]; ss = ov * ov; }
    ss = block_sum(ss, red);
    if (tid < 128) {
        const float r = rsqrtf(ss / 128.f + RMS_EPS);
        O[((size_t)(b0 + bl) * S + t) * D + h * 128 + e] = ov * r * subg[e] * (1.f - lam_init);
    }
}

__global__ void __launch_bounds__(256) o_hgrn(const float* __restrict__ Z, const float* __restrict__ lb_logits, const float* __restrict__ ng, float* __restrict__ O, int b0) {
    __shared__ float qs[128], fs[128], ks[128], part[256], red[16];
    const int h = blockIdx.x, bl = blockIdx.z, tid = threadIdx.x, v = tid & 127, kh = tid >> 7;
    float lb = 0.f;
    if (tid < 128) {
        const int c = h * 128 + tid;
        const float a0 = lb_logits[c], a1 = lb_logits[2048 + c], a2 = lb_logits[4096 + c], a3 = lb_logits[6144 + c];
        const float mm = fmaxf(fmaxf(a0, a1), fmaxf(a2, a3));
        const float e0 = expf(a0 - mm), e1 = expf(a1 - mm), e2 = expf(a2 - mm), e3 = expf(a3 - mm);
        lb = (e1 + e2) / (e0 + e1 + e2 + e3);
    }
    float St[64];
#pragma unroll
    for (int i = 0; i < 64; ++i) St[i] = 0.f;
    const float gn = ng[v];
    for (int t = 0; t < S; ++t) {
        const float* zr = Z + ((size_t)bl * S + t) * 8192;
        if (tid < 128) {
            const float qv = zr[h * 128 + tid]; qs[tid] = qv * sigm(qv);
            const float z = zr[2048 + h * 128 + tid];
            fs[tid] = lb + (1.f - lb) * sigm(z);
            ks[tid] = (1.f - lb) * sigm(-z);
        }
        const float iv = zr[4096 + h * 128 + v];
        __syncthreads();
        float p = 0.f;
#pragma unroll
        for (int kk = 0; kk < 64; ++kk) { const int k = kh * 64 + kk; St[kk] = fmaf(fs[k], St[kk], ks[k] * iv); p = fmaf(qs[k], St[kk], p); }
        part[tid] = p;
        __syncthreads();
        float ov = 0.f, ss = 0.f;
        if (tid < 128) { ov = part[tid] + part[tid + 128]; ss = ov * ov; }
        ss = block_sum(ss, red);
        if (tid < 128) {
            const float r = rsqrtf(ss / 128.f + RMS_EPS);
            const float gt = zr[6144 + h * 128 + v];
            O[((size_t)(b0 + bl) * S + t) * D + h * 128 + v] = ov * r * gn * (gt * sigm(gt));
        }
        __syncthreads();
    }
}

__global__ void __launch_bounds__(256) o_dsa(const float* __restrict__ Z, const float* __restrict__ bias, float* __restrict__ O, int b0) {
    __shared__ float qi[1024], wi[16], sc[2048], q[2048], pj[256], red[16];
    __shared__ int idx[256];
    __shared__ unsigned char sel[2048];
    __shared__ int nsel_s;
    const int t = blockIdx.x, bl = blockIdx.z, tid = threadIdx.x;
    const size_t zr0 = (size_t)bl * S;
    const int LD = 4176;
    const float* zq = Z + (zr0 + t) * LD;
    for (int i = tid; i < 1024; i += 256) qi[i] = zq[3072 + i];
    for (int i = tid; i < 2048; i += 256) q[i] = zq[i];
    if (tid < 16) wi[tid] = zq[4160 + tid] * 0.25f;
    __syncthreads();
    for (int s = tid; s < S; s += 256) {
        float a = -INFINITY;
        if (s <= t) {
            const float* kp = Z + (zr0 + s) * LD + 4096;
            a = 0.f;
            for (int hh = 0; hh < 16; ++hh) {
                float d = 0.f;
                for (int e = 0; e < 64; ++e) d = fmaf(qi[hh * 64 + e], kp[e], d);
                d *= 0.125f;
                a += wi[hh] * fmaxf(d, 0.f);
            }
        }
        sc[s] = a;
    }
    __syncthreads();
    for (int s = tid; s < S; s += 256) {
        const float v = sc[s];
        int r = 0;
        for (int s2 = 0; s2 < S; ++s2) { const float v2 = sc[s2]; r += (v2 > v || (v2 == v && s2 < s)) ? 1 : 0; }
        sel[s] = (r < TOPK && s <= t) ? 1 : 0;
    }
    __syncthreads();
    if (tid == 0) { int n = 0; for (int s = 0; s < S; ++s) if (sel[s]) { if (n < 256) idx[n] = s; ++n; } nsel_s = n < 256 ? n : 256; }
    __syncthreads();
    const int nsel = nsel_s;
    for (int h = 0; h < 32; ++h) {
        const int kvh = h >> 2;
        float scv = -INFINITY; int s = 0;
        if (tid < nsel) {
            s = idx[tid];
            const float* kp = Z + (zr0 + s) * LD + 2048 + kvh * 64;
            float d = 0.f;
            for (int e = 0; e < 64; ++e) d = fmaf(q[h * 64 + e], kp[e], d);
            scv = d * 0.125f + bias[bucket(t - s) * 32 + h];
        }
        const float mx = block_max(scv, red);
        const float ev = (tid < nsel) ? expf(scv - mx) : 0.f;
        const float sm = block_sum(ev, red);
        pj[tid] = ev / sm;
        __syncthreads();
        if (tid < 64) {
            float o = 0.f;
            for (int j = 0; j < nsel; ++j) o = fmaf(pj[j], Z[(zr0 + idx[j]) * LD + 2560 + kvh * 64 + tid], o);
            O[((size_t)(b0 + bl) * S + t) * D + h * 64 + tid] = o;
        }
        __syncthreads();
    }
}

__global__ void __launch_bounds__(256) o_convact(const float* __restrict__ U, const float* __restrict__ cw, float* __restrict__ A) {
    const int c = blockIdx.x * 256 + threadIdx.x; const size_t r = blockIdx.y; const int t = (int)(r % S);
    float g = 0.f, v = 0.f;
#pragma unroll
    for (int j = 0; j < 3; ++j) {
        const int tt = t - 2 + j;
        if (tt >= 0) { const float* u = U + (r - 2 + j) * NUP; g = fmaf(cw[j * NUP + c], u[c], g); v = fmaf(cw[j * NUP + DFF + c], u[DFF + c], v); }
    }
    A[r * DFF + c] = g * sigm(g) * v;
}

struct Bufs { float *X, *H, *Z, *O, *MF, *U, *A; };

template <class Hook> static void run_mixer(const Bufs& bf, void* const* d_in, int layer, int b0, int nb, hipStream_t st, Hook hook) {
    const float* ng = (const float*)d_in[3] + (size_t)layer * 4 * D;
    const int rows = nb * S; const size_t r0 = (size_t)b0 * S;
    const float* bias = (const float*)d_in[1];
    o_rmsnorm<false><<<rows, 256, 0, st>>>(bf.X + r0 * D, ng, bf.H);
    hook(0);
    const int kind = layer % 4;
    const float* win = (const float*)d_in[kind == 0 ? 7 : kind == 1 ? 10 : kind == 2 ? 14 : 17];
    const float* wout = (const float*)d_in[kind == 0 ? 8 : kind == 1 ? 11 : kind == 2 ? 15 : 18];
    const int nin = kind == 0 ? SWA_IN : kind == 1 ? DIFF_IN : kind == 2 ? HGRN_IN : DSA_IN;
    o_gemm<<<dim3((nin + 127) / 128, rows / 128), 256, 0, st>>>(bf.H, D, win, nin, bf.Z, nin, nin, D);
    hook(1);
    if (kind == 0) o_swa<<<dim3(S, 32, nb), 128, 0, st>>>(bf.Z, bias, (const float*)d_in[9], bf.O, b0);
    else if (kind == 1) o_diff<<<dim3(S, 16, nb), 256, 0, st>>>(bf.Z, bias, (const float*)d_in[12], (const float*)d_in[13], bf.O, b0, 0.8f - 0.6f * expf(-0.3f * (float)layer));
    else if (kind == 2) o_hgrn<<<dim3(16, 1, nb), 256, 0, st>>>(bf.Z, (const float*)d_in[2], (const float*)d_in[16], bf.O, b0);
    else o_dsa<<<dim3(S, 1, nb), 256, 0, st>>>(bf.Z, bias, bf.O, b0);
    o_gemm<<<dim3(D / 128, rows / 128), 256, 0, st>>>(bf.O + r0 * D, D, wout, D, bf.MF + r0 * D, D, D, D);
    o_rmsnorm<true><<<rows, 256, 0, st>>>(bf.MF + r0 * D, ng + D, bf.X + r0 * D);
}
template <class Hook> static void run_ffn(const Bufs& bf, void* const* d_in, int layer, int b0, int nb, hipStream_t st, Hook hook) {
    const float* ng = (const float*)d_in[3] + (size_t)layer * 4 * D;
    const int rows = nb * S; const size_t r0 = (size_t)b0 * S;
    o_rmsnorm<false><<<rows, 256, 0, st>>>(bf.X + r0 * D, ng + 2 * D, bf.H);
    o_gemm<<<dim3(NUP / 128, rows / 128), 256, 0, st>>>(bf.H, D, (const float*)d_in[4] + (size_t)layer * D * NUP, NUP, bf.U, NUP, NUP, D);
    hook(2);
    o_convact<<<dim3(DFF / 256, rows), 256, 0, st>>>(bf.U, (const float*)d_in[5] + (size_t)layer * 3 * NUP, bf.A);
    hook(3);
    o_gemm<<<dim3(D / 128, rows / 128), 256, 0, st>>>(bf.A, DFF, (const float*)d_in[6] + (size_t)layer * DFF * D, D, bf.MF + r0 * D, D, D, DFF);
    o_rmsnorm<true><<<rows, 256, 0, st>>>(bf.MF + r0 * D, ng + 3 * D, bf.X + r0 * D);
}
struct NoHook { void operator()(int) const {} };
}

#endif

#if MODE != 1
#define GAS __attribute__((address_space(1)))
#define LAS __attribute__((address_space(3)))
typedef _Float16 half_t;
typedef _Float16 h16x8 __attribute__((ext_vector_type(8)));
typedef _Float16 h16x4 __attribute__((ext_vector_type(4)));
typedef _Float16 h16x2 __attribute__((ext_vector_type(2)));
typedef float f32x4 __attribute__((ext_vector_type(4)));
typedef float f32x2 __attribute__((ext_vector_type(2)));
typedef unsigned u32x4 __attribute__((ext_vector_type(4)));
typedef unsigned u32x2 __attribute__((ext_vector_type(2)));
#define MFMA16(a, b, c) __builtin_amdgcn_mfma_f32_16x16x32_f16((a), (b), (c), 0, 0, 0)
__device__ __forceinline__ unsigned pkh(float lo, float hi) { h16x2 v; v.x = (_Float16)lo; v.y = (_Float16)hi; return __builtin_bit_cast(unsigned, v); }
__device__ __forceinline__ float fexp2(float x) { return __builtin_amdgcn_exp2f(x); }
__device__ __forceinline__ float fexp(float x) { return __builtin_amdgcn_exp2f(x * 1.4426950408889634f); }
__device__ __forceinline__ float fsigm(float x) { return __builtin_amdgcn_rcpf(1.f + fexp(-x)); }

#define XB_TMO      128
#define XB_XCNT(j)  (256  + 64 * (j))
#define XB_XSUB(j)  (1280 + 64 * (j))
#define XB_XGEN(j)  (2304 + 64 * (j))
#define XB_TOP      3328
#define XB_TOPGEN   3392
#define XCD_BAR_WORDS 3456
#define XB_SPIN_CAP (1u << 18)

__device__ __forceinline__ unsigned xb_ld(unsigned* p)              { return __hip_atomic_load(p, __ATOMIC_RELAXED, __HIP_MEMORY_SCOPE_AGENT); }
__device__ __forceinline__ unsigned xb_add(unsigned* p, unsigned v) { return __hip_atomic_fetch_add(p, v, __ATOMIC_RELAXED, __HIP_MEMORY_SCOPE_AGENT); }
__device__ __forceinline__ unsigned xb_xcc_id() { return (unsigned)__builtin_amdgcn_s_getreg((3 << 11) | 20) & 0xFu; }
#define XB_SPIN(cond, bar) do { unsigned _sp = 0; while (cond) { __builtin_amdgcn_s_sleep(1); \
    if ((++_sp & 255u) == 0u) { if (xb_ld(&(bar)[XB_TMO])) break; if (_sp > XB_SPIN_CAP) { atomicAdd(&(bar)[XB_TMO], 1u); break; } } } } while (0)

struct XcdBarrier {
    unsigned* bar; unsigned x;
    volatile LAS unsigned* st;
};

__device__ __forceinline__ XcdBarrier xcd_barrier_post(unsigned* bar, volatile LAS unsigned* st) {
    XcdBarrier b; b.bar = bar; b.x = xb_xcc_id(); b.st = st;
    if (threadIdx.x == 0) (void)xb_add(&bar[XB_XCNT(b.x)], 1u);
    return b;
}
__device__ __forceinline__ void xcd_barrier_complete(unsigned* bar, unsigned x, unsigned& nloc, unsigned& nx) {
    const unsigned G = gridDim.x * gridDim.y * gridDim.z;
    unsigned sum, cnt, mine, sp = 0u;
    for (;;) {
        sum = 0u; cnt = 0u; mine = 0u;
#pragma unroll
        for (unsigned j = 0; j < 16; ++j) { const unsigned c = xb_ld(&bar[XB_XCNT(j)]); sum += c; cnt += (c > 0u) ? 1u : 0u; mine = (j == x) ? c : mine; }
        if (sum == G) break;
        __builtin_amdgcn_s_sleep(1);
        if ((++sp & 255u) == 0u) { if (xb_ld(&bar[XB_TMO])) break; if (sp > XB_SPIN_CAP) { atomicAdd(&bar[XB_TMO], 1u); break; } }
    }
    nloc = mine > 0u ? mine : 1u; nx = cnt > 0u ? cnt : 1u;
}

__device__ __forceinline__ void xcd_barrier(const XcdBarrier& b) {
    asm volatile("s_waitcnt vmcnt(0)" ::: "memory");
    __syncthreads();
    if (threadIdx.x == 0) {
        unsigned* bar = b.bar;
        __builtin_amdgcn_s_waitcnt(0);
        unsigned nloc = b.st[0], nx = b.st[1];
        if (nloc == 0u) { xcd_barrier_complete(bar, b.x, nloc, nx); b.st[0] = nloc; b.st[1] = nx; }
        const unsigned old = xb_add(&bar[XB_XSUB(b.x)], 1u);
        const unsigned gen = old / nloc;
        if (old + 1u == (gen + 1u) * nloc) {
            __builtin_amdgcn_fence(__ATOMIC_RELEASE, "agent");
            asm volatile("s_waitcnt vmcnt(0)" ::: "memory");
            const unsigned og = xb_add(&bar[XB_TOP], 1u);
            const unsigned tg = og / nx;
            if (og + 1u == (tg + 1u) * nx) xb_add(&bar[XB_TOPGEN], 1u);
            else XB_SPIN(xb_ld(&bar[XB_TOPGEN]) == tg, bar);
            __builtin_amdgcn_fence(__ATOMIC_ACQUIRE, "agent");
            xb_add(&bar[XB_XGEN(b.x)], 1u);
            asm volatile("s_waitcnt vmcnt(0)" ::: "memory");
        } else {
            XB_SPIN(xb_ld(&bar[XB_XGEN(b.x)]) == gen, bar);
            __builtin_amdgcn_fence(__ATOMIC_ACQUIRE, "agent");
            asm volatile("s_waitcnt vmcnt(0)" ::: "memory");
        }
    }
    __syncthreads();
}

template <int CTRL> __device__ __forceinline__ float dppx_f(float v) { return __builtin_bit_cast(float, __builtin_amdgcn_update_dpp(0, __builtin_bit_cast(int, v), CTRL, 0xf, 0xf, true)); }
template <int CTRL> __device__ __forceinline__ float dppo_f(float old, float v) { return __builtin_bit_cast(float, __builtin_amdgcn_update_dpp(__builtin_bit_cast(int, old), __builtin_bit_cast(int, v), CTRL, 0xf, 0xf, false)); }
namespace pg8 {
#define PG8_LAS __attribute__((address_space(3)))
constexpr int BM = 256, BK = 64, HALF = 128, HTB = HALF * BK * 2  , STAGE_BYTES = 8 * HTB, NXCD = 8, WGM = 8;
__host__ __device__ __forceinline__ int lds_byte(int r, int c) { const int st = (r >> 4) * 2 + (c >> 5), rr = r & 15, cc = c & 31, ob = rr * 64 + cc * 2; return st * 1024 + (ob ^ (((ob >> 9) & 1) << 5)); }
__host__ __device__ __forceinline__ void stage_rc(int b, int& R, int& C) { const int st = b / 1024, sb = b % 1024, swz = sb ^ (((sb >> 9) & 1) << 5); R = (st >> 1) * 16 + swz / 64; C = (st & 1) * 32 + (swz % 64) / 2; }
__host__ __device__ __forceinline__ int perm32(int rho) { const int n = rho >> 4, i = rho & 15; return 8 * (i >> 2) + 4 * n + (i & 3); }
struct Unit { int pm, pn; };
struct Gemm { const half_t* A; const half_t* Bt; int M, N, K; int a_step = 256, a_off = 0; };
struct StaticOrder {
    int nM, nN, nwg, G, c;
    __host__ __device__ void init(int M, int N, int G_, int c_) { nM = M / BM; nN = N / BM; nwg = nM * nN; G = G_; c = c_; }
    __host__ __device__ bool next(int i, Unit& u) const {
        const long L = (long)i * G + c; if (L >= nwg) return false;
        int wgid = (int)L; { const int q = nwg / NXCD, r = nwg % NXCD, xcd = wgid % NXCD, off = wgid / NXCD; wgid = (xcd < r ? xcd * (q + 1) : r * (q + 1) + (xcd - r) * q) + off; }
        const int nig = WGM * nN, gid = wgid / nig, fm = gid * WGM, gsz = (nM - fm) < WGM ? (nM - fm) : WGM;
        u.pm = fm + ((wgid % nig) % gsz); u.pn = (wgid % nig) / gsz; return true;
    }
    __device__ __forceinline__ void a_ready(const Unit&) const {}
    __device__ __forceinline__ void done(const Unit&) const {}
};
struct EpiF32 {
    static constexpr bool PERM = false, AFTER_DRAIN = false;
    float* C; int ldc;
    __device__ __forceinline__ void operator()(const f32x4 (&acc)[2][2][4][2], const Unit& u, int wr, int wc, int fr, int fq) const {
        const int row0 = u.pm * BM + wr * 64 + fr, col0 = u.pn * BM + wc * 32 + 4 * fq;
#pragma unroll
        for (int ai = 0; ai < 2; ++ai)
#pragma unroll
            for (int m = 0; m < 4; ++m) { float* rowp = C + (size_t)(row0 + ai * HALF + m * 16) * ldc + col0;
#pragma unroll
                for (int bj = 0; bj < 2; ++bj)
#pragma unroll
                    for (int n = 0; n < 2; ++n) *(f32x4*)(rowp + bj * HALF + n * 16) = acc[ai][bj][m][n]; }
    }
};
template <bool SCALE>
struct EpiH16T {
    static constexpr bool PERM = true, AFTER_DRAIN = false;
    half_t* O; int ldc; const float* rs = nullptr;
    __device__ __forceinline__ void operator()(const f32x4 (&acc)[2][2][4][2], const Unit& u, int wr, int wc, int fr, int fq) const {
        const int row0 = u.pm * BM + wr * 64 + fr, col0 = u.pn * BM + wc * 32 + 8 * fq;
        float sc[2][4];
#pragma unroll
        for (int ai = 0; ai < 2; ++ai)
#pragma unroll
            for (int m = 0; m < 4; ++m) sc[ai][m] = SCALE ? rs[row0 + ai * HALF + m * 16] : 1.f;
#pragma unroll
        for (int ai = 0; ai < 2; ++ai)
#pragma unroll
            for (int m = 0; m < 4; ++m) { half_t* rowp = O + (size_t)(row0 + ai * HALF + m * 16) * ldc + col0;
#pragma unroll
                for (int bj = 0; bj < 2; ++bj) { f32x4 v0 = acc[ai][bj][m][0], v1 = acc[ai][bj][m][1];
                    if (SCALE) { v0 *= sc[ai][m]; v1 *= sc[ai][m]; }
                    u32x4 w; w.x = pkh(v0[0], v0[1]); w.y = pkh(v0[2], v0[3]); w.z = pkh(v1[0], v1[1]); w.w = pkh(v1[2], v1[3]);
                    *(u32x4*)(rowp + bj * HALF) = w; } }
    }
};
using EpiH16 = EpiH16T<false>;
struct EpiConv {
    static constexpr bool PERM = true, AFTER_DRAIN = false;
    half_t* ACT; const float* cw; PG8_LAS float* xb; int Mrows, seq, dff, nup; const float* rs;
    __device__ __forceinline__ void operator()(f32x4 (&acc)[2][2][4][2], const Unit& u, int wr, int wc, int fr, int fq) const {
        int cc0 = wc * 32 + 8 * fq;
        asm volatile("" : "+v"(cc0));
        PG8_LAS float* wl = xb + 2048; PG8_LAS float* rsl = xb + 2048 + 768;
        if (fr >= 14) {
#pragma unroll
            for (int ai = 0; ai < 2; ++ai)
#pragma unroll
                for (int bj = 0; bj < 2; ++bj)
#pragma unroll
                    for (int n = 0; n < 2; ++n) *(PG8_LAS f32x4*)(xb + ((((2 * ai + wr) * 2 + (fr - 14)) * 2 + bj) * 128) + cc0 + 4 * n) = acc[ai][bj][3][n];
        }
        { const int t = (wr * 4 + wc) * 64 + fq * 16 + fr;
          for (int idx = t; idx < 768; idx += 512) { const int j = idx >> 8, col = idx & 255; wl[idx] = cw[(size_t)j * nup + (col >> 7) * dff + 128 * u.pn + (col & 127)]; }
          if (t < 256) { int gr = 254 * u.pm - 2 + t; gr = gr < 0 ? 0 : (gr >= Mrows ? Mrows - 1 : gr); rsl[t] = rs[gr]; } }
        asm volatile("s_waitcnt vmcnt(0) lgkmcnt(0)" ::: "memory"); __builtin_amdgcn_s_barrier(); asm volatile("" ::: "memory");
        const int gr0 = 254 * u.pm - 2;
        const bool hs = ((gr0 + 255) >> 11) != ((gr0 - 2) >> 11);
#pragma unroll
        for (int ai = 0; ai < 2; ++ai) {
            const int pred = 2 * ai + wr - 1;
#pragma unroll
            for (int mm = 0; mm < 4; ++mm) {
                const int m = 3 - mm;
                const int R = 128 * ai + 64 * wr + 16 * m + fr, gr = gr0 + R, ts = gr & (seq - 1);
                if (mm == 0) { const float rc = rsl[R];
#pragma unroll
                    for (int bj = 0; bj < 2; ++bj)
#pragma unroll
                        for (int n = 0; n < 2; ++n) acc[ai][bj][3][n] *= rc; }
                if (m > 0) { const float rp = rsl[R - 16];
#pragma unroll
                    for (int bj = 0; bj < 2; ++bj)
#pragma unroll
                        for (int n = 0; n < 2; ++n) acc[ai][bj][m > 0 ? m - 1 : 0][n] *= rp; }
                float rx0 = 0.f, rx1 = 0.f;
                if (m == 0 && pred >= 0) { rx0 = rsl[64 * pred + 62]; rx1 = rsl[64 * pred + 63]; }
#pragma unroll
                for (int n = 0; n < 2; ++n) {
                    f32x4 cv[2];
#pragma unroll
                    for (int bj = 0; bj < 2; ++bj) {
                        const f32x4 cur = acc[ai][bj][m][n];
                        f32x4 p1, p2;
                        if (m > 0) {
                            const f32x4 pv = acc[ai][bj][m > 0 ? m - 1 : 0][n];
#pragma unroll
                            for (int e = 0; e < 4; ++e) { const float q1 = dppx_f<0x121>(pv[e]), q2 = dppx_f<0x122>(pv[e]);
                                p1[e] = dppo_f<0x111>(q1, cur[e]); p2[e] = dppo_f<0x112>(q2, cur[e]); }
                        } else {
                            f32x4 x0 = (f32x4){0.f, 0.f, 0.f, 0.f}, x1 = x0;
                            if (pred >= 0) { x0 = *(const PG8_LAS f32x4*)(xb + (((pred * 2 + 0) * 2 + bj) * 128) + cc0 + 4 * n); x1 = *(const PG8_LAS f32x4*)(xb + (((pred * 2 + 1) * 2 + bj) * 128) + cc0 + 4 * n); x0 *= rx0; x1 *= rx1; }
#pragma unroll
                            for (int e = 0; e < 4; ++e) { const float o2 = (fr == 0) ? x0[e] : x1[e];
                                p1[e] = dppo_f<0x111>(x1[e], cur[e]); p2[e] = dppo_f<0x112>(o2, cur[e]); }
                        }
                        if (hs) {
#pragma unroll
                            for (int e = 0; e < 4; ++e) { p1[e] = (ts >= 1) ? p1[e] : 0.f; p2[e] = (ts >= 2) ? p2[e] : 0.f; }
                        }
                        const f32x4 w0 = *(const PG8_LAS f32x4*)(wl + 0 * 256 + bj * 128 + cc0 + 4 * n), w1 = *(const PG8_LAS f32x4*)(wl + 1 * 256 + bj * 128 + cc0 + 4 * n), w2 = *(const PG8_LAS f32x4*)(wl + 2 * 256 + bj * 128 + cc0 + 4 * n);
                        cv[bj] = w0 * p2 + w1 * p1 + w2 * cur;
                    }
                    float r_[4];
#pragma unroll
                    for (int e = 0; e < 4; ++e) { const float g_ = cv[0][e]; r_[e] = g_ * __builtin_amdgcn_rcpf(1.f + __builtin_amdgcn_exp2f(-1.4426950408889634f * g_)) * cv[1][e]; }
                    u32x2 o; o.x = pkh(r_[0], r_[1]); o.y = pkh(r_[2], r_[3]);
                    if (R >= 2 && gr < Mrows) *(u32x2*)(ACT + (size_t)gr * dff + 128 * u.pn + cc0 + 4 * n) = o;
                    asm volatile("" ::: "memory"); __builtin_amdgcn_sched_barrier(0);
                }
                asm volatile("" ::: "memory"); __builtin_amdgcn_sched_barrier(0);
            }
        }
    }
};
template <class Epi, class Sched, bool ALIGN_EPI = false, bool SP2 = false>
__device__ __forceinline__ void gemm_phase(PG8_LAS unsigned char* lds, const Gemm g, const Sched& S, const Epi& E) {
    const int tid = threadIdx.x, wid = __builtin_amdgcn_readfirstlane(tid >> 6), lane = tid & 63, wr = wid >> 2, wc = wid & 3, fr = lane & 15, fq = lane >> 4;
    const int K = g.K, nt = K / BK;
    unsigned voffA[2], voffB[2];
#pragma unroll
    for (int i = 0; i < 2; ++i) { int R, C; stage_rc(tid * 16 + i * 8192, R, C); const int Rb = Epi::PERM ? ((R & ~31) + perm32(R & 31)) : R;
        voffA[i] = (unsigned)(R * K + C) * 2u; voffB[i] = (unsigned)(Rb * K + C) * 2u; }
    const size_t kstep = (size_t)(BK * 2);
    const size_t hstep = (size_t)HALF * K * 2;
    const size_t tstep = 2 * hstep;
    const unsigned ldsw = (unsigned)wid * 1024u;
    const int aoff = lds_byte(wr * 64 + fr, fq * 8), boff = lds_byte(wc * 32 + fr, fq * 8);
#define PG8_SA(b, h) (((b) * 2 + (h)) * HTB)
#define PG8_SB(b, h) ((4 + (b) * 2 + (h)) * HTB)
#define PG8_STAGE(bufoff, gbase, voff) do { _Pragma("unroll") for (int _i = 0; _i < 2; ++_i) \
        __builtin_amdgcn_global_load_lds((const unsigned*)((const char*)(gbase) + (voff)[_i]), (PG8_LAS unsigned*)(lds + (bufoff) + ldsw + _i * 8192), 16, 0, 0); } while (0)
#define PG8_LDA(dst, b, h) do { _Pragma("unroll") for (int m = 0; m < 4; ++m) _Pragma("unroll") for (int k = 0; k < 2; ++k) dst[m][k] = *(const PG8_LAS h16x8*)(lds + PG8_SA(b, h) + aoff + m * 2048 + k * 1024); } while (0)
#define PG8_LDB(dst, b, h) do { _Pragma("unroll") for (int n = 0; n < 2; ++n) _Pragma("unroll") for (int k = 0; k < 2; ++k) dst[n][k] = *(const PG8_LAS h16x8*)(lds + PG8_SB(b, h) + boff + n * 2048 + k * 1024); } while (0)
#define PG8_MMA(ai, bj, At, Bt) do { __builtin_amdgcn_s_setprio(1); _Pragma("unroll") for (int m = 0; m < 4; ++m) _Pragma("unroll") for (int n = 0; n < 2; ++n) _Pragma("unroll") for (int k = 0; k < 2; ++k) \
        acc[ai][bj][m][n] = __builtin_amdgcn_mfma_f32_16x16x32_f16(Bt[n][k], At[m][k], acc[ai][bj][m][n], 0, 0, 0); __builtin_amdgcn_s_setprio(0); } while (0)
#define PG8_WAIT_V(n) asm volatile("s_waitcnt vmcnt(" #n ")" ::: "memory")
#define PG8_WAIT_L(n) asm volatile("s_waitcnt lgkmcnt(" #n ")" ::: "memory")
#define PG8_BAR __builtin_amdgcn_s_barrier()
#define PG8_SCHED __builtin_amdgcn_sched_barrier(0)
    Unit cur, nxt; int ui = 0;
    if (!S.next(0, cur)) return;
    f32x4 acc[2][2][4][2];
#pragma unroll
    for (int a = 0; a < 2; ++a)
#pragma unroll
        for (int b = 0; b < 2; ++b)
#pragma unroll
            for (int m = 0; m < 4; ++m)
#pragma unroll
                for (int n = 0; n < 2; ++n) acc[a][b][m][n] = (f32x4){0.f, 0.f, 0.f, 0.f};
    h16x8 At[4][2], B0[2][2], B1[2][2];
    const long arow_bytes = (long)K * 2; const char* cA = (const char*)g.A + ((long)cur.pm * g.a_step + g.a_off) * arow_bytes; const char* cB = (const char*)g.Bt + (size_t)cur.pn * tstep;
    S.a_ready(cur);
    if constexpr (SP2) {
        PG8_STAGE(PG8_SB(0, 0), cB, voffB); PG8_STAGE(PG8_SB(0, 1), cB + hstep, voffB); PG8_STAGE(PG8_SA(0, 0), cA, voffA); PG8_STAGE(PG8_SA(0, 1), cA + hstep, voffA);
        if (wr == 1) PG8_BAR;
        PG8_WAIT_V(2); PG8_BAR;
        PG8_STAGE(PG8_SB(1, 0), cB + kstep, voffB); PG8_STAGE(PG8_SA(1, 0), cA + kstep, voffA); PG8_STAGE(PG8_SB(1, 1), cB + hstep + kstep, voffB);
        PG8_WAIT_V(6); PG8_BAR;
    } else {
        PG8_STAGE(PG8_SB(0, 0), cB, voffB); PG8_STAGE(PG8_SA(0, 0), cA, voffA); PG8_STAGE(PG8_SB(0, 1), cB + hstep, voffB); PG8_STAGE(PG8_SA(0, 1), cA + hstep, voffA);
        if (wr == 1) PG8_BAR;
        PG8_WAIT_V(4); PG8_BAR;
        PG8_STAGE(PG8_SB(1, 0), cB + kstep, voffB); PG8_STAGE(PG8_SA(1, 0), cA + kstep, voffA); PG8_STAGE(PG8_SB(1, 1), cB + hstep + kstep, voffB);
        PG8_WAIT_V(6); PG8_BAR;
    }
    for (;;) {
        const bool has_next = S.next(ui + 1, nxt);
        const char* nA = has_next ? (const char*)g.A + ((long)nxt.pm * g.a_step + g.a_off) * arow_bytes : cA; const char* nB = has_next ? (const char*)g.Bt + (size_t)nxt.pn * tstep : cB;
        for (int t = 0; t < nt; t += 2) {
            const bool last = (t == nt - 2);
            const char* a1 = cA + (size_t)(t + 1) * kstep;
            const char* a2 = last ? nA : cA + (size_t)(t + 2) * kstep; const char* b2 = last ? nB : cB + (size_t)(t + 2) * kstep;
            const char* a3 = a2 + kstep; const char* b3 = b2 + kstep;
            if (last && has_next) S.a_ready(nxt);
            if constexpr (SP2) {
            PG8_LDB(B0, 0, 0); PG8_LDB(B1, 0, 1); PG8_SCHED; PG8_LDA(At, 0, 0); PG8_STAGE(PG8_SA(1, 1), a1 + hstep, voffA);
            PG8_WAIT_V(8); PG8_WAIT_L(0); PG8_BAR; PG8_MMA(0, 0, At, B0); PG8_MMA(0, 1, At, B1); PG8_BAR; PG8_SCHED;
            PG8_LDA(At, 0, 1); PG8_STAGE(PG8_SB(0, 0), b2, voffB); PG8_STAGE(PG8_SB(0, 1), b2 + hstep, voffB); PG8_STAGE(PG8_SA(0, 0), a2, voffA);
            PG8_WAIT_V(8); PG8_WAIT_L(0); PG8_BAR; PG8_MMA(1, 0, At, B0); PG8_MMA(1, 1, At, B1); PG8_BAR; PG8_SCHED;
            PG8_LDB(B0, 1, 0); PG8_LDB(B1, 1, 1); PG8_SCHED; PG8_LDA(At, 1, 0); PG8_STAGE(PG8_SA(0, 1), a2 + hstep, voffA);
            PG8_WAIT_V(8); PG8_WAIT_L(0); PG8_BAR; PG8_MMA(0, 0, At, B0); PG8_MMA(0, 1, At, B1); PG8_BAR; PG8_SCHED;
            PG8_LDA(At, 1, 1); PG8_STAGE(PG8_SB(1, 0), b3, voffB); PG8_STAGE(PG8_SB(1, 1), b3 + hstep, voffB); PG8_STAGE(PG8_SA(1, 0), a3, voffA);
            PG8_WAIT_V(8); PG8_WAIT_L(0); PG8_BAR; PG8_MMA(1, 0, At, B0); PG8_MMA(1, 1, At, B1); PG8_BAR; PG8_SCHED;
            } else {
            PG8_LDB(B0, 0, 0); PG8_SCHED; PG8_LDA(At, 0, 0); PG8_STAGE(PG8_SA(1, 1), a1 + hstep, voffA);
            PG8_WAIT_L(8); PG8_BAR; PG8_WAIT_L(0); PG8_MMA(0, 0, At, B0); PG8_BAR; PG8_SCHED;
            PG8_LDB(B1, 0, 1); PG8_STAGE(PG8_SB(0, 0), b2, voffB);
            PG8_BAR; PG8_WAIT_L(0); PG8_MMA(0, 1, At, B1); PG8_BAR;
            PG8_LDA(At, 0, 1); PG8_STAGE(PG8_SA(0, 0), a2, voffA);
            PG8_BAR; PG8_WAIT_L(0); PG8_MMA(1, 0, At, B0); PG8_BAR; PG8_SCHED;
            PG8_STAGE(PG8_SB(0, 1), b2 + hstep, voffB);
            PG8_WAIT_V(6); PG8_BAR; PG8_MMA(1, 1, At, B1); PG8_BAR;
            PG8_LDB(B0, 1, 0); PG8_SCHED; PG8_LDA(At, 1, 0); PG8_STAGE(PG8_SA(0, 1), a2 + hstep, voffA);
            PG8_WAIT_L(8); PG8_BAR; PG8_WAIT_L(0); PG8_MMA(0, 0, At, B0); PG8_BAR; PG8_SCHED;
            PG8_LDB(B1, 1, 1); PG8_STAGE(PG8_SB(1, 0), b3, voffB);
            PG8_BAR; PG8_WAIT_L(0); PG8_MMA(0, 1, At, B1); PG8_BAR;
            PG8_LDA(At, 1, 1); PG8_STAGE(PG8_SA(1, 0), a3, voffA);
            PG8_BAR; PG8_WAIT_L(0); PG8_MMA(1, 0, At, B0); PG8_BAR; PG8_SCHED;
            PG8_STAGE(PG8_SB(1, 1), b3 + hstep, voffB);
            PG8_WAIT_V(6); PG8_BAR; PG8_MMA(1, 1, At, B1); PG8_BAR;
            }
        }
        if constexpr (ALIGN_EPI) { if (wr == 0) PG8_BAR; }
        if constexpr (!Epi::AFTER_DRAIN) { E(acc, cur, wr, wc, fr, fq); S.done(cur); }
#if defined(PROBE_MASK) && ((PROBE_MASK >> 11) & 1)
        if constexpr (!Epi::AFTER_DRAIN) { asm volatile("" ::: "memory"); E(acc, cur, wr, wc, fr, fq); }
#endif
        if (!has_next) break;
#pragma unroll
        for (int a = 0; a < 2; ++a)
#pragma unroll
            for (int b = 0; b < 2; ++b)
#pragma unroll
                for (int m = 0; m < 4; ++m)
#pragma unroll
                    for (int n = 0; n < 2; ++n) acc[a][b][m][n] = (f32x4){0.f, 0.f, 0.f, 0.f};
        cur = nxt; cA = nA; cB = nB; ++ui;
        if constexpr (ALIGN_EPI) { if (wr == 1) PG8_BAR; }
    }
    PG8_WAIT_V(0);
    if constexpr (!ALIGN_EPI) { if (wr == 0) PG8_BAR; }
    PG8_BAR;
    if constexpr (Epi::AFTER_DRAIN) { E.fused(acc, cur, wr, wc, fr, fq, lds, wid, lane); S.done(cur); }
#undef PG8_SA
#undef PG8_SB
#undef PG8_STAGE
#undef PG8_LDA
#undef PG8_LDB
#undef PG8_MMA
#undef PG8_WAIT_V
#undef PG8_WAIT_L
#undef PG8_BAR
#undef PG8_SCHED
}
}

namespace fp {
using namespace cfg;
constexpr int NW = 8, NTH = 512;
constexpr int RING_BYTES = 131072, MISC_OFF = RING_BYTES, LDS_BYTES = 147456;
constexpr size_t MiB = 1u << 20;
constexpr size_t WS_CTL = 0, CTL_BYTES = 1 * MiB;
constexpr size_t WS_WIN0 = 1 * MiB, WS_WIN1 = WS_WIN0 + 12 * MiB, WS_WIN2 = WS_WIN1 + 24 * MiB, WS_WIN3 = WS_WIN2 + 32 * MiB;
constexpr size_t WS_WOUT = WS_WIN3 + 17 * MiB, WOUT_STRIDE = 8 * MiB;
constexpr size_t WS_WUP = WS_WOUT + 32 * MiB, WUP_STRIDE = 44 * MiB;
constexpr size_t WS_WDN = WS_WUP + 176 * MiB, WDN_STRIDE = 22 * MiB;
constexpr size_t WS_H = WS_WDN + 88 * MiB;
constexpr size_t WS_ZU = WS_H + 32 * MiB;
constexpr size_t WS_O = WS_ZU + 176 * MiB;
constexpr size_t WS_MF = WS_O + 32 * MiB;
constexpr size_t WS_ACT = WS_MF + 64 * MiB;
constexpr size_t WS_MBITS = WS_ACT + 64 * MiB;
constexpr size_t WS_HUT = WS_ACT;
constexpr size_t WS_HDEC = WS_ACT + 64 * MiB;
constexpr size_t WS_KW = WS_MBITS + 2 * MiB;
constexpr int DSA_MAIN = 4096, KW_LD = 96;
constexpr size_t WS_X16 = WS_ACT + 88 * MiB;
constexpr size_t WS_FAST_END = WS_X16 + 32 * MiB;
static_assert(WS_WIN0 + (size_t)SWA_IN * D * 2 == WS_WIN1 && WS_WIN1 + (size_t)DIFF_IN * D * 2 == WS_WIN2 && WS_WIN2 + (size_t)HGRN_IN * D * 2 == WS_WIN3 && WS_WIN3 + (size_t)DSA_PAD * D * 2 == WS_WOUT, "weights map");
static_assert((size_t)NUP * D * 2 == WUP_STRIDE && (size_t)DFF * D * 2 == WDN_STRIDE && (size_t)M * NUP * 2 == 176 * MiB && (size_t)M * DFF * 2 == 88 * MiB, "map sizes");
constexpr size_t WS_RS = WS_CTL + 512 * 1024;
constexpr int CW_TMO = 0, CW_BAR = 4096, CW_CK = 16384;

#define LDS_BARRIER() do { asm volatile("s_waitcnt lgkmcnt(0)" ::: "memory"); __builtin_amdgcn_s_barrier(); asm volatile("" ::: "memory"); } while (0)
struct Params {
    const float* in[19];
    float* out;
    unsigned char* ws;
    int ph_lo, ph_hi;
};
struct Ctx {
    LAS unsigned char* lds;
    int tid, lane, wave, vcu, G;
};

template <int CTRL> __device__ __forceinline__ float dpp_f(float v) { return __builtin_bit_cast(float, __builtin_amdgcn_update_dpp(0, __builtin_bit_cast(int, v), CTRL, 0xf, 0xf, true)); }
template <int CTRL> __device__ __forceinline__ int dpp_i(int v) { return __builtin_amdgcn_update_dpp(0, v, CTRL, 0xf, 0xf, true); }
__device__ __forceinline__ float rsum16(float v) { v += dpp_f<0xB1>(v); v += dpp_f<0x4E>(v); v += dpp_f<0x141>(v); v += dpp_f<0x140>(v); return v; }
__device__ __forceinline__ int rsum16i(int v) { v += dpp_i<0xB1>(v); v += dpp_i<0x4E>(v); v += dpp_i<0x141>(v); v += dpp_i<0x140>(v); return v; }
__device__ __forceinline__ float wsum64(float v) {
    const int iv = __builtin_bit_cast(int, rsum16(v));
    return (__builtin_bit_cast(float, __builtin_amdgcn_readlane(iv, 0)) + __builtin_bit_cast(float, __builtin_amdgcn_readlane(iv, 16))) +
           (__builtin_bit_cast(float, __builtin_amdgcn_readlane(iv, 32)) + __builtin_bit_cast(float, __builtin_amdgcn_readlane(iv, 48)));
}
__device__ __forceinline__ int wsum64i(int v) { v = rsum16i(v); return (__builtin_amdgcn_readlane(v, 0) + __builtin_amdgcn_readlane(v, 16)) + (__builtin_amdgcn_readlane(v, 32) + __builtin_amdgcn_readlane(v, 48)); }
__device__ __forceinline__ float sum16(float v) { v += __shfl_xor(v, 1); v += __shfl_xor(v, 2); v += __shfl_xor(v, 4); v += __shfl_xor(v, 8); return v; }
__device__ __forceinline__ float max16(float v) { v = fmaxf(v, __shfl_xor(v, 1)); v = fmaxf(v, __shfl_xor(v, 2)); v = fmaxf(v, __shfl_xor(v, 4)); v = fmaxf(v, __shfl_xor(v, 8)); return v; }

template <bool MAPUP = false>
__device__ __forceinline__ void transpose_tile(const Ctx& c, const float* __restrict__ W, int K, int N, half_t* __restrict__ WT, int item, int ntn, const float* __restrict__ gk = nullptr) {
    const int kb = item / ntn, nb = item % ntn, k0 = 64 * kb, n0 = 256 * nb, lane = c.lane, w = c.wave;
    LAS half_t* T = (LAS half_t*)c.lds;
    const int n = n0 + 4 * lane;
    f32x4 v[8];
#pragma unroll
    for (int i = 0; i < 8; ++i) v[i] = (n < N) ? *(const f32x4*)(W + (size_t)(k0 + 8 * w + i) * N + n) : (f32x4){0.f, 0.f, 0.f, 0.f};
    if (gk) {
#pragma unroll
        for (int i = 0; i < 8; ++i) v[i] *= gk[k0 + 8 * w + i];
    }
#pragma unroll
    for (int e = 0; e < 4; ++e) { u32x4 o; o.x = pkh(v[0][e], v[1][e]); o.y = pkh(v[2][e], v[3][e]); o.z = pkh(v[4][e], v[5][e]); o.w = pkh(v[6][e], v[7][e]);
        *(LAS u32x4*)(T + (4 * lane + e) * 72 + 8 * w) = o; }
    LDS_BARRIER();
#pragma unroll
    for (int i = 0; i < 4; ++i) { const int id = c.tid + NTH * i, row = id >> 3, ch = id & 7;
        const u32x4 o = *(const LAS u32x4*)(T + row * 72 + 8 * ch);
        int drow = n0 + row;
        if (MAPUP) { const int nn = drow < DFF ? drow : drow - DFF; drow = 256 * (nn >> 7) + (nn & 127) + (drow < DFF ? 0 : 128); }
        *(u32x4*)(WT + (size_t)drow * K + k0 + 8 * ch) = o; }
    LDS_BARRIER();
}
__device__ __forceinline__ void norm_row_first(const float* __restrict__ xrow, half_t* __restrict__ xout, float* __restrict__ rs, int lane) {
    f32x4 v[8]; float ss = 0.f;
#pragma unroll
    for (int j = 0; j < 8; ++j) { v[j] = *(const f32x4*)(xrow + 4 * lane + 256 * j); ss += (v[j].x * v[j].x + v[j].y * v[j].y) + (v[j].z * v[j].z + v[j].w * v[j].w); }
    const float r = rsqrtf(wsum64(ss) * (1.f / D) + RMS_EPS);
    if (lane == 0) *rs = r;
#pragma unroll
    for (int j = 0; j < 8; ++j) { u32x2 xo; xo.x = pkh(v[j].x, v[j].y); xo.y = pkh(v[j].z, v[j].w); *(u32x2*)(xout + 4 * lane + 256 * j) = xo; }
}
constexpr int I_UP = 32 * (NUP / 256), I_DN = (DFF / 64) * (D / 256), FFN_TILES = I_UP + I_DN;
__device__ __forceinline__ void ffn_weight_tile(const Ctx& c, const Params& p, int l, int t) {
    unsigned char* ws = p.ws;
    if (t < I_UP) transpose_tile<true>(c, p.in[4] + (size_t)l * D * NUP, D, NUP, (half_t*)(ws + WS_WUP + l * WUP_STRIDE), t, NUP / 256, p.in[3] + (size_t)(4 * l + 2) * D);
    else transpose_tile(c, p.in[6] + (size_t)l * DFF * D, DFF, D, (half_t*)(ws + WS_WDN + l * WDN_STRIDE), t - I_UP, D / 256);
}
constexpr int DEFER_PER_WG = 10, DEFER_G1 = 128 * DEFER_PER_WG, DEFER_G3 = 84 * DEFER_PER_WG;
static_assert(DEFER_G1 + DEFER_G3 >= FFN_TILES, "layer 1's FFN weights fit the two spare slots");
__device__ __forceinline__ void spare_slot_convert(const Ctx& c, const Params& p, int l, int first, int last, int rank) {
    for (int i = 0; i < DEFER_PER_WG; ++i) { const int t = first + rank * DEFER_PER_WG + i; if (t < last) ffn_weight_tile(c, p, l, t); }
}
__device__ __forceinline__ void prologue_phase(const Ctx& c, const Params& p) {
    const int gw = c.vcu * NW + c.wave, NGW = c.G * NW;
    unsigned char* ws = p.ws;
    constexpr int I_W0 = 32 * (SWA_IN / 256), I_W1 = 32 * (DIFF_IN / 256), I_W2 = 32 * (HGRN_IN / 256), I_W3 = 32 * (DSA_PAD / 256), I_WO = 32 * (D / 256);
    constexpr int I_F23 = FFN_TILES - DEFER_G3;
    constexpr int NITEMS = I_W0 + I_W1 + I_W2 + I_W3 + 4 * I_WO + FFN_TILES + 2 * I_F23;
    const bool defer = (c.G == 256);
    const int nitems = defer ? NITEMS : NITEMS + FFN_TILES + 2 * DEFER_G3;
    for (int it = c.vcu; it < nitems; it += c.G) {
        int r = it;
        if (r < I_W0) { transpose_tile(c, p.in[7], D, SWA_IN, (half_t*)(ws + WS_WIN0), r, SWA_IN / 256, p.in[3]); continue; } r -= I_W0;
        if (r < I_W1) { transpose_tile(c, p.in[10], D, DIFF_IN, (half_t*)(ws + WS_WIN1), r, DIFF_IN / 256, p.in[3] + 4 * D); continue; } r -= I_W1;
        if (r < I_W2) { transpose_tile(c, p.in[14], D, HGRN_IN, (half_t*)(ws + WS_WIN2), r, HGRN_IN / 256, p.in[3] + 8 * D); continue; } r -= I_W2;
        if (r < I_W3) { transpose_tile(c, p.in[17], D, DSA_IN, (half_t*)(ws + WS_WIN3), r, DSA_PAD / 256, p.in[3] + 12 * D); continue; } r -= I_W3;
        if (r < 4 * I_WO) { const int l = r / I_WO; r -= l * I_WO; const float* src = l == 0 ? p.in[8] : l == 1 ? p.in[11] : l == 2 ? p.in[15] : p.in[18];
            transpose_tile(c, src, D, D, (half_t*)(ws + WS_WOUT + l * WOUT_STRIDE), r, D / 256); continue; } r -= 4 * I_WO;
        if (r < FFN_TILES) { ffn_weight_tile(c, p, 0, r); continue; } r -= FFN_TILES;
        if (r < I_F23) { ffn_weight_tile(c, p, 2, DEFER_G3 + r); continue; } r -= I_F23;
        if (r < I_F23) { ffn_weight_tile(c, p, 3, DEFER_G3 + r); continue; } r -= I_F23;
        if (r < FFN_TILES) { ffn_weight_tile(c, p, 1, r); continue; } r -= FFN_TILES;
        if (r < DEFER_G3) { ffn_weight_tile(c, p, 2, r); continue; } r -= DEFER_G3;
        ffn_weight_tile(c, p, 3, r);
    }
    const float* x = p.in[0];
    for (int m = gw; m < M; m += NGW) norm_row_first(x + (size_t)m * D, (half_t*)(ws + WS_X16) + (size_t)m * D, (float*)(ws + WS_RS) + m, c.lane);
}

__device__ __forceinline__ void resnorm_phase(const Ctx& c, half_t* __restrict__ X, const half_t* __restrict__ MF, const float* __restrict__ g1, float* __restrict__ RS, float* __restrict__ out32) {
    const int gw = c.vcu * NW + c.wave, NGW = c.G * NW, lane = c.lane;
    for (int m = gw; m < M; m += NGW) {
        const half_t* mf = MF + (size_t)m * D; half_t* xr = X + (size_t)m * D;
        f32x4 v[8]; h16x4 xh[8]; float ss = 0.f;
#pragma unroll
        for (int j = 0; j < 8; ++j) { const h16x4 hv = *(const h16x4*)(mf + 4 * lane + 256 * j); xh[j] = *(const h16x4*)(xr + 4 * lane + 256 * j); v[j] = (f32x4){(float)hv[0], (float)hv[1], (float)hv[2], (float)hv[3]};
            ss += (v[j].x * v[j].x + v[j].y * v[j].y) + (v[j].z * v[j].z + v[j].w * v[j].w); }
        const float r1 = rsqrtf(wsum64(ss) * (1.f / D) + RMS_EPS);
        float s2 = 0.f;
#pragma unroll
        for (int j = 0; j < 8; ++j) { const f32x4 gg = *(const f32x4*)(g1 + 4 * lane + 256 * j); const f32x4 xx = (f32x4){(float)xh[j][0], (float)xh[j][1], (float)xh[j][2], (float)xh[j][3]};
            v[j] = xx + v[j] * r1 * gg; s2 += (v[j].x * v[j].x + v[j].y * v[j].y) + (v[j].z * v[j].z + v[j].w * v[j].w);
            if (out32) *(f32x4*)(out32 + (size_t)m * D + 4 * lane + 256 * j) = v[j];
            else { u32x2 xo; xo.x = pkh(v[j].x, v[j].y); xo.y = pkh(v[j].z, v[j].w); *(u32x2*)(xr + 4 * lane + 256 * j) = xo; } }
        if (RS) { const float r2 = rsqrtf(wsum64(s2) * (1.f / D) + RMS_EPS); if (lane == 0) RS[m] = r2; }
    }
}
__device__ __forceinline__ void convact_phase(const Ctx& c, const half_t* __restrict__ U, const float* __restrict__ cw, half_t* __restrict__ ACT) {
    const int gw = c.vcu * NW + c.wave, NGW = c.G * NW, lane = c.lane;
    constexpr int NCC = DFF / 512, NRB = M / 16;
    for (int it = gw; it < NCC * NRB; it += NGW) {
        const int cc = it % NCC, rb = it / NCC, c0 = cc * 512 + lane * 8, r0 = rb * 16, t0 = r0 % S;
        float wg[3][8], wv[3][8];
#pragma unroll
        for (int j = 0; j < 3; ++j) {
            const f32x4 a0 = *(const f32x4*)(cw + j * NUP + c0), a1 = *(const f32x4*)(cw + j * NUP + c0 + 4);
            const f32x4 b0 = *(const f32x4*)(cw + j * NUP + DFF + c0), b1 = *(const f32x4*)(cw + j * NUP + DFF + c0 + 4);
#pragma unroll
            for (int e = 0; e < 4; ++e) { wg[j][e] = a0[e]; wg[j][4 + e] = a1[e]; wv[j][e] = b0[e]; wv[j][4 + e] = b1[e]; }
        }
        float g2[8], g1[8], v2[8], v1[8];
        if (t0 == 0) {
#pragma unroll
            for (int e = 0; e < 8; ++e) { g2[e] = 0.f; g1[e] = 0.f; v2[e] = 0.f; v1[e] = 0.f; }
        } else {
            const h16x8 a = *(const h16x8*)(U + (size_t)(r0 - 2) * NUP + c0), b = *(const h16x8*)(U + (size_t)(r0 - 1) * NUP + c0);
            const h16x8 cgv = *(const h16x8*)(U + (size_t)(r0 - 2) * NUP + DFF + c0), d = *(const h16x8*)(U + (size_t)(r0 - 1) * NUP + DFF + c0);
#pragma unroll
            for (int e = 0; e < 8; ++e) { g2[e] = (float)a[e]; g1[e] = (float)b[e]; v2[e] = (float)cgv[e]; v1[e] = (float)d[e]; }
        }
        for (int r = r0; r < r0 + 16; ++r) {
            const h16x8 gc = *(const h16x8*)(U + (size_t)r * NUP + c0), vc = *(const h16x8*)(U + (size_t)r * NUP + DFF + c0);
            float o[8];
#pragma unroll
            for (int e = 0; e < 8; ++e) {
                const float gcur = (float)gc[e], vcur = (float)vc[e];
                const float gg = wg[0][e] * g2[e] + wg[1][e] * g1[e] + wg[2][e] * gcur;
                const float vv = wv[0][e] * v2[e] + wv[1][e] * v1[e] + wv[2][e] * vcur;
                o[e] = gg * fsigm(gg) * vv;
                g2[e] = g1[e]; g1[e] = gcur; v2[e] = v1[e]; v1[e] = vcur;
            }
            u32x4 w; w.x = pkh(o[0], o[1]); w.y = pkh(o[2], o[3]); w.z = pkh(o[4], o[5]); w.w = pkh(o[6], o[7]);
            *(u32x4*)(ACT + (size_t)r * DFF + c0) = w;
        }
    }
}
__device__ __forceinline__ void hgrn_normgate_phase(const Ctx& c, const float* __restrict__ OR, const half_t* __restrict__ Z, const float* __restrict__ ng, half_t* __restrict__ O) {
    const int gw = c.vcu * NW + c.wave, NGW = c.G * NW, lane = c.lane;
    const f32x4 gn = *(const f32x4*)(ng + ((4 * lane) & 127));
    for (int m = gw; m < M; m += NGW) {
        const float* orow = OR + (size_t)m * D; const half_t* grow = Z + (size_t)m * HGRN_IN + 6144; half_t* out = O + (size_t)m * D;
        f32x4 v[8]; h16x4 gt[8];
#pragma unroll
        for (int j = 0; j < 8; ++j) { v[j] = *(const f32x4*)(orow + 4 * lane + 256 * j); gt[j] = *(const h16x4*)(grow + 4 * lane + 256 * j); }
#pragma unroll
        for (int j = 0; j < 8; ++j) {
            const int col = 4 * lane + 256 * j;
            float ss = (v[j].x * v[j].x + v[j].y * v[j].y) + (v[j].z * v[j].z + v[j].w * v[j].w);
            ss = rsum16(ss); ss += __shfl_xor(ss, 16);
            const float r = rsqrtf(ss * (1.f / 128.f) + RMS_EPS);
            float o[4];
#pragma unroll
            for (int e = 0; e < 4; ++e) { const float gv = (float)gt[j][e]; o[e] = v[j][e] * r * gn[e] * (gv * fsigm(gv)); }
            u32x2 w; w.x = pkh(o[0], o[1]); w.y = pkh(o[2], o[3]);
            *(u32x2*)(out + col) = w;
        }
    }
}

typedef float f32x16 __attribute__((ext_vector_type(16)));
#define MFMA32(a, b, c) __builtin_amdgcn_mfma_f32_32x32x16_f16((a), (b), (c), 0, 0, 0)
constexpr float LOG2E = 1.4426950408889634f, C2 = 0.125f * LOG2E, ATT_THR = 8.0f, NEGBIG = -1e30f;
__device__ __forceinline__ int crow(int r, int hi) { return (r & 3) + 8 * (r >> 2) + 4 * hi; }
__device__ __forceinline__ float xhalf_max(float m) { auto rr = __builtin_amdgcn_permlane32_swap(__float_as_uint(m), __float_as_uint(m), false, false); return fmaxf(__uint_as_float(rr[0]), __uint_as_float(rr[1])); }
__device__ __forceinline__ float xhalf_sum(float m) { auto rr = __builtin_amdgcn_permlane32_swap(__float_as_uint(m), __float_as_uint(m), false, false); return __uint_as_float(rr[0]) + __uint_as_float(rr[1]); }

typedef short v4i16_t __attribute__((ext_vector_type(4)));
template <int NDB, bool NEAR, int AM, bool SWZ = false>
__device__ __forceinline__ void attn_tile(const LAS half_t* Kt, const LAS half_t* Vr, const h16x8 (&qf)[4], float& mhat, float& lsum, f32x16 (&o)[NDB],
                                          LAS float* wsf, const LAS float* bd2, int qrel, unsigned mw0, unsigned mw1, int r32, int hi, bool start) {
    f32x16 pp[2];
    constexpr bool UPFRONT = (NDB == 2);
    if (UPFRONT) {
        const int KRS = SWZ ? 64 : 72, sw = SWZ ? ((r32 >> 1) & 7) : 0;
        const LAS half_t* kp = Kt + r32 * KRS;
        const f32x16 z = {0.f, 0.f, 0.f, 0.f, 0.f, 0.f, 0.f, 0.f, 0.f, 0.f, 0.f, 0.f, 0.f, 0.f, 0.f, 0.f};
        pp[0] = MFMA32(*(const LAS h16x8*)(kp + ((hi ^ sw) * 8)), qf[0], z); pp[1] = MFMA32(*(const LAS h16x8*)(kp + 32 * KRS + ((hi ^ sw) * 8)), qf[0], z);
#pragma unroll
        for (int ks = 1; ks < 4; ++ks) { pp[0] = MFMA32(*(const LAS h16x8*)(kp + (((2 * ks + hi) ^ sw) * 8)), qf[ks], pp[0]); pp[1] = MFMA32(*(const LAS h16x8*)(kp + 32 * KRS + (((2 * ks + hi) ^ sw) * 8)), qf[ks], pp[1]); }
#if defined(PROBE_MASK) && ((PROBE_MASK >> 13) & 1)
        { f32x16 t0 = z, t1 = z;
#pragma unroll
          for (int ks = 0; ks < 4; ++ks) { t0 = MFMA32(*(const LAS h16x8*)(kp + 16 * ks), qf[ks], t0); t1 = MFMA32(*(const LAS h16x8*)(kp + 32 * 72 + 16 * ks), qf[ks], t1); }
#pragma unroll
          for (int r = 0; r < 16; ++r) { pp[0][r] = 0.5f * (pp[0][r] + t0[r]); pp[1][r] = 0.5f * (pp[1][r] + t1[r]); } }
#endif
    }
#pragma unroll
    for (int blk = 0; blk < 2; ++blk) {
        f32x16 p;
        if (UPFRONT) p = pp[blk];
        else if (!SWZ) {
            const LAS half_t* kp = Kt + (32 * blk + r32) * 72 + 8 * hi;
            const f32x16 z = {0.f, 0.f, 0.f, 0.f, 0.f, 0.f, 0.f, 0.f, 0.f, 0.f, 0.f, 0.f, 0.f, 0.f, 0.f, 0.f};
            p = MFMA32(*(const LAS h16x8*)(kp), qf[0], z);
#pragma unroll
            for (int ks = 1; ks < 4; ++ks) p = MFMA32(*(const LAS h16x8*)(kp + 16 * ks), qf[ks], p);
        } else {
            const LAS half_t* kp = Kt + (32 * blk + r32) * 64; const int sw = (r32 >> 1) & 7;
            const f32x16 z = {0.f, 0.f, 0.f, 0.f, 0.f, 0.f, 0.f, 0.f, 0.f, 0.f, 0.f, 0.f, 0.f, 0.f, 0.f, 0.f};
            p = MFMA32(*(const LAS h16x8*)(kp + ((hi ^ sw) * 8)), qf[0], z);
#pragma unroll
            for (int ks = 1; ks < 4; ++ks) p = MFMA32(*(const LAS h16x8*)(kp + (((2 * ks + hi) ^ sw) * 8)), qf[ks], p);
        }
#pragma unroll
        for (int r = 0; r < 16; ++r) p[r] = fmaf(p[r], C2, -mhat);
        if (NEAR) {
#pragma unroll
            for (int r = 0; r < 16; ++r) {
                const int d0 = qrel - 32 * blk - ((r & 3) + 8 * (r >> 2));
                const int i0 = d0 < 0 ? 0 : (d0 > 128 ? 128 : d0);
                const bool ok0 = (AM == 0) ? (d0 >= 0 && d0 < 128) : (d0 >= 0);
                p[r] = ok0 ? p[r] + bd2[i0] : NEGBIG;
                if (NDB > 2 && (r & 7) == 7) asm volatile("" ::: "memory");
            }
        }
        if (AM == 1) {
            const unsigned ws = (blk == 0 ? mw0 : mw1) >> (4 * hi);
#pragma unroll
            for (int r = 0; r < 16; ++r) { const unsigned bit = 1u << ((r & 3) + 8 * (r >> 2)); p[r] = (ws & bit) ? p[r] : NEGBIG; }
        }
        float rm;
        { const float a0 = fmaxf(fmaxf(p[0], p[1]), fmaxf(p[2], p[3])), a1 = fmaxf(fmaxf(p[4], p[5]), fmaxf(p[6], p[7])), a2 = fmaxf(fmaxf(p[8], p[9]), fmaxf(p[10], p[11])), a3 = fmaxf(fmaxf(p[12], p[13]), fmaxf(p[14], p[15]));
          rm = fmaxf(fmaxf(a0, a1), fmaxf(a2, a3)); }
        rm = xhalf_max(rm);
        if (start && blk == 0) {
            const float dl = (rm > -1e29f) ? rm : 0.f; mhat += dl;
#pragma unroll
            for (int r = 0; r < 16; ++r) p[r] -= dl;
        } else if (__any(rm > ATT_THR)) {
            const float dl = (rm > ATT_THR) ? rm : 0.f; mhat += dl;
#pragma unroll
            for (int r = 0; r < 16; ++r) p[r] -= dl;
            const float f = fexp2(-dl); lsum *= f;
            if (hi == 0) wsf[r32] = f;
#pragma unroll
            for (int r = 0; r < 16; ++r) { const float fr_ = wsf[crow(r, hi)];
#pragma unroll
                for (int d = 0; d < NDB; ++d) o[d][r] *= fr_;
                if (NDB > 2 && (r & 3) == 3) asm volatile("" ::: "memory"); }
        }
#if defined(PROBE_MASK) && ((PROBE_MASK >> 14) & 1)
#pragma unroll
        for (int r = 0; r < 16; ++r) { float t_ = fexp2(p[r] - 40.f); asm volatile("" : "+v"(t_)); p[r] += t_ * 1e-30f; }
#endif
#pragma unroll
        for (int r = 0; r < 16; ++r) p[r] = fexp2(p[r]);
        lsum += ((p[0] + p[1]) + (p[2] + p[3])) + ((p[4] + p[5]) + (p[6] + p[7])) + (((p[8] + p[9]) + (p[10] + p[11])) + ((p[12] + p[13]) + (p[14] + p[15])));
        u32x4 pw[2];
        pw[0] = (u32x4){pkh(p[0], p[1]), pkh(p[2], p[3]), pkh(p[4], p[5]), pkh(p[6], p[7])};
        pw[1] = (u32x4){pkh(p[8], p[9]), pkh(p[10], p[11]), pkh(p[12], p[13]), pkh(p[14], p[15])};
        constexpr int VSTR = SWZ ? 32 * NDB : 32 * NDB + 32;
        const int j4 = (r32 & 15) >> 2, vsw = (NDB == 4) ? j4 : (j4 >> 1);
        const LAS half_t* vb = SWZ ? Vr + (32 * blk + 4 * hi + j4) * VSTR + 4 * (r32 & 1)
                                   : Vr + (32 * blk + 4 * hi + j4) * VSTR + 16 * (r32 >> 4) + 4 * (r32 & 3);
#pragma unroll
        for (int d = 0; d < NDB; ++d) {
            const int vco = SWZ ? ((((d ^ vsw) << 2) | (2 * (r32 >> 4)) | ((r32 & 3) >> 1)) * 8) : 32 * d;
#pragma unroll
            for (int s2 = 0; s2 < 2; ++s2) {
                const v4i16_t lo = __builtin_amdgcn_ds_read_tr16_b64_v4i16((LAS v4i16_t*)(vb + (16 * s2) * VSTR + vco));
                const v4i16_t hi2 = __builtin_amdgcn_ds_read_tr16_b64_v4i16((LAS v4i16_t*)(vb + (16 * s2 + 8) * VSTR + vco));
                typedef short s16x8 __attribute__((ext_vector_type(8)));
                const s16x8 vv = (s16x8){lo[0], lo[1], lo[2], lo[3], hi2[0], hi2[1], hi2[2], hi2[3]};
                o[d] = MFMA32(__builtin_bit_cast(h16x8, pw[s2]), __builtin_bit_cast(h16x8, vv), o[d]);
            }
            if (NDB > 2 && (d & 1)) asm volatile("" ::: "memory");
        }
    }
}

template <int AM>
__device__ __forceinline__ void gqa_phase(const Ctx& c, const half_t* __restrict__ Z, int ldz, int koff, int voff, const float* __restrict__ bias, const float* __restrict__ sinks,
                                          const unsigned* __restrict__ mbits, half_t* __restrict__ O) {
    const int tid = c.tid, lane = c.lane, w = c.wave, r32 = lane & 31, hi = lane >> 5;
    constexpr int VS = 96;
    LAS half_t* Kb = (LAS half_t*)c.lds;
    LAS half_t* Vb = Kb + 2 * 64 * 72;
    constexpr int GQA_TILE_BYTES = (2 * 64 * 72 + 2 * 64 * VS) * 2;
    LAS float* wsf = (LAS float*)(c.lds + GQA_TILE_BYTES) + w * 64;
    LAS float* btab = (LAS float*)(c.lds + GQA_TILE_BYTES + 8 * 64 * 4);
    for (int i = tid; i < 32 * 129; i += NTH) { const int h = i / 129, d = i % 129; const int bk = d < 128 ? (int)BUCKET_LUT[d] : 31; btab[h * 132 + d] = (bias[bk * 32 + h] - bias[31 * 32 + h]) * LOG2E; }
    const int skey = tid >> 3, sch = tid & 7;
    for (int U = c.vcu; U < 1024; U += c.G) {
        const int grp = U & 255, ui = U >> 8, bkv = grp >> 3, sx = grp & 7;
        const int qb = (ui == 0) ? sx : (ui == 1) ? 15 - sx : (ui == 2) ? 16 + sx : 31 - sx;
        const int b = bkv >> 3, kvh = bkv & 7, h = kvh * 4 + (w >> 1);
        const int qw0 = qb * 64 + 32 * (w & 1), q = qw0 + r32;
        const size_t rowbase = (size_t)b * S;
        h16x8 qf[4];
#pragma unroll
        for (int ks = 0; ks < 4; ++ks) qf[ks] = *(const h16x8*)(Z + (rowbase + q) * ldz + h * 64 + 16 * ks + 8 * hi);
        float mhat = 0.f, lsum = 0.f;
        if (AM == 0) { mhat = (sinks[h] - bias[31 * 32 + h]) * LOG2E; lsum = (hi == 0) ? 1.f : 0.f; }
        f32x16 o[2];
#pragma unroll
        for (int d = 0; d < 2; ++d)
#pragma unroll
            for (int r = 0; r < 16; ++r) o[d][r] = 0.f;
        const int kt_lo = (AM == 0) ? (qb >= 2 ? qb - 2 : 0) : 0;
        const LAS float* bt = btab + h * 132;
        const half_t* sbase = Z + (rowbase + skey) * ldz + kvh * 64 + sch * 8;
        const unsigned* mrow = mbits + (rowbase + q) * 64;
        u32x4 kreg = *(const u32x4*)(sbase + (size_t)(64 * kt_lo) * ldz + koff);
        h16x8 vreg = *(const h16x8*)(sbase + (size_t)(64 * kt_lo) * ldz + voff);
        u32x2 mnext = (u32x2){0xffffffffu, 0xffffffffu};
        if (AM == 1) mnext = *(const u32x2*)(mrow + 2 * kt_lo);
        LDS_BARRIER();
        {
            *(LAS u32x4*)(Kb + skey * 72 + sch * 8) = kreg;
            *(LAS h16x8*)(Vb + skey * VS + sch * 8) = vreg;
        }
        if (kt_lo < qb) { kreg = *(const u32x4*)(sbase + (size_t)(64 * (kt_lo + 1)) * ldz + koff); vreg = *(const h16x8*)(sbase + (size_t)(64 * (kt_lo + 1)) * ldz + voff); }
        LDS_BARRIER();
        for (int kt = kt_lo; kt <= qb; ++kt) {
            const int cur = (kt - kt_lo) & 1;
            const u32x2 mcur = mnext;
            if (kt < qb) {
                LAS half_t* Kn = Kb + (cur ^ 1) * (64 * 72); LAS half_t* Vn = Vb + (cur ^ 1) * (64 * VS);
                *(LAS u32x4*)(Kn + skey * 72 + sch * 8) = kreg;
                *(LAS h16x8*)(Vn + skey * VS + sch * 8) = vreg;
                if (AM == 1) mnext = *(const u32x2*)(mrow + 2 * (kt + 1));
                if (kt + 1 < qb) { kreg = *(const u32x4*)(sbase + (size_t)(64 * (kt + 2)) * ldz + koff); vreg = *(const h16x8*)(sbase + (size_t)(64 * (kt + 2)) * ldz + voff); }
            }
            const LAS half_t* Kt = Kb + cur * (64 * 72); const LAS half_t* Vt = Vb + cur * (64 * VS);
            const int qrel = q - 64 * kt - 4 * hi;
            const bool start = (AM == 1) && (kt == kt_lo);
            const bool near = (AM == 0) || (64 * kt + 191 > qw0);
            if (near) attn_tile<2, true, AM>(Kt, Vt, qf, mhat, lsum, o, wsf, bt, qrel, mcur.x, mcur.y, r32, hi, start);
            else attn_tile<2, false, AM>(Kt, Vt, qf, mhat, lsum, o, wsf, bt, qrel, mcur.x, mcur.y, r32, hi, start);
            LDS_BARRIER();
#if defined(PROBE_MASK) && ((PROBE_MASK >> 12) & 1)
            LDS_BARRIER(); LDS_BARRIER();
#endif
        }
        {
            const float lt = xhalf_sum(lsum);
            if (hi == 0) wsf[r32] = 1.f / lt;
            float inv[16];
#pragma unroll
            for (int r = 0; r < 16; ++r) inv[r] = wsf[crow(r, hi)];
#pragma unroll
            for (int r = 0; r < 16; ++r) {
                half_t* op = O + (rowbase + qw0 + crow(r, hi)) * D + h * 64 + r32;
                op[0] = (half_t)(o[0][r] * inv[r]); op[32] = (half_t)(o[1][r] * inv[r]);
            }
        }
    }
    LDS_BARRIER();
}

__device__ __forceinline__ void diff_phase(const Ctx& c, const half_t* __restrict__ Z, const float* __restrict__ bias, const float* __restrict__ lambdas, const float* __restrict__ subg,
                                           float lam_init, half_t* __restrict__ O) {
    const int tid = c.tid, lane = c.lane, w = c.wave, r32 = lane & 31, hi = lane >> 5;
    constexpr int ldz = DIFF_IN;
    constexpr int KIMG = 64 * 64, VIMG = 64 * 128, BUF_H = 2 * KIMG + VIMG;
    LAS half_t* ring = (LAS half_t*)c.lds;
    constexpr int TILE_BYTES = 3 * BUF_H * 2;
    LAS float* cb = (LAS float*)c.lds;
    static_assert(128 * 132 * 4 <= TILE_BYTES, "combine buffer");
    LAS float* wsf = (LAS float*)(c.lds + TILE_BYTES) + w * 64;
    LAS float* btab = (LAS float*)(c.lds + TILE_BYTES + 8 * 64 * 4);
    static_assert(TILE_BYTES + 8 * 64 * 4 + 32 * 132 * 4 <= RING_BYTES, "diff LDS");
    for (int i = tid; i < 32 * 129; i += NTH) { const int h = i / 129, d = i % 129; const int bk = d < 128 ? (int)BUCKET_LUT[d] : 31; btab[h * 132 + d] = (bias[bk * 32 + h] - bias[31 * 32 + h]) * LOG2E; }
    float lam;
    { float l1 = lambdas[lane] * lambdas[64 + lane], l2 = lambdas[128 + lane] * lambdas[192 + lane]; l1 = wsum64(l1); l2 = wsum64(l2); lam = expf(l1) - expf(l2) + lam_init; }
    const int mp = w & 1, rg = w >> 1;
    const int kkey = 8 * w + (lane >> 3), kch = (lane & 7) ^ ((kkey >> 1) & 7);
    const int vkey0 = 8 * w + (lane >> 4), vkey1 = vkey0 + 4, vch0 = (lane & 15) ^ (4 * (vkey0 & 3)), vch1 = (lane & 15) ^ (4 * (vkey1 & 3));
    for (int U = c.vcu; U < 1024; U += c.G) {
        const int grp = U & 255, ui = U >> 8, bh = grp >> 2, sx = grp & 3;
        const int qb = (ui == 0) ? sx : (ui == 1) ? 7 - sx : (ui == 2) ? 8 + sx : 15 - sx;
        const int b = bh >> 4, hd = bh & 15;
        const int qw0 = qb * 128 + 32 * rg, q = qw0 + r32;
        const size_t rowbase = (size_t)b * S;
        h16x8 qf[4];
#pragma unroll
        for (int ks = 0; ks < 4; ++ks) qf[ks] = *(const h16x8*)(Z + (rowbase + q) * ldz + hd * 128 + mp * 64 + 16 * ks + 8 * hi);
        float mhat = 0.f, lsum = 0.f;
        f32x16 o[4];
#pragma unroll
        for (int d = 0; d < 4; ++d)
#pragma unroll
            for (int r = 0; r < 16; ++r) o[d][r] = 0.f;
        const LAS float* bt = btab + (hd * 2 + mp) * 132;
        const int kt_hi = 2 * qb + 1;
        const half_t* gk = Z + (rowbase + kkey) * ldz + 2048 + hd * 128 + kch * 8;
        const half_t* gv0 = Z + (rowbase + vkey0) * ldz + 4096 + hd * 128 + vch0 * 8;
        const half_t* gv1 = Z + (rowbase + vkey1) * ldz + 4096 + hd * 128 + vch1 * 8;
#define DIFF_DMA(t, si) do { const size_t adv = (size_t)(64 * (t)) * ldz; LAS half_t* slot = ring + (si) * BUF_H; \
            __builtin_amdgcn_global_load_lds((const unsigned*)(gk + adv), (LAS unsigned*)(slot + w * 512), 16, 0, 0); \
            __builtin_amdgcn_global_load_lds((const unsigned*)(gk + adv + 64), (LAS unsigned*)(slot + KIMG + w * 512), 16, 0, 0); \
            __builtin_amdgcn_global_load_lds((const unsigned*)(gv0 + adv), (LAS unsigned*)(slot + 2 * KIMG + w * 1024), 16, 0, 0); \
            __builtin_amdgcn_global_load_lds((const unsigned*)(gv1 + adv), (LAS unsigned*)(slot + 2 * KIMG + w * 1024 + 512), 16, 0, 0); } while (0)
        LDS_BARRIER();
        DIFF_DMA(0, 0);
        DIFF_DMA(1, 1);
        asm volatile("s_waitcnt vmcnt(4)" ::: "memory");
        LDS_BARRIER();
        int s_cur = 0, s_nn = 2;
#pragma unroll 1
        for (int kt = 0; kt <= kt_hi; ++kt) {
            if (kt + 2 <= kt_hi) DIFF_DMA(kt + 2, s_nn);
            if (64 * kt <= qw0 + 31) {
                const LAS half_t* slot = ring + s_cur * BUF_H;
                const LAS half_t* Kt = slot + mp * KIMG; const LAS half_t* Vt = slot + 2 * KIMG;
                const int qrel = q - 64 * kt - 4 * hi;
                if (64 * kt + 191 > qw0) attn_tile<4, true, 2, true>(Kt, Vt, qf, mhat, lsum, o, wsf, bt, qrel, 0u, 0u, r32, hi, kt == 0);
                else attn_tile<4, false, 2, true>(Kt, Vt, qf, mhat, lsum, o, wsf, bt, qrel, 0u, 0u, r32, hi, kt == 0);
            }
            if (kt + 2 <= kt_hi) asm volatile("s_waitcnt vmcnt(4)" ::: "memory"); else asm volatile("s_waitcnt vmcnt(0)" ::: "memory");
            LDS_BARRIER();
            s_cur = (s_cur == 2) ? 0 : s_cur + 1; s_nn = (s_nn == 2) ? 0 : s_nn + 1;
        }
#undef DIFF_DMA
        {
            const float lt = xhalf_sum(lsum);
            if (hi == 0) wsf[r32] = 1.f / lt;
            float inv[16];
#pragma unroll
            for (int r = 0; r < 16; ++r) inv[r] = wsf[crow(r, hi)];
            if (mp == 1) {
#pragma unroll
                for (int d = 0; d < 4; ++d)
#pragma unroll
                    for (int r = 0; r < 16; ++r) cb[(32 * rg + crow(r, hi)) * 132 + 32 * d + r32] = o[d][r] * inv[r];
            }
            LDS_BARRIER();
            if (mp == 0) {
#pragma unroll
                for (int d = 0; d < 4; ++d)
#pragma unroll
                    for (int r = 0; r < 16; ++r) { LAS float* pc = cb + (32 * rg + crow(r, hi)) * 132 + 32 * d + r32; *pc = o[d][r] * inv[r] - lam * (*pc); }
            }
            LDS_BARRIER();
            const int qq = tid >> 2, q4 = tid & 3;
            f32x4 v[8]; float ss = 0.f;
#pragma unroll
            for (int i = 0; i < 8; ++i) { v[i] = *(const LAS f32x4*)(cb + qq * 132 + 32 * q4 + 4 * i); ss += (v[i].x * v[i].x + v[i].y * v[i].y) + (v[i].z * v[i].z + v[i].w * v[i].w); }
            ss += dpp_f<0xB1>(ss); ss += dpp_f<0x4E>(ss);
            const float rn = rsqrtf(ss * (1.f / 128.f) + RMS_EPS) * (1.f - lam_init);
            half_t* op = O + (rowbase + qb * 128 + qq) * D + hd * 128 + 32 * q4;
#pragma unroll
            for (int i = 0; i < 4; ++i) {
                const f32x4 g0 = *(const f32x4*)(subg + 32 * q4 + 8 * i), g1 = *(const f32x4*)(subg + 32 * q4 + 8 * i + 4);
                const f32x4 a = v[2 * i] * rn * g0, bq = v[2 * i + 1] * rn * g1;
                u32x4 wv; wv.x = pkh(a.x, a.y); wv.y = pkh(a.z, a.w); wv.z = pkh(bq.x, bq.y); wv.w = pkh(bq.z, bq.w);
                *(u32x4*)(op + 8 * i) = wv;
            }
        }
    }
    LDS_BARRIER();
}

__device__ __forceinline__ void dsa_kiwi_phase(const Ctx& c, const half_t* __restrict__ H, const float* __restrict__ RS, const half_t* __restrict__ W3, half_t* __restrict__ KW) {
    const int tid = c.tid, lane = c.lane, w = c.wave, fr = lane & 15, fq = lane >> 4;
    LAS float* red = (LAS float*)c.lds;
    for (int it = c.vcu; it < M / 32; it += c.G) {
        const int row0 = 32 * it;
        f32x4 acc[2][5];
#pragma unroll
        for (int mt = 0; mt < 2; ++mt)
#pragma unroll
            for (int nt = 0; nt < 5; ++nt) acc[mt][nt] = (f32x4){0.f, 0.f, 0.f, 0.f};
#pragma unroll 2
        for (int ks = 8 * w; ks < 8 * w + 8; ++ks) {
            h16x8 a[2];
#pragma unroll
            for (int mt = 0; mt < 2; ++mt) a[mt] = *(const h16x8*)(H + (size_t)(row0 + 16 * mt + fr) * D + 32 * ks + 8 * fq);
#pragma unroll
            for (int nt = 0; nt < 5; ++nt) { const h16x8 bw = *(const h16x8*)(W3 + (size_t)(DSA_MAIN + 16 * nt + fr) * D + 32 * ks + 8 * fq);
#pragma unroll
                for (int mt = 0; mt < 2; ++mt) acc[mt][nt] = MFMA16(a[mt], bw, acc[mt][nt]); }
        }
        LDS_BARRIER();
#pragma unroll
        for (int mt = 0; mt < 2; ++mt)
#pragma unroll
            for (int nt = 0; nt < 5; ++nt) *(LAS f32x4*)(red + ((w * 10 + mt * 5 + nt) * 64 + lane) * 4) = acc[mt][nt];
        LDS_BARRIER();
#pragma unroll
        for (int j = 0; j < 5; ++j) {
            const int idx = tid + NTH * j, t = idx >> 8, e = idx & 255;
            float s = 0.f;
#pragma unroll
            for (int w2 = 0; w2 < 8; ++w2) s += red[(w2 * 10 + t) * 256 + e];
            const int mt = t / 5, nt = t % 5, l2 = e >> 2, r = e & 3;
            const int row = row0 + 16 * mt + 4 * (l2 >> 4) + r;
            KW[(size_t)row * KW_LD + 16 * nt + (l2 & 15)] = (half_t)(s * RS[row]);
        }
    }
    LDS_BARRIER();
}

__device__ __forceinline__ void dsa_score_phase(const Ctx& c, const half_t* __restrict__ Z, const half_t* __restrict__ KW, float* __restrict__ SC) {
    const int lane = c.lane, w = c.wave, fr = lane & 15, fq = lane >> 4;
    constexpr int ldz = DSA_MAIN;
    for (int U = c.vcu; U < 512; U += c.G) {
        const int grp = U & 255, ui = U >> 8, b = grp >> 6, sx = grp & 63;
        const int qblk = (ui == 0) ? sx : 127 - sx;
        const int q0 = 16 * qblk, ng = (qblk >> 3) + 1;
        const size_t rowbase = (size_t)b * S;
        const half_t* kp = KW + (rowbase + 16 * w + fr) * KW_LD + 8 * fq;
        h16x8 k0 = *(const h16x8*)kp, k1 = *(const h16x8*)(kp + 32);
        h16x8 qf[16][2];
        { const half_t* qp = Z + (rowbase + q0 + fr) * ldz + 3072 + 8 * fq;
#pragma unroll
          for (int h = 0; h < 16; ++h)
#pragma unroll
              for (int ks = 0; ks < 2; ++ks) qf[h][ks] = *(const h16x8*)(qp + 64 * h + 32 * ks); }
        float wq[16];
        { const h16x8 w0 = *(const h16x8*)(KW + (rowbase + q0 + fr) * KW_LD + 64), w1 = *(const h16x8*)(KW + (rowbase + q0 + fr) * KW_LD + 72);
#pragma unroll
          for (int e = 0; e < 8; ++e) { wq[e] = (float)w0[e] * (1.f / 32.f); wq[8 + e] = (float)w1[e] * (1.f / 32.f); } }
        float* sp = SC + (rowbase + q0 + fr) * S + 16 * w + 4 * fq;
#pragma unroll 1
        for (int g = 0; g < ng; ++g) {
            h16x8 n0 = k0, n1 = k1;
            if (g + 1 < ng) { n0 = *(const h16x8*)(kp + (size_t)(g + 1) * 128 * KW_LD); n1 = *(const h16x8*)(kp + (size_t)(g + 1) * 128 * KW_LD + 32); }
            f32x4 acc = (f32x4){0.f, 0.f, 0.f, 0.f};
#pragma unroll
            for (int h = 0; h < 16; ++h) {
                const f32x4 t = MFMA16(k1, qf[h][1], MFMA16(k0, qf[h][0], ((f32x4){0.f, 0.f, 0.f, 0.f})));
#pragma unroll
                for (int r = 0; r < 4; ++r) acc[r] += wq[h] * fmaxf(t[r], 0.f);
            }
            *(f32x4*)(sp + 128 * g) = acc;
            k0 = n0; k1 = n1;
        }
    }
}
__device__ __forceinline__ void dsa_select_phase(const Ctx& c, const float* __restrict__ SC, unsigned* __restrict__ mbits) {
    const int gw = c.vcu * NW + c.wave, NGW = c.G * NW, lane = c.lane;
    for (int R = gw; R < M; R += NGW) {
        const int q = R % S; const float* sp = SC + (size_t)R * S;
        unsigned key[32];
#pragma unroll
        for (int j = 0; j < 32; ++j) { const int s = lane + 64 * j; unsigned k = 0u;
            if (s <= q) { const unsigned u = __float_as_uint(sp[s]); k = (u & 0x80000000u) ? ~u : (u | 0x80000000u); }
            key[j] = k; }
        unsigned T = 0u;
        if (q + 1 > TOPK) {
            for (int bit = 31; bit >= 0; --bit) {
                const unsigned cand = T | (1u << bit); int cnt = 0;
#pragma unroll
                for (int j = 0; j < 32; ++j) cnt += (key[j] >= cand) ? 1 : 0;
                if (wsum64i(cnt) >= TOPK) T = cand;
            }
        }
        unsigned* mp = mbits + (size_t)R * 64;
#pragma unroll
        for (int j = 0; j < 32; ++j) { const int s = lane + 64 * j; const unsigned long long bm = __ballot(key[j] >= T && s <= q);
            if (lane == 0) { mp[2 * j] = (unsigned)bm; mp[2 * j + 1] = (unsigned)(bm >> 32); } }
    }
}

__device__ __forceinline__ void hgrn_scan_phase(const Ctx& c, const half_t* __restrict__ Z, const float* __restrict__ lb_logits, float* __restrict__ OR) {
    const int tid = c.tid, lane = c.lane, w = c.wave, fr = lane & 15, fq = lane >> 4;
    constexpr int ldz = HGRN_IN;
    LAS float* QD = (LAS float*)c.lds;
    LAS half_t* QS = (LAS half_t*)(c.lds + 33792);
    LAS half_t* KS = QS + 64 * 136;
    LAS half_t* Vt = KS + 64 * 136;
    LAS half_t* At = Vt + 32 * 72;
    LAS half_t* St = At + 64 * 72;
    LAS float* Tot = (LAS float*)(St + 32 * 136);
    LAS float* TE = Tot + 4 * 128;
    LAS float* TF = TE + 4 * 128;
    LAS float* TD = TF + 4 * 128;
    LAS float* TDEC = TD + 3 * 128;
    const int k = tid & 127, tq = tid >> 7;
    for (int U = c.vcu; U < 256; U += c.G) {
        const int b = U >> 6, hd = (U >> 2) & 15, vs = U & 3;
        float lb;
        { const int ch = hd * 128 + k; const float a0 = lb_logits[ch], a1 = lb_logits[2048 + ch], a2 = lb_logits[4096 + ch], a3 = lb_logits[6144 + ch];
          const float mm = fmaxf(fmaxf(a0, a1), fmaxf(a2, a3)); const float e0 = expf(a0 - mm), e1 = expf(a1 - mm), e2 = expf(a2 - mm), e3 = expf(a3 - mm);
          lb = (e1 + e2) / (e0 + e1 + e2 + e3); }
        LDS_BARRIER();
        for (int i = tid; i < 64 * 72; i += NTH) At[i] = (half_t)0.f;
        for (int i = tid; i < 32 * 136; i += NTH) St[i] = (half_t)0.f;
        f32x4 sacc[2]; sacc[0] = (f32x4){0.f, 0.f, 0.f, 0.f}; sacc[1] = (f32x4){0.f, 0.f, 0.f, 0.f};
        u32x4 qv_[2], zv_[2]; h16x4 vraw;
        const half_t* zp0 = Z + ((size_t)b * S + (tid >> 4)) * ldz + hd * 128 + (tid & 15) * 8;
        const half_t* vp0 = Z + ((size_t)b * S + (tid >> 3)) * ldz + 4096 + hd * 128 + vs * 32 + (tid & 7) * 4;
#define HG_LOAD(ck_) do { const half_t* zp = zp0 + (size_t)(64 * (ck_)) * ldz; \
            qv_[0] = *(const u32x4*)(zp); zv_[0] = *(const u32x4*)(zp + 2048); qv_[1] = *(const u32x4*)(zp + (size_t)32 * ldz); zv_[1] = *(const u32x4*)(zp + (size_t)32 * ldz + 2048); \
            vraw = *(const h16x4*)(vp0 + (size_t)(64 * (ck_)) * ldz); } while (0)
#define HG_SB() do { asm volatile("" ::: "memory"); __builtin_amdgcn_sched_barrier(0); } while (0)
        HG_LOAD(0);
        for (int ck = 0; ck < S / 64; ++ck) {
            const size_t row0 = (size_t)b * S + 64 * ck;
            LDS_BARRIER();
            {
                const int t = tid >> 4, k8 = (tid & 15) * 8;
                *(LAS u32x4*)(QS + t * 136 + k8) = qv_[0]; *(LAS u32x4*)(KS + t * 136 + k8) = zv_[0];
                *(LAS u32x4*)(QS + (t + 32) * 136 + k8) = qv_[1]; *(LAS u32x4*)(KS + (t + 32) * 136 + k8) = zv_[1];
                const int tv = tid >> 3, v4 = (tid & 7) * 4;
#pragma unroll
                for (int j = 0; j < 4; ++j) Vt[(v4 + j) * 72 + tv] = vraw[j];
                if (ck + 1 < S / 64) HG_LOAD(ck + 1);
            }
            LDS_BARRIER();
            {
                float fv[16]; float prod = 1.f;
#pragma unroll
                for (int tt = 0; tt < 16; ++tt) { const float sg = fsigm((float)KS[(16 * tq + tt) * 136 + k]); fv[tt] = lb + (1.f - lb) * sg; prod *= fv[tt]; }
                prod = fmaxf(prod, 1e-30f);
                Tot[tq * 128 + k] = __logf(prod);
                LDS_BARRIER();
                const float t0 = Tot[k], t1 = Tot[128 + k], t2 = Tot[256 + k], t3 = Tot[384 + k];
                const float be1 = t0, be2 = t0 + t1, be3 = be2 + t2, be4 = be3 + t3;
                if (tq == 0) { TE[k] = 1.f; TE[128 + k] = fexp(be1); TE[256 + k] = fexp(be2); TE[384 + k] = fexp(be3); }
                else if (tq == 1) { TF[k] = fexp(be4 - be1); TF[128 + k] = fexp(be4 - be2); TF[256 + k] = fexp(be4 - be3); TF[384 + k] = 1.f; }
                else if (tq == 2) { TD[k] = fexp(be2 - be1); TD[128 + k] = fexp(be3 - be1); TD[256 + k] = fexp(be3 - be2); }
                else TDEC[k] = fexp(be4);
                const float ip16 = __builtin_amdgcn_rcpf(prod);
                float P = 1.f;
#pragma unroll
                for (int tt = 0; tt < 16; ++tt) {
                    const float qv = (float)QS[(16 * tq + tt) * 136 + k];
                    P = fmaxf(P * fv[tt], 1e-30f);
                    const float qp = qv * fsigm(qv), ky = 1.f - fv[tt];
                    const int t = 16 * tq + tt;
                    const float qsv = qp * P;
                    QS[t * 136 + k] = (half_t)qsv;
                    QD[t * 132 + k] = qsv * ip16;
                    KS[t * 136 + k] = (half_t)(ky * prod * __builtin_amdgcn_rcpf(P));
                    if ((tt & 3) == 3) HG_SB();
                }
            }
            LDS_BARRIER();
            if (w < 4) {
                const int I = w;
                f32x4 acc = (f32x4){0.f, 0.f, 0.f, 0.f}, acc2 = acc;
#pragma unroll 2
                for (int m = 0; m < 8; m += 2) {
                    const int k0 = 16 * m + 4 * fq;
                    const f32x4 qd = *(const LAS f32x4*)(QD + (16 * I + fr) * 132 + k0), qd2 = *(const LAS f32x4*)(QD + (16 * I + fr) * 132 + k0 + 16);
                    const h16x4 kv = *(const LAS h16x4*)(KS + (16 * I + fr) * 136 + k0), kv2 = *(const LAS h16x4*)(KS + (16 * I + fr) * 136 + k0 + 16);
#pragma unroll
                    for (int e = 0; e < 4; ++e) { acc = __builtin_amdgcn_mfma_f32_16x16x4f32(qd[e], (float)kv[e], acc, 0, 0, 0);
                                                  acc2 = __builtin_amdgcn_mfma_f32_16x16x4f32(qd2[e], (float)kv2[e], acc2, 0, 0, 0); }
                }
#pragma unroll
                for (int r = 0; r < 4; ++r) { const int tl = 4 * fq + r; At[(16 * I + tl) * 72 + 16 * I + fr] = (half_t)((fr <= tl) ? (acc[r] + acc2[r]) : 0.f); }
            } else {
                const int nb = (w < 6) ? 2 : 1;
                for (int bi = 0; bi < nb; ++bi) {
                    const int I = (w == 4) ? (bi == 0 ? 1 : 3) : (w == 5) ? (bi == 0 ? 2 : 3) : (w == 6) ? 3 : 2;
                    const int J = (w == 4) ? (bi == 0 ? 0 : 1) : (w == 5) ? (bi == 0 ? 1 : 0) : (w == 6) ? 2 : 0;
                    const int dsel = (I == 2) ? 0 : (J == 0 ? 1 : 2);
                    f32x4 acc = (f32x4){0.f, 0.f, 0.f, 0.f};
#pragma unroll
                    for (int ks = 0; ks < 4; ++ks) {
                        const int k0 = 32 * ks + 8 * fq;
                        h16x8 a = *(const LAS h16x8*)(QS + (16 * I + fr) * 136 + k0);
                        const h16x8 bb = *(const LAS h16x8*)(KS + (16 * J + fr) * 136 + k0);
                        if (I - J >= 2) {
                            const f32x4 d0 = *(const LAS f32x4*)(TD + dsel * 128 + k0), d1 = *(const LAS f32x4*)(TD + dsel * 128 + k0 + 4);
#pragma unroll
                            for (int j = 0; j < 4; ++j) { a[j] = (half_t)((float)a[j] * d0[j]); a[4 + j] = (half_t)((float)a[4 + j] * d1[j]); }
                        }
                        acc = MFMA16(a, bb, acc);
                    }
#pragma unroll
                    for (int r = 0; r < 4; ++r) At[(16 * I + 4 * fq + r) * 72 + 16 * J + fr] = (half_t)acc[r];
                }
            }
            const int mt = w - 4;
            f32x4 oacc[2]; oacc[0] = (f32x4){0.f, 0.f, 0.f, 0.f}; oacc[1] = oacc[0];
            if (w >= 4) {
#pragma unroll
                for (int ks = 0; ks < 4; ++ks) {
                    h16x8 a = *(const LAS h16x8*)(QS + (16 * mt + fr) * 136 + 32 * ks + 8 * fq);
                    if (mt > 0) {
                        const f32x4 e0 = *(const LAS f32x4*)(TE + mt * 128 + 32 * ks + 8 * fq), e1 = *(const LAS f32x4*)(TE + mt * 128 + 32 * ks + 8 * fq + 4);
#pragma unroll
                        for (int j = 0; j < 4; ++j) { a[j] = (half_t)((float)a[j] * e0[j]); a[4 + j] = (half_t)((float)a[4 + j] * e1[j]); }
                    }
#pragma unroll
                    for (int nt = 0; nt < 2; ++nt) { const h16x8 sb = *(const LAS h16x8*)(St + (16 * nt + fr) * 136 + 32 * ks + 8 * fq); oacc[nt] = MFMA16(a, sb, oacc[nt]); }
                }
            }
            LDS_BARRIER();
            if (w >= 4) {
#pragma unroll
                for (int ks = 0; ks < 2; ++ks) {
                    const h16x8 a = *(const LAS h16x8*)(At + (16 * mt + fr) * 72 + 32 * ks + 8 * fq);
#pragma unroll
                    for (int nt = 0; nt < 2; ++nt) { const h16x8 vb = *(const LAS h16x8*)(Vt + (16 * nt + fr) * 72 + 32 * ks + 8 * fq); oacc[nt] = MFMA16(a, vb, oacc[nt]); }
                }
#pragma unroll
                for (int nt = 0; nt < 2; ++nt)
#pragma unroll
                    for (int r = 0; r < 4; ++r) OR[(row0 + 16 * mt + 4 * fq + r) * D + hd * 128 + vs * 32 + 16 * nt + fr] = oacc[nt][r];
            }
            {
#pragma unroll
                for (int r = 0; r < 4; ++r) { const float dec = TDEC[16 * w + 4 * fq + r]; sacc[0][r] *= dec; sacc[1][r] *= dec; }
                const int kr = 16 * w + fr;
#pragma unroll
                for (int ks = 0; ks < 2; ++ks) {
                    const float fj = TF[(2 * ks + (fq >> 1)) * 128 + kr];
                    h16x8 a;
#pragma unroll
                    for (int j = 0; j < 8; ++j) { const int s2 = 32 * ks + 8 * fq + j; a[j] = (half_t)((float)KS[s2 * 136 + kr] * fj); }
#pragma unroll
                    for (int n2 = 0; n2 < 2; ++n2) { const h16x8 vb = *(const LAS h16x8*)(Vt + (16 * n2 + fr) * 72 + 32 * ks + 8 * fq); sacc[n2] = MFMA16(a, vb, sacc[n2]); }
                }
#pragma unroll
                for (int n2 = 0; n2 < 2; ++n2) { u32x2 pk; pk.x = pkh(sacc[n2][0], sacc[n2][1]); pk.y = pkh(sacc[n2][2], sacc[n2][3]);
                    *(LAS u32x2*)(St + (16 * n2 + fr) * 136 + 16 * w + 4 * fq) = pk; }
            }
        }
#undef HG_LOAD
#undef HG_SB
    }
    LDS_BARRIER();
}
__device__ __forceinline__ float hgrn_lb(const float* __restrict__ lb_logits, int ch) {
    const float a0 = lb_logits[ch], a1 = lb_logits[2048 + ch], a2 = lb_logits[4096 + ch], a3 = lb_logits[6144 + ch];
    const float mm = fmaxf(fmaxf(a0, a1), fmaxf(a2, a3)); const float e0 = expf(a0 - mm), e1 = expf(a1 - mm), e2 = expf(a2 - mm), e3 = expf(a3 - mm);
    return (e1 + e2) / (e0 + e1 + e2 + e3);
}
constexpr int HG_VS = 144;
__device__ __forceinline__ h16x8 hgrn_vfrag(const LAS half_t* Vr, int fr, int fq, int ks, int nt) {
    const LAS half_t* p = Vr + (32 * ks + 8 * fq + (fr >> 2)) * HG_VS + 16 * nt + 4 * (fr & 3);
    const v4i16_t lo = __builtin_amdgcn_ds_read_tr16_b64_v4i16((LAS v4i16_t*)p);
    const v4i16_t hi2 = __builtin_amdgcn_ds_read_tr16_b64_v4i16((LAS v4i16_t*)(p + 4 * HG_VS));
    typedef short s16x8 __attribute__((ext_vector_type(8)));
    const s16x8 vv = (s16x8){lo[0], lo[1], lo[2], lo[3], hi2[0], hi2[1], hi2[2], hi2[3]};
    return __builtin_bit_cast(h16x8, vv);
}

__device__ __forceinline__ void hgrn_local_phase(const Ctx& c, const half_t* __restrict__ Z, const float* __restrict__ lb_logits, half_t* __restrict__ UT, float* __restrict__ DEC) {
    const int tid = c.tid, lane = c.lane, w = c.wave, fr = lane & 15, fq = lane >> 4;
    constexpr int ldz = HGRN_IN;
    LAS half_t* KS = (LAS half_t*)c.lds;
    LAS half_t* Vr = KS + 64 * 136;
    LAS float* Tot = (LAS float*)(Vr + 64 * HG_VS);
    LAS float* TF = Tot + 4 * 128;
    const int k = tid & 127, tq = tid >> 7;
    const int st = tid >> 4, sk8 = (tid & 15) * 8;
    u32x4 zv_[2], vv_[2];
#define HA_LOAD(u_) do { const int b_ = (u_) >> 9, hd_ = ((u_) >> 5) & 15, ck_ = (u_) & 31; const half_t* zp = Z + ((size_t)b_ * S + 64 * ck_ + st) * ldz + hd_ * 128 + sk8; \
        zv_[0] = *(const u32x4*)(zp + 2048); zv_[1] = *(const u32x4*)(zp + (size_t)32 * ldz + 2048); vv_[0] = *(const u32x4*)(zp + 4096); vv_[1] = *(const u32x4*)(zp + (size_t)32 * ldz + 4096); } while (0)
    int U = c.vcu;
    if (U < 2048) HA_LOAD(U);
    for (; U < 2048; U += c.G) {
        const int hd = (U >> 5) & 15;
        const float lb = hgrn_lb(lb_logits, hd * 128 + k);
        LDS_BARRIER();
        *(LAS u32x4*)(KS + st * 136 + sk8) = zv_[0]; *(LAS u32x4*)(KS + (st + 32) * 136 + sk8) = zv_[1];
        *(LAS u32x4*)(Vr + st * HG_VS + sk8) = vv_[0]; *(LAS u32x4*)(Vr + (st + 32) * HG_VS + sk8) = vv_[1];
        if (U + c.G < 2048) HA_LOAD(U + c.G);
        LDS_BARRIER();
        float fv[16]; float prod = 1.f;
#pragma unroll
        for (int tt = 0; tt < 16; ++tt) { const float sg = fsigm((float)KS[(16 * tq + tt) * 136 + k]); fv[tt] = lb + (1.f - lb) * sg; prod *= fv[tt]; }
        prod = fmaxf(prod, 1e-30f);
        Tot[tq * 128 + k] = __logf(prod);
        LDS_BARRIER();
        {
            const float t0 = Tot[k], t1 = Tot[128 + k], t2 = Tot[256 + k], t3 = Tot[384 + k];
            const float be1 = t0, be2 = t0 + t1, be3 = be2 + t2, be4 = be3 + t3;
            if (tq == 1) { TF[k] = fexp(be4 - be1); TF[128 + k] = fexp(be4 - be2); TF[256 + k] = fexp(be4 - be3); TF[384 + k] = 1.f; }
            if (tq == 3) DEC[(size_t)U * 128 + k] = fexp(be4);
            float P = 1.f;
#pragma unroll
            for (int tt = 0; tt < 16; ++tt) { P = fmaxf(P * fv[tt], 1e-30f); KS[(16 * tq + tt) * 136 + k] = (half_t)((1.f - fv[tt]) * prod * __builtin_amdgcn_rcpf(P)); }
        }
        LDS_BARRIER();
        f32x4 acc[8];
#pragma unroll
        for (int nt = 0; nt < 8; ++nt) acc[nt] = (f32x4){0.f, 0.f, 0.f, 0.f};
        const int kr = 16 * w + fr;
#pragma unroll
        for (int ks = 0; ks < 2; ++ks) {
            const float fj = TF[(2 * ks + (fq >> 1)) * 128 + kr];
            h16x8 a;
#pragma unroll
            for (int j = 0; j < 8; ++j) { const int s2 = 32 * ks + 8 * fq + j; a[j] = (half_t)((float)KS[s2 * 136 + kr] * fj); }
#pragma unroll
            for (int nt = 0; nt < 8; ++nt) acc[nt] = MFMA16(a, hgrn_vfrag(Vr, fr, fq, ks, nt), acc[nt]);
        }
        half_t* ut = UT + (size_t)U * 16384;
#pragma unroll
        for (int nt = 0; nt < 8; ++nt) { u32x2 pk; pk.x = pkh(acc[nt][0], acc[nt][1]); pk.y = pkh(acc[nt][2], acc[nt][3]);
            *(u32x2*)(ut + (16 * nt + fr) * 128 + 16 * w + 4 * fq) = pk; }
    }
#undef HA_LOAD
    LDS_BARRIER();
}

__device__ __forceinline__ void hgrn_carry_phase(const Ctx& c, const half_t* __restrict__ UT, const float* __restrict__ DEC, half_t* __restrict__ SS) {
    for (int g = c.vcu * NTH + c.tid; g < 64 * 2048; g += c.G * NTH) {
        const int bh = g >> 11, p8 = (g & 2047) * 8, k0 = p8 & 127;
        float s[8];
#pragma unroll
        for (int e = 0; e < 8; ++e) s[e] = 0.f;
#pragma unroll 4
        for (int ck = 0; ck < 32; ++ck) {
            const size_t u = (size_t)bh * 32 + ck;
            const h16x8 uv = *(const h16x8*)(UT + u * 16384 + p8);
            const f32x4 d0 = *(const f32x4*)(DEC + u * 128 + k0), d1 = *(const f32x4*)(DEC + u * 128 + k0 + 4);
            u32x4 o; o.x = pkh(s[0], s[1]); o.y = pkh(s[2], s[3]); o.z = pkh(s[4], s[5]); o.w = pkh(s[6], s[7]);
            *(u32x4*)(SS + u * 16384 + p8) = o;
#pragma unroll
            for (int e = 0; e < 4; ++e) { s[e] = fmaf(d0[e], s[e], (float)uv[e]); s[4 + e] = fmaf(d1[e], s[4 + e], (float)uv[4 + e]); }
        }
    }
}

__device__ __forceinline__ void hgrn_out_phase(const Ctx& c, const half_t* __restrict__ Z, const float* __restrict__ lb_logits, const half_t* __restrict__ SS, const float* __restrict__ ng,
                                               half_t* __restrict__ O) {
    const int tid = c.tid, lane = c.lane, w = c.wave, fr = lane & 15, fq = lane >> 4;
    constexpr int ldz = HGRN_IN;
    LAS float* QD = (LAS float*)c.lds;
    LAS half_t* KS = (LAS half_t*)(c.lds + 33792);
    LAS half_t* Vr = KS + 64 * 136;
    LAS half_t* At = Vr + 64 * HG_VS;
    LAS half_t* St = At + 64 * 72;
    LAS float* Tot = (LAS float*)(St + 128 * 136);
    LAS float* TX = Tot + 4 * 128;
    LAS float* TE = TX + 7 * 128;
    LAS float* RS = TE + 4 * 128;
    static_assert(33792 + (64 * 136 + 64 * HG_VS + 64 * 72 + 128 * 136) * 2 + (4 + 7 + 4) * 128 * 4 + 64 * 2 * 4 <= RING_BYTES, "hgrn_out LDS");
    const int k = tid & 127, tq = tid >> 7;
    const int st = tid >> 4, sk8 = (tid & 15) * 8;
    for (int i = tid; i < 64 * 72; i += NTH) At[i] = (half_t)0.f;
    u32x4 qv_[2], zv_[2], vv_[2], sv_[4];
#define HC_LOAD(u_) do { const int b_ = (u_) >> 9, hd_ = ((u_) >> 5) & 15, ck_ = (u_) & 31; const half_t* zp = Z + ((size_t)b_ * S + 64 * ck_ + st) * ldz + hd_ * 128 + sk8; \
        qv_[0] = *(const u32x4*)(zp); qv_[1] = *(const u32x4*)(zp + (size_t)32 * ldz); zv_[0] = *(const u32x4*)(zp + 2048); zv_[1] = *(const u32x4*)(zp + (size_t)32 * ldz + 2048); \
        vv_[0] = *(const u32x4*)(zp + 4096); vv_[1] = *(const u32x4*)(zp + (size_t)32 * ldz + 4096); \
        const half_t* sp = SS + (size_t)(u_) * 16384 + st * 128 + sk8; \
        _Pragma("unroll") for (int i_ = 0; i_ < 4; ++i_) sv_[i_] = *(const u32x4*)(sp + i_ * 32 * 128); } while (0)
    int U = c.vcu;
    if (U < 2048) HC_LOAD(U);
    for (; U < 2048; U += c.G) {
        const int b = U >> 9, hd = (U >> 5) & 15, ck = U & 31;
        const size_t row0 = (size_t)b * S + 64 * ck;
        const float lb = hgrn_lb(lb_logits, hd * 128 + k);
        LDS_BARRIER();
#pragma unroll
        for (int i = 0; i < 2; ++i) { const h16x8 qh = __builtin_bit_cast(h16x8, qv_[i]); f32x4 a0, a1;
#pragma unroll
            for (int e = 0; e < 4; ++e) { const float x0 = (float)qh[e], x1 = (float)qh[4 + e]; a0[e] = x0 * fsigm(x0); a1[e] = x1 * fsigm(x1); }
            *(LAS f32x4*)(QD + (st + 32 * i) * 132 + sk8) = a0; *(LAS f32x4*)(QD + (st + 32 * i) * 132 + sk8 + 4) = a1; }
        *(LAS u32x4*)(KS + st * 136 + sk8) = zv_[0]; *(LAS u32x4*)(KS + (st + 32) * 136 + sk8) = zv_[1];
        *(LAS u32x4*)(Vr + st * HG_VS + sk8) = vv_[0]; *(LAS u32x4*)(Vr + (st + 32) * HG_VS + sk8) = vv_[1];
#pragma unroll
        for (int i = 0; i < 4; ++i) *(LAS u32x4*)(St + (st + 32 * i) * 136 + sk8) = sv_[i];
        if (U + c.G < 2048) HC_LOAD(U + c.G);
        LDS_BARRIER();
        float fv[16]; float prod = 1.f;
#pragma unroll
        for (int tt = 0; tt < 16; ++tt) { const float sg = fsigm((float)KS[(16 * tq + tt) * 136 + k]); fv[tt] = lb + (1.f - lb) * sg; prod *= fv[tt]; }
        prod = fmaxf(prod, 1e-30f);
        Tot[tq * 128 + k] = __logf(prod);
        LDS_BARRIER();
        {
            const float t0 = Tot[k], t1 = Tot[128 + k], t2 = Tot[256 + k], t3 = Tot[384 + k];
            const float be1 = t0, be2 = t0 + t1, be3 = be2 + t2, be4 = be3 + t3;
            if (tq == 0) { TE[k] = fexp(be1); TE[128 + k] = fexp(be2); TE[256 + k] = fexp(be3); TE[384 + k] = fexp(be4); }
            else if (tq == 1) { TX[k] = fexp(be2 - be1); TX[128 + k] = fexp(be3 - be1); TX[256 + k] = fexp(be3 - be2); }
            else if (tq == 2) { TX[384 + k] = fexp(be4 - be1); TX[512 + k] = fexp(be4 - be2); TX[640 + k] = fexp(be4 - be3); }
            const float ip16 = __builtin_amdgcn_rcpf(prod);
            float P = 1.f;
#pragma unroll
            for (int tt = 0; tt < 16; ++tt) {
                const int t = 16 * tq + tt;
                P = fmaxf(P * fv[tt], 1e-30f);
                QD[t * 132 + k] *= P * ip16;
                KS[t * 136 + k] = (half_t)((1.f - fv[tt]) * prod * __builtin_amdgcn_rcpf(P));
                if ((tt & 3) == 3) { asm volatile("" ::: "memory"); __builtin_amdgcn_sched_barrier(0); }
            }
        }
        LDS_BARRIER();
        if (w < 4) {
            const int I = w;
            f32x4 acc = (f32x4){0.f, 0.f, 0.f, 0.f}, acc2 = acc;
#pragma unroll 2
            for (int m = 0; m < 8; m += 2) {
                const int k0 = 16 * m + 4 * fq;
                const f32x4 qd = *(const LAS f32x4*)(QD + (16 * I + fr) * 132 + k0), qd2 = *(const LAS f32x4*)(QD + (16 * I + fr) * 132 + k0 + 16);
                const h16x4 kv = *(const LAS h16x4*)(KS + (16 * I + fr) * 136 + k0), kv2 = *(const LAS h16x4*)(KS + (16 * I + fr) * 136 + k0 + 16);
#pragma unroll
                for (int e = 0; e < 4; ++e) { acc = __builtin_amdgcn_mfma_f32_16x16x4f32(qd[e], (float)kv[e], acc, 0, 0, 0);
                                              acc2 = __builtin_amdgcn_mfma_f32_16x16x4f32(qd2[e], (float)kv2[e], acc2, 0, 0, 0); }
            }
#pragma unroll
            for (int r = 0; r < 4; ++r) { const int tl = 4 * fq + r; At[(16 * I + tl) * 72 + 16 * I + fr] = (half_t)((fr <= tl) ? (acc[r] + acc2[r]) : 0.f); }
        } else {
            const int nb = (w < 6) ? 2 : 1;
            for (int bi = 0; bi < nb; ++bi) {
                const int I = (w == 4) ? (bi == 0 ? 1 : 3) : (w == 5) ? (bi == 0 ? 2 : 3) : (w == 6) ? 3 : 2;
                const int J = (w == 4) ? (bi == 0 ? 0 : 1) : (w == 5) ? (bi == 0 ? 1 : 0) : (w == 6) ? 2 : 0;
                const LAS float* tx = TX + (I * (I - 1) / 2 + J) * 128;
                f32x4 acc = (f32x4){0.f, 0.f, 0.f, 0.f};
#pragma unroll
                for (int ks = 0; ks < 4; ++ks) {
                    const int k0 = 32 * ks + 8 * fq;
                    const f32x4 q0 = *(const LAS f32x4*)(QD + (16 * I + fr) * 132 + k0), q1 = *(const LAS f32x4*)(QD + (16 * I + fr) * 132 + k0 + 4);
                    const f32x4 x0 = *(const LAS f32x4*)(tx + k0), x1 = *(const LAS f32x4*)(tx + k0 + 4);
                    const h16x8 bb = *(const LAS h16x8*)(KS + (16 * J + fr) * 136 + k0);
                    h16x8 a;
#pragma unroll
                    for (int j = 0; j < 4; ++j) { a[j] = (half_t)(q0[j] * x0[j]); a[4 + j] = (half_t)(q1[j] * x1[j]); }
                    acc = MFMA16(a, bb, acc);
                }
#pragma unroll
                for (int r = 0; r < 4; ++r) At[(16 * I + 4 * fq + r) * 72 + 16 * J + fr] = (half_t)acc[r];
            }
        }
        const int mt = w >> 1, nh = w & 1;
        f32x4 oacc[4];
#pragma unroll
        for (int n = 0; n < 4; ++n) oacc[n] = (f32x4){0.f, 0.f, 0.f, 0.f};
        half_t gt[4][4];
#pragma unroll
        for (int n = 0; n < 4; ++n)
#pragma unroll
            for (int r = 0; r < 4; ++r) gt[n][r] = Z[(row0 + 16 * mt + 4 * fq + r) * ldz + 6144 + hd * 128 + 64 * nh + 16 * n + fr];
#pragma unroll
        for (int ks = 0; ks < 4; ++ks) {
            const int k0 = 32 * ks + 8 * fq;
            const f32x4 q0 = *(const LAS f32x4*)(QD + (16 * mt + fr) * 132 + k0), q1 = *(const LAS f32x4*)(QD + (16 * mt + fr) * 132 + k0 + 4);
            const f32x4 x0 = *(const LAS f32x4*)(TE + mt * 128 + k0), x1 = *(const LAS f32x4*)(TE + mt * 128 + k0 + 4);
            h16x8 a;
#pragma unroll
            for (int j = 0; j < 4; ++j) { a[j] = (half_t)(q0[j] * x0[j]); a[4 + j] = (half_t)(q1[j] * x1[j]); }
#pragma unroll
            for (int n = 0; n < 4; ++n) { const h16x8 sb = *(const LAS h16x8*)(St + (64 * nh + 16 * n + fr) * 136 + k0); oacc[n] = MFMA16(a, sb, oacc[n]); }
        }
        LDS_BARRIER();
#pragma unroll
        for (int ks = 0; ks < 2; ++ks) {
            const h16x8 a = *(const LAS h16x8*)(At + (16 * mt + fr) * 72 + 32 * ks + 8 * fq);
#pragma unroll
            for (int n = 0; n < 4; ++n) oacc[n] = MFMA16(a, hgrn_vfrag(Vr, fr, fq, ks, 4 * nh + n), oacc[n]);
        }
        {
            float ssq[4];
#pragma unroll
            for (int r = 0; r < 4; ++r) { float s_ = 0.f;
#pragma unroll
                for (int n = 0; n < 4; ++n) s_ += oacc[n][r] * oacc[n][r];
                ssq[r] = rsum16(s_); }
            if (fr == 0) {
#pragma unroll
                for (int r = 0; r < 4; ++r) RS[(16 * mt + 4 * fq + r) * 2 + nh] = ssq[r];
            }
            LDS_BARRIER();
#pragma unroll
            for (int r = 0; r < 4; ++r) {
                const int t = 16 * mt + 4 * fq + r;
                const float rn = rsqrtf((RS[t * 2] + RS[t * 2 + 1]) * (1.f / 128.f) + RMS_EPS);
                half_t* op = O + (row0 + t) * D + hd * 128 + 64 * nh + fr;
#pragma unroll
                for (int n = 0; n < 4; ++n) { const float gv = (float)gt[n][r]; op[16 * n] = (half_t)(oacc[n][r] * rn * ng[64 * nh + 16 * n + fr] * (gv * fsigm(gv))); }
            }
        }
    }
#undef HC_LOAD
    LDS_BARRIER();
}

}

namespace fp {
constexpr int N_PHASES = 41;
#ifndef PROBE_MASK
#define PROBE_MASK 0
#endif
#define FP_PHASE_G(id, grp, ...) do { if (lo <= (id) && (id) < hi) { \
        if constexpr (((PROBE_MASK) >> (grp)) & 1) { _Pragma("unroll 1") for (int rep_ = 0; rep_ < 2; ++rep_) { asm volatile("" : "+s"(rep_)); __VA_ARGS__; if (rep_ == 0) xcd_barrier(bar); } } \
        else { __VA_ARGS__; } \
        if ((id) + 1 < hi) { xcd_barrier(bar); if constexpr (((PROBE_MASK) >> 10) & 1) xcd_barrier(bar); } } } while (0)
#define FP_PHASE(id, ...) FP_PHASE_G(id, 31, __VA_ARGS__)

template <int L>
__device__ __forceinline__ void layer_phases(const Ctx& c, const Params& p, const XcdBarrier& bar, int lo, int hi) {
    constexpr int KIND = L % 4, PB = 1 + 10 * L;
    constexpr int NIN = KIND == 0 ? SWA_IN : KIND == 1 ? DIFF_IN : KIND == 2 ? HGRN_IN : DSA_MAIN;
    constexpr size_t WIN_OFF = KIND == 0 ? WS_WIN0 : KIND == 1 ? WS_WIN1 : KIND == 2 ? WS_WIN2 : WS_WIN3;
    unsigned char* ws = p.ws;
    half_t* H = (half_t*)(ws + WS_X16); float* RS = (float*)(ws + WS_RS); half_t* ZU = (half_t*)(ws + WS_ZU); half_t* O = (half_t*)(ws + WS_O); float* MF = (float*)(ws + WS_MF); half_t* ACT = (half_t*)(ws + WS_ACT);
    const float* ng = p.in[3] + (size_t)L * 4 * D;
    const float* bias = p.in[1];
    FP_PHASE_G(PB + 0, 0, { if constexpr (KIND == 3) dsa_kiwi_phase(c, H, RS, (const half_t*)(ws + WS_WIN3), (half_t*)(ws + WS_KW));
                       pg8::Gemm g{H, (const half_t*)(ws + WIN_OFF), M, NIN, D}; pg8::StaticOrder so; so.init(M, NIN, c.G, (int)blockIdx.x); pg8::EpiH16T<true> E{ZU, NIN, RS};
                       pg8::gemm_phase<pg8::EpiH16T<true>, pg8::StaticOrder, true, true>(c.lds, g, so, E);
                       if constexpr (L == 0) { if (c.G == 256 && (int)blockIdx.x >= so.nwg - c.G) spare_slot_convert(c, p, 1, 0, DEFER_G1, (int)blockIdx.x - (so.nwg - c.G)); } });
    if constexpr (KIND == 0) {
        FP_PHASE_G(PB + 1, 1, gqa_phase<0>(c, ZU, SWA_IN, 2048, 2560, bias, p.in[9], nullptr, O));
    } else if constexpr (KIND == 1) {
        FP_PHASE_G(PB + 1, 2, diff_phase(c, ZU, bias, p.in[12], p.in[13], 0.8f - 0.6f * 0.74081822068f  , O));
    } else if constexpr (KIND == 2) {
        FP_PHASE_G(PB + 1, 3, hgrn_local_phase(c, ZU, p.in[2], (half_t*)(ws + WS_HUT), (float*)(ws + WS_HDEC)));
        FP_PHASE_G(PB + 2, 7, hgrn_carry_phase(c, (const half_t*)(ws + WS_HUT), (const float*)(ws + WS_HDEC), (half_t*)MF));
        FP_PHASE_G(PB + 3, 3, hgrn_out_phase(c, ZU, p.in[2], (const half_t*)MF, p.in[16], O));
    } else {
        FP_PHASE_G(PB + 1, 8, dsa_score_phase(c, ZU, (const half_t*)(ws + WS_KW), (float*)(ws + WS_ACT)));
        FP_PHASE_G(PB + 2, 9, dsa_select_phase(c, (const float*)(ws + WS_ACT), (unsigned*)(ws + WS_MBITS)));
        FP_PHASE_G(PB + 3, 4, gqa_phase<1>(c, ZU, DSA_MAIN, 2048, 2560, bias, nullptr, (const unsigned*)(ws + WS_MBITS), O));
    }
    FP_PHASE_G(PB + 4, 0, { pg8::Gemm g{O, (const half_t*)(ws + WS_WOUT + L * WOUT_STRIDE), M, D, D}; pg8::StaticOrder so; so.init(M, D, c.G, (int)blockIdx.x); pg8::EpiH16 E{(half_t*)MF, D};
                       pg8::gemm_phase<pg8::EpiH16, pg8::StaticOrder, true, true>(c.lds, g, so, E); });
    FP_PHASE(PB + 5, resnorm_phase(c, (half_t*)(ws + WS_X16), (const half_t*)MF, ng + D, RS, nullptr));
    FP_PHASE_G(PB + 6, 0, { constexpr int MT = (M + 253) / 254; pg8::Gemm g{H, (const half_t*)(ws + WS_WUP + L * WUP_STRIDE), MT * 256, NUP, D, 254, -2}; pg8::StaticOrder so; so.init(MT * 256, NUP, c.G, (int)blockIdx.x);
                       pg8::EpiConv E{ACT, p.in[5] + (size_t)L * 3 * NUP, (LAS float*)(c.lds + MISC_OFF + 256), M, S, DFF, NUP, RS};
                       pg8::gemm_phase<pg8::EpiConv, pg8::StaticOrder, true, true>(c.lds, g, so, E);
                       if constexpr (L < 3) { const int nfull = so.nwg % c.G;
                           if (c.G == 256 && nfull == 256 - 84 && (int)blockIdx.x >= nfull) spare_slot_convert(c, p, L + 1, L == 0 ? DEFER_G1 : 0, L == 0 ? FFN_TILES : DEFER_G3, (int)blockIdx.x - nfull); } });
    FP_PHASE_G(PB + 8, 0, { pg8::Gemm g{ACT, (const half_t*)(ws + WS_WDN + L * WDN_STRIDE), M, D, DFF}; pg8::StaticOrder so; so.init(M, D, c.G, (int)blockIdx.x); pg8::EpiH16 E{(half_t*)MF, D};
                       pg8::gemm_phase<pg8::EpiH16, pg8::StaticOrder, true, true>(c.lds, g, so, E); });
    FP_PHASE(PB + 9, resnorm_phase(c, (half_t*)(ws + WS_X16), (const half_t*)MF, ng + 3 * D, (L < 3) ? RS : (float*)nullptr, (L < 3) ? (float*)nullptr : p.out));
}

__global__ void __launch_bounds__(NTH, 2) fwd_kernel(Params p) {
    extern __shared__ __attribute__((aligned(16))) unsigned char lds_raw[];
    Ctx c;
    c.lds = (LAS unsigned char*)lds_raw;
    c.tid = threadIdx.x; c.lane = c.tid & 63; c.wave = __builtin_amdgcn_readfirstlane(c.tid >> 6);
    c.G = gridDim.x; { const int bx = blockIdx.x; c.vcu = (c.G % 8 == 0) ? (bx % 8) * (c.G / 8) + bx / 8 : bx; }
    volatile LAS unsigned* misc = (volatile LAS unsigned*)(c.lds + MISC_OFF);
    if (c.tid < 4) misc[c.tid] = 0u;
    __syncthreads();
    XcdBarrier bar = xcd_barrier_post((unsigned*)(p.ws + WS_CTL) + CW_BAR, misc);
    const int lo = p.ph_lo, hi = p.ph_hi;
    FP_PHASE_G(0, 6, prologue_phase(c, p));
#ifndef ONLY_LAYER
#define ONLY_LAYER -1
#endif
    if constexpr (ONLY_LAYER < 0 || ONLY_LAYER == 0) layer_phases<0>(c, p, bar, lo, hi);
    if constexpr (ONLY_LAYER < 0 || ONLY_LAYER == 1) layer_phases<1>(c, p, bar, lo, hi);
    if constexpr (ONLY_LAYER < 0 || ONLY_LAYER == 2) layer_phases<2>(c, p, bar, lo, hi);
    if constexpr (ONLY_LAYER < 0 || ONLY_LAYER == 3) layer_phases<3>(c, p, bar, lo, hi);
}

static int g_grid = 0;
static int fast_setup() {
    if (g_grid == 0) {
        int dev = 0, cus = 0, per_cu = 0;
        if (hipGetDevice(&dev) != hipSuccess || hipDeviceGetAttribute(&cus, hipDeviceAttributeMultiprocessorCount, dev) != hipSuccess) { fprintf(stderr, "kernel_launch: device query failed\n"); g_grid = -1; return g_grid; }
        if (hipFuncSetAttribute((const void*)fwd_kernel, hipFuncAttributeMaxDynamicSharedMemorySize, LDS_BYTES) != hipSuccess) { fprintf(stderr, "kernel_launch: hipFuncSetAttribute failed\n"); g_grid = -1; return g_grid; }
        if (hipOccupancyMaxActiveBlocksPerMultiprocessor(&per_cu, (const void*)fwd_kernel, NTH, LDS_BYTES) != hipSuccess || per_cu < 1) fprintf(stderr, "kernel_launch: occupancy query says %d\n", per_cu);
        (void)hipGetLastError();
        g_grid = cus;
    }
    return g_grid;
}
static void fast_launch(void* const* d_in, void* d_out, void* d_ws, int lo, int hi, hipStream_t stream) {
    Params p{};
    for (int i = 0; i < 19; ++i) p.in[i] = (const float*)d_in[i];
    p.out = (float*)d_out; p.ws = (unsigned char*)d_ws; p.ph_lo = lo; p.ph_hi = hi;
#if MODE == 2
    (void)hipMemsetAsync((char*)d_ws + WS_CTL + CW_BAR * 4, 0, XCD_BAR_WORDS * 4, stream);
#endif
    hipLaunchKernelGGL(fwd_kernel, dim3(g_grid), dim3(NTH), LDS_BYTES, stream, p);
}
}

#if MODE == 0
extern "C" void kernel_launch(void* const* d_in, const int* in_sizes, int n_in, void* d_out, int out_size, void* d_ws, size_t ws_size, hipStream_t stream) {
    if (fp::fast_setup() <= 0) return;
    (void)hipMemsetAsync((char*)d_ws + fp::WS_CTL, 0, fp::CTL_BYTES, stream);
    fp::fast_launch(d_in, d_out, d_ws, 0, fp::N_PHASES, stream);
}
#endif

#if MODE == 2
namespace dbg {
using namespace cfg;
template <bool HALF>
__global__ void __launch_bounds__(256) cmp_kernel(const void* f, int ldf, const float* o, int ldo, int rows, int cols, float* sums) {
    float sd = 0.f, so = 0.f;
    const size_t n = (size_t)rows * cols;
    for (size_t i = (size_t)blockIdx.x * 256 + threadIdx.x; i < n; i += (size_t)gridDim.x * 256) {
        const int r = (int)(i / cols), cc = (int)(i % cols);
        const float fv = HALF ? (float)((const half_t*)f)[(size_t)r * ldf + cc] : ((const float*)f)[(size_t)r * ldf + cc];
        const float ov = o[(size_t)r * ldo + cc];
        const float d = fv - ov; sd += d * d; so += ov * ov;
    }
    for (int off = 32; off >= 1; off >>= 1) { sd += __shfl_xor(sd, off); so += __shfl_xor(so, off); }
    if ((threadIdx.x & 63) == 0) { atomicAdd(sums, sd); atomicAdd(sums + 1, so); }
}
__global__ void __launch_bounds__(256) report_kernel(const float* sums, int nck, float* out, size_t n) {
    int bad = 0; float V = 0.f;
    for (int k = 0; k < nck; ++k) {
        const float sd = sums[2 * k], so = sums[2 * k + 1];
        if (so == 0.f && sd == 0.f) continue;
        const float rvr = sd / so;
        const float tol = (k == 23) ? 2e-2f : (k > 23) ? 5e-3f : 3e-4f;
        if (!(rvr < tol)) {
            int e = 15;
            if (rvr == rvr) { e = (int)floorf(1.f - log10f(rvr)); e = e < 0 ? 0 : (e > 12 ? 12 : e); }
            V = (float)(10 + k + 1) * powf(10.f, (float)(4 + e)); bad = 1; break;
        }
    }
    if (!bad) return;
    for (size_t i = (size_t)blockIdx.x * 256 + threadIdx.x; i < n; i += (size_t)gridDim.x * 256) out[i] = (i == 0) ? V : 0.f;
}
}

extern "C" void kernel_launch(void* const* d_in, const int* in_sizes, int n_in, void* d_out, int out_size, void* d_ws, size_t ws_size, hipStream_t stream) {
    using namespace cfg;
    if (fp::fast_setup() <= 0) return;
    unsigned char* ws = (unsigned char*)d_ws;
    (void)hipMemsetAsync(ws + fp::WS_CTL, 0, fp::CTL_BYTES, stream);
    float* sums = (float*)(ws + fp::WS_CTL) + fp::CW_CK;
    constexpr size_t MiB = 1u << 20;
    size_t off = fp::WS_FAST_END + 2 * MiB;
    orc::Bufs bf;
    bf.X = (float*)(ws + off); off += 64 * MiB;
    bf.O = (float*)(ws + off); off += 64 * MiB;
    bf.MF = (float*)(ws + off); off += 64 * MiB;
    bf.H = (float*)(ws + off); off += 16 * MiB;
    bf.Z = (float*)(ws + off); off += 64 * MiB;
    bf.U = (float*)(ws + off); off += 88 * MiB;
    bf.A = (float*)(ws + off); off += 44 * MiB;
    if (off > ws_size) { fprintf(stderr, "kernel_launch: workspace too small (%zu > %zu)\n", off, ws_size); return; }
    (void)hipMemcpyAsync(bf.X, d_in[0], (size_t)M * D * 4, hipMemcpyDeviceToDevice, stream);
    half_t* fZU = (half_t*)(ws + fp::WS_ZU); half_t* fO = (half_t*)(ws + fp::WS_O); half_t* fACT = (half_t*)(ws + fp::WS_ACT);
    float* fX = (float*)d_out;
    fp::fast_launch(d_in, d_out, d_ws, 0, 1, stream);
    for (int L = 0; L < 4; ++L) {
        const int kind = L % 4, PB = 1 + 10 * L;
        const int nin = kind == 0 ? SWA_IN : kind == 1 ? DIFF_IN : kind == 2 ? HGRN_IN : DSA_IN;
        const int ninp = kind == 3 ? fp::DSA_MAIN : nin;
        float* ck = sums + 2 * 7 * L;
        fp::fast_launch(d_in, d_out, d_ws, PB, PB + 1, stream);
        for (int b = 0; b < B; ++b)
            orc::run_mixer(bf, d_in, L, b, 1, stream, [&](int stage) {
                if (b != 0) return;
                if (stage == 1) dbg::cmp_kernel<true><<<1024, 256, 0, stream>>>(fZU, ninp, bf.Z, nin, S, nin < ninp ? nin : ninp, ck + 2);
            });
        fp::fast_launch(d_in, d_out, d_ws, PB + 1, PB + 4, stream);
        dbg::cmp_kernel<true><<<1024, 256, 0, stream>>>(fO, D, bf.O, D, M, D, ck + 4);
        fp::fast_launch(d_in, d_out, d_ws, PB + 4, PB + 5, stream);
        fp::fast_launch(d_in, d_out, d_ws, PB + 5, PB + 6, stream);
        dbg::cmp_kernel<true><<<1024, 256, 0, stream>>>(ws + fp::WS_X16, D, bf.X, D, M, D, ck + 6);
        fp::fast_launch(d_in, d_out, d_ws, PB + 6, PB + 7, stream);
        for (int b = 0; b < B; ++b)
            orc::run_ffn(bf, d_in, L, b, 1, stream, [&](int stage) {
                if (b != 0) return;
                if (stage == 2) { (void)fZU; }
                if (stage == 3) dbg::cmp_kernel<true><<<1024, 256, 0, stream>>>(fACT, DFF, bf.A, DFF, S, DFF, ck + 10);
            });
        fp::fast_launch(d_in, d_out, d_ws, PB + 8, PB + 9, stream);
        fp::fast_launch(d_in, d_out, d_ws, PB + 9, PB + 10, stream);
        if (L < 3) dbg::cmp_kernel<true><<<1024, 256, 0, stream>>>(ws + fp::WS_X16, D, bf.X, D, M, D, ck + 12);
        else dbg::cmp_kernel<false><<<1024, 256, 0, stream>>>(fX, D, bf.X, D, M, D, ck + 12);
    }
    dbg::report_kernel<<<1024, 256, 0, stream>>>(sums, 28, fX, (size_t)M * D);
}
#endif
#endif
#if MODE == 1
extern "C" void kernel_launch(void* const* d_in, const int* in_sizes, int n_in, void* d_out, int out_size, void* d_ws, size_t ws_size, hipStream_t stream) {
    using namespace cfg;
    float* ws = (float*)d_ws;
    orc::Bufs bf;
    bf.X = (float*)d_out;
    size_t off = 0;
    bf.H = ws + off; off += (size_t)M * D;
    bf.O = ws + off; off += (size_t)M * D;
    bf.MF = ws + off; off += (size_t)M * D;
    bf.Z = ws + off; off += (size_t)M * 8192;
    bf.U = ws + off; off += (size_t)M * NUP;
    bf.A = ws + off; off += (size_t)M * DFF;
    hipMemcpyAsync(bf.X, d_in[0], (size_t)M * D * 4, hipMemcpyDeviceToDevice, stream);
    for (int layer = 0; layer < 4; ++layer) {
        orc::run_mixer(bf, d_in, layer, 0, B, stream, orc::NoHook());
        orc::run_ffn(bf, d_in, layer, 0, B, stream, orc::NoHook());
    }
}
#endif
```

```cpp
#define MODE 0
#include <hip/hip_runtime.h>
#include <stdint.h>
#include <stdio.h>
#include <math.h>

#ifndef MODE
#define MODE 1
#endif

namespace cfg {
constexpr int B = 4, S = 2048, D = 2048, M = B * S, DFF = 5632, NUP = 2 * DFF, TOPK = 256;
constexpr int SWA_IN = 3072, DIFF_IN = 6144, HGRN_IN = 8192, DSA_IN = 4176, DSA_PAD = 4352;
constexpr float RMS_EPS = 1e-6f;
}
__constant__ unsigned char BUCKET_LUT[128] = {0,1,2,3,4,5,6,7,8,9,10,11,12,13,14,15,16,16,16,17,17,18,18,18,19,19,19,20,20,20,20,21,21,21,21,22,22,22,22,22,23,23,23,23,23,23,24,24,24,24,24,24,25,25,25,25,25,25,25,26,26,26,26,26,26,26,26,27,27,27,27,27,27,27,27,27,27,28,28,28,28,28,28,28,28,28,28,29,29,29,29,29,29,29,29,29,29,29,29,30,30,30,30,30,30,30,30,30,30,30,30,30,30,31,31,31,31,31,31,31,31,31,31,31,31,31,31,31};
#if MODE != 0
namespace orc {
using namespace cfg;

__device__ __forceinline__ float sigm(float x) { return 1.f / (1.f + expf(-x)); }
__device__ __forceinline__ int bucket(int n) { return n < 128 ? (int)BUCKET_LUT[n] : 31; }

__device__ __forceinline__ float wave_sum(float v) {
#pragma unroll
    for (int o = 32; o >= 1; o >>= 1) v += __shfl_xor(v, o);
    return v;
}
__device__ __forceinline__ float wave_max(float v) {
#pragma unroll
    for (int o = 32; o >= 1; o >>= 1) v = fmaxf(v, __shfl_xor(v, o));
    return v;
}
__device__ __forceinline__ float block_sum(float v, float* red) {
    v = wave_sum(v);
    const int w = threadIdx.x >> 6, nw = blockDim.x >> 6;
    __syncthreads();
    if ((threadIdx.x & 63) == 0) red[w] = v;
    __syncthreads();
    float r = 0.f;
    for (int i = 0; i < nw; ++i) r += red[i];
    return r;
}
__device__ __forceinline__ float block_max(float v, float* red) {
    v = wave_max(v);
    const int w = threadIdx.x >> 6, nw = blockDim.x >> 6;
    __syncthreads();
    if ((threadIdx.x & 63) == 0) red[w] = v;
    __syncthreads();
    float r = red[0];
    for (int i = 1; i < nw; ++i) r = fmaxf(r, red[i]);
    return r;
}

__global__ void __launch_bounds__(256) o_gemm(const float* __restrict__ A, int lda, const float* __restrict__ W, int ldw,
                                              float* __restrict__ C, int ldc, int N, int K) {
    __shared__ float As[16][132];
    __shared__ float Ws[16][132];
    const int tid = threadIdx.x, tx = tid & 15, ty = tid >> 4;
    const int m0 = blockIdx.y * 128, n0 = blockIdx.x * 128;
    float acc[8][8];
#pragma unroll
    for (int i = 0; i < 8; ++i)
#pragma unroll
        for (int j = 0; j < 8; ++j) acc[i][j] = 0.f;
    for (int k0 = 0; k0 < K; k0 += 16) {
#pragma unroll
        for (int i = 0; i < 8; ++i) { const int idx = tid + i * 256, r = idx >> 4, c = idx & 15; As[c][r] = A[(size_t)(m0 + r) * lda + k0 + c]; }
#pragma unroll
        for (int i = 0; i < 8; ++i) { const int idx = tid + i * 256, r = idx >> 7, c = idx & 127; Ws[r][c] = (n0 + c < N) ? W[(size_t)(k0 + r) * ldw + n0 + c] : 0.f; }
        __syncthreads();
#pragma unroll
        for (int kk = 0; kk < 16; ++kk) {
            float a[8], b[8];
#pragma unroll
            for (int i = 0; i < 8; ++i) { a[i] = As[kk][ty * 8 + i]; b[i] = Ws[kk][tx * 8 + i]; }
#pragma unroll
            for (int i = 0; i < 8; ++i)
#pragma unroll
                for (int j = 0; j < 8; ++j) acc[i][j] = fmaf(a[i], b[j], acc[i][j]);
        }
        __syncthreads();
    }
#pragma unroll
    for (int i = 0; i < 8; ++i)
#pragma unroll
        for (int j = 0; j < 8; ++j) { const int n = n0 + tx * 8 + j; if (n < N) C[(size_t)(m0 + ty * 8 + i) * ldc + n] = acc[i][j]; }
}

template <bool ADD>
__global__ void __launch_bounds__(256) o_rmsnorm(const float* __restrict__ in, const float* __restrict__ g, float* __restrict__ out) {
    __shared__ float red[16];
    const size_t row = blockIdx.x;
    const float* x = in + row * D;
    float ss = 0.f;
    for (int c = threadIdx.x; c < D; c += 256) ss += x[c] * x[c];
    ss = block_sum(ss, red);
    const float r = rsqrtf(ss / (float)D + RMS_EPS);
    for (int c = threadIdx.x; c < D; c += 256) { const float y = x[c] * r * g[c]; if (ADD) out[row * D + c] += y; else out[row * D + c] = y; }
}

__global__ void __launch_bounds__(128) o_swa(const float* __restrict__ Z, const float* __restrict__ bias, const float* __restrict__ sinks, float* __restrict__ O, int b0) {
    __shared__ float qs[64], ps[128], red[16];
    const int t = blockIdx.x, h = blockIdx.y, bl = blockIdx.z, kvh = h >> 2, tid = threadIdx.x;
    const size_t zr = (size_t)bl * S + t;
    const float* zq = Z + zr * 3072;
    if (tid < 64) qs[tid] = zq[h * 64 + tid];
    __syncthreads();
    const int j = tid, s = t - j;
    float sc = -INFINITY;
    if (s >= 0) {
        const float* kp = Z + (zr - j) * 3072 + 2048 + kvh * 64;
        float d = 0.f;
        for (int e = 0; e < 64; ++e) d = fmaf(qs[e], kp[e], d);
        sc = d * 0.125f + bias[bucket(j) * 32 + h];
    }
    const float sink = sinks[h];
    const float mx = fmaxf(block_max(sc, red), sink);
    const float p = (s >= 0) ? expf(sc - mx) : 0.f;
    const float den = block_sum(p, red) + expf(sink - mx);
    ps[j] = p / den;
    __syncthreads();
    if (tid < 64) {
        float o = 0.f;
        const int nj = t < 127 ? t + 1 : 128;
        for (int jj = 0; jj < nj; ++jj) o = fmaf(ps[jj], Z[(zr - jj) * 3072 + 2560 + kvh * 64 + tid], o);
        O[((size_t)(b0 + bl) * S + t) * D + h * 64 + tid] = o;
    }
}

__global__ void __launch_bounds__(256) o_diff(const float* __restrict__ Z, const float* __restrict__ bias, const float* __restrict__ lambdas, const float* __restrict__ subg,
                                              float* __restrict__ O, int b0, float lam_init) {
    __shared__ float qs[128], sc[2][2048], part[256], red[16];
    const int t = blockIdx.x, h = blockIdx.y, bl = blockIdx.z, tid = threadIdx.x;
    const size_t zr0 = (size_t)bl * S;
    const float* zq = Z + (zr0 + t) * 6144;
    if (tid < 128) qs[tid] = zq[h * 128 + tid];
    float l1 = 0.f, l2 = 0.f;
    if (tid < 64) { l1 = lambdas[tid] * lambdas[64 + tid]; l2 = lambdas[128 + tid] * lambdas[192 + tid]; }
    l1 = block_sum(l1, red); l2 = block_sum(l2, red);
    const float lam = expf(l1) - expf(l2) + lam_init;
    float mx[2], sm[2];
    for (int m = 0; m < 2; ++m) {
        float lmx = -INFINITY;
        for (int s = tid; s <= t; s += 256) {
            const float* kp = Z + (zr0 + s) * 6144 + 2048 + h * 128 + m * 64;
            float d = 0.f;
            for (int e = 0; e < 64; ++e) d = fmaf(qs[m * 64 + e], kp[e], d);
            const float v = d * 0.125f + bias[bucket(t - s) * 32 + h * 2 + m];
            sc[m][s] = v; lmx = fmaxf(lmx, v);
        }
        mx[m] = block_max(lmx, red);
        float ls = 0.f;
        for (int s = tid; s <= t; s += 256) ls += expf(sc[m][s] - mx[m]);
        sm[m] = block_sum(ls, red);
    }
    for (int s = tid; s <= t; s += 256) sc[0][s] = expf(sc[0][s] - mx[0]) / sm[0] - lam * (expf(sc[1][s] - mx[1]) / sm[1]);
    __syncthreads();
    const int e = tid & 127, half = tid >> 7;
    float o = 0.f;
    for (int s = half; s <= t; s += 2) o = fmaf(sc[0][s], Z[(zr0 + s) * 6144 + 4096 + h * 128 + e], o);
    part[tid] = o;
    __syncthreads();
    float ov = 0.f, ss = 0.f;
    if (tid < 128) { ov = part[tid] + part[tid + 128]; ss = ov * ov; }
    ss = block_sum(ss, red);
    if (tid < 128) {
        const float r = rsqrtf(ss / 128.f + RMS_EPS);
        O[((size_t)(b0 + bl) * S + t) * D + h * 128 + e] = ov * r * subg[e] * (1.f - lam_init);
    }
}

__global__ void __launch_bounds__(256) o_hgrn(const float* __restrict__ Z, const float* __restrict__ lb_logits, const float* __restrict__ ng, float* __restrict__ O, int b0) {
    __shared__ float qs[128], fs[128], ks[128], part[256], red[16];
    const int h = blockIdx.x, bl = blockIdx.z, tid = threadIdx.x, v = tid & 127, kh = tid >> 7;
    float lb = 0.f;
    if (tid < 128) {
        const int c = h * 128 + tid;
        const float a0 = lb_logits[c], a1 = lb_logits[2048 + c], a2 = lb_logits[4096 + c], a3 = lb_logits[6144 + c];
        const float mm = fmaxf(fmaxf(a0, a1), fmaxf(a2, a3));
        const float e0 = expf(a0 - mm), e1 = expf(a1 - mm), e2 = expf(a2 - mm), e3 = expf(a3 - mm);
        lb = (e1 + e2) / (e0 + e1 + e2 + e3);
    }
    float St[64];
#pragma unroll
    for (int i = 0; i < 64; ++i) St[i] = 0.f;
    const float gn = ng[v];
    for (int t = 0; t < S; ++t) {
        const float* zr = Z + ((size_t)bl * S + t) * 8192;
        if (tid < 128) {
            const float qv = zr[h * 128 + tid]; qs[tid] = qv * sigm(qv);
            const float z = zr[2048 + h * 128 + tid];
            fs[tid] = lb + (1.f - lb) * sigm(z);
            ks[tid] = (1.f - lb) * sigm(-z);
        }
        const float iv = zr[4096 + h * 128 + v];
        __syncthreads();
        float p = 0.f;
#pragma unroll
        for (int kk = 0; kk < 64; ++kk) { const int k = kh * 64 + kk; St[kk] = fmaf(fs[k], St[kk], ks[k] * iv); p = fmaf(qs[k], St[kk], p); }
        part[tid] = p;
        __syncthreads();
        float ov = 0.f, ss = 0.f;
        if (tid < 128) { ov = part[tid] + part[tid + 128]; ss = ov * ov; }
        ss = block_sum(ss, red);
        if (tid < 128) {
            const float r = rsqrtf(ss / 128.f + RMS_EPS);
            const float gt = zr[6144 + h * 128 + v];
            O[((size_t)(b0 + bl) * S + t) * D + h * 128 + v] = ov * r * gn * (gt * sigm(gt));
        }
        __syncthreads();
    }
}

__global__ void __launch_bounds__(256) o_dsa(const float* __restrict__ Z, const float* __restrict__ bias, float* __restrict__ O, int b0) {
    __shared__ float qi[1024], wi[16], sc[2048], q[2048], pj[256], red[16];
    __shared__ int idx[256];
    __shared__ unsigned char sel[2048];
    __shared__ int nsel_s;
    const int t = blockIdx.x, bl = blockIdx.z, tid = threadIdx.x;
    const size_t zr0 = (size_t)bl * S;
    const int LD = 4176;
    const float* zq = Z + (zr0 + t) * LD;
    for (int i = tid; i < 1024; i += 256) qi[i] = zq[3072 + i];
    for (int i = tid; i < 2048; i += 256) q[i] = zq[i];
    if (tid < 16) wi[tid] = zq[4160 + tid] * 0.25f;
    __syncthreads();
    for (int s = tid; s < S; s += 256) {
        float a = -INFINITY;
        if (s <= t) {
            const float* kp = Z + (zr0 + s) * LD + 4096;
            a = 0.f;
            for (int hh = 0; hh < 16; ++hh) {
                float d = 0.f;
                for (int e = 0; e < 64; ++e) d = fmaf(qi[hh * 64 + e], kp[e], d);
                d *= 0.125f;
                a += wi[hh] * fmaxf(d, 0.f);
            }
        }
        sc[s] = a;
    }
    __syncthreads();
    for (int s = tid; s < S; s += 256) {
        const float v = sc[s];
        int r = 0;
        for (int s2 = 0; s2 < S; ++s2) { const float v2 = sc[s2]; r += (v2 > v || (v2 == v && s2 < s)) ? 1 : 0; }
        sel[s] = (r < TOPK && s <= t) ? 1 : 0;
    }
    __syncthreads();
    if (tid == 0) { int n = 0; for (int s = 0; s < S; ++s) if (sel[s]) { if (n < 256) idx[n] = s; ++n; } nsel_s = n < 256 ? n : 256; }
    __syncthreads();
    const int nsel = nsel_s;
    for (int h = 0; h < 32; ++h) {
        const int kvh = h >> 2;
        float scv = -INFINITY; int s = 0;
        if (tid < nsel) {
            s = idx[tid];
            const float* kp = Z + (zr0 + s) * LD + 2048 + kvh * 64;
            float d = 0.f;
            for (int e = 0; e < 64; ++e) d = fmaf(q[h * 64 + e], kp[e], d);
            scv = d * 0.125f + bias[bucket(t - s) * 32 + h];
        }
        const float mx = block_max(scv, red);
        const float ev = (tid < nsel) ? expf(scv - mx) : 0.f;
        const float sm = block_sum(ev, red);
        pj[tid] = ev / sm;
        __syncthreads();
        if (tid < 64) {
            float o = 0.f;
            for (int j = 0; j < nsel; ++j) o = fmaf(pj[j], Z[(zr0 + idx[j]) * LD + 2560 + kvh * 64 + tid], o);
            O[((size_t)(b0 + bl) * S + t) * D + h * 64 + tid] = o;
        }
        __syncthreads();
    }
}

__global__ void __launch_bounds__(256) o_convact(const float* __restrict__ U, const float* __restrict__ cw, float* __restrict__ A) {
    const int c = blockIdx.x * 256 + threadIdx.x; const size_t r = blockIdx.y; const int t = (int)(r % S);
    float g = 0.f, v = 0.f;
#pragma unroll
    for (int j = 0; j < 3; ++j) {
        const int tt = t - 2 + j;
        if (tt >= 0) { const float* u = U + (r - 2 + j) * NUP; g = fmaf(cw[j * NUP + c], u[c], g); v = fmaf(cw[j * NUP + DFF + c], u[DFF + c], v); }
    }
    A[r * DFF + c] = g * sigm(g) * v;
}

struct Bufs { float *X, *H, *Z, *O, *MF, *U, *A; };

template <class Hook> static void run_mixer(const Bufs& bf, void* const* d_in, int layer, int b0, int nb, hipStream_t st, Hook hook) {
    const float* ng = (const float*)d_in[3] + (size_t)layer * 4 * D;
    const int rows = nb * S; const size_t r0 = (size_t)b0 * S;
    const float* bias = (const float*)d_in[1];
    o_rmsnorm<false><<<rows, 256, 0, st>>>(bf.X + r0 * D, ng, bf.H);
    hook(0);
    const int kind = layer % 4;
    const float* win = (const float*)d_in[kind == 0 ? 7 : kind == 1 ? 10 : kind == 2 ? 14 : 17];
    const float* wout = (const float*)d_in[kind == 0 ? 8 : kind == 1 ? 11 : kind == 2 ? 15 : 18];
    const int nin = kind == 0 ? SWA_IN : kind == 1 ? DIFF_IN : kind == 2 ? HGRN_IN : DSA_IN;
    o_gemm<<<dim3((nin + 127) / 128, rows / 128), 256, 0, st>>>(bf.H, D, win, nin, bf.Z, nin, nin, D);
    hook(1);
    if (kind == 0) o_swa<<<dim3(S, 32, nb), 128, 0, st>>>(bf.Z, bias, (const float*)d_in[9], bf.O, b0);
    else if (kind == 1) o_diff<<<dim3(S, 16, nb), 256, 0, st>>>(bf.Z, bias, (const float*)d_in[12], (const float*)d_in[13], bf.O, b0, 0.8f - 0.6f * expf(-0.3f * (float)layer));
    else if (kind == 2) o_hgrn<<<dim3(16, 1, nb), 256, 0, st>>>(bf.Z, (const float*)d_in[2], (const float*)d_in[16], bf.O, b0);
    else o_dsa<<<dim3(S, 1, nb), 256, 0, st>>>(bf.Z, bias, bf.O, b0);
    o_gemm<<<dim3(D / 128, rows / 128), 256, 0, st>>>(bf.O + r0 * D, D, wout, D, bf.MF + r0 * D, D, D, D);
    o_rmsnorm<true><<<rows, 256, 0, st>>>(bf.MF + r0 * D, ng + D, bf.X + r0 * D);
}
template <class Hook> static void run_ffn(const Bufs& bf, void* const* d_in, int layer, int b0, int nb, hipStream_t st, Hook hook) {
    const float* ng = (const float*)d_in[3] + (size_t)layer * 4 * D;
    const int rows = nb * S; const size_t r0 = (size_t)b0 * S;
    o_rmsnorm<false><<<rows, 256, 0, st>>>(bf.X + r0 * D, ng + 2 * D, bf.H);
    o_gemm<<<dim3(NUP / 128, rows / 128), 256, 0, st>>>(bf.H, D, (const float*)d_in[4] + (size_t)layer * D * NUP, NUP, bf.U, NUP, NUP, D);
    hook(2);
    o_convact<<<dim3(DFF / 256, rows), 256, 0, st>>>(bf.U, (const float*)d_in[5] + (size_t)layer * 3 * NUP, bf.A);
    hook(3);
    o_gemm<<<dim3(D / 128, rows / 128), 256, 0, st>>>(bf.A, DFF, (const float*)d_in[6] + (size_t)layer * DFF * D, D, bf.MF + r0 * D, D, D, DFF);
    o_rmsnorm<true><<<rows, 256, 0, st>>>(bf.MF + r0 * D, ng + 3 * D, bf.X + r0 * D);
}
struct NoHook { void operator()(int) const {} };
}

#endif

#if MODE != 1
#define GAS __attribute__((address_space(1)))
#define LAS __attribute__((address_space(3)))
typedef _Float16 half_t;
typedef _Float16 h16x8 __attribute__((ext_vector_type(8)));
typedef _Float16 h16x4 __attribute__((ext_vector_type(4)));
typedef _Float16 h16x2 __attribute__((ext_vector_type(2)));
typedef float f32x4 __attribute__((ext_vector_type(4)));
typedef float f32x2 __attribute__((ext_vector_type(2)));
typedef unsigned u32x4 __attribute__((ext_vector_type(4)));
typedef unsigned u32x2 __attribute__((ext_vector_type(2)));
#define MFMA16(a, b, c) __builtin_amdgcn_mfma_f32_16x16x32_f16((a), (b), (c), 0, 0, 0)
__device__ __forceinline__ unsigned pkh(float lo, float hi) { h16x2 v; v.x = (_Float16)lo; v.y = (_Float16)hi; return __builtin_bit_cast(unsigned, v); }
__device__ __forceinline__ float fexp2(float x) { return __builtin_amdgcn_exp2f(x); }
__device__ __forceinline__ float fexp(float x) { return __builtin_amdgcn_exp2f(x * 1.4426950408889634f); }
__device__ __forceinline__ float fsigm(float x) { return __builtin_amdgcn_rcpf(1.f + fexp(-x)); }

#define XB_TMO      128
#define XB_XCNT(j)  (256  + 64 * (j))
#define XB_XSUB(j)  (1280 + 64 * (j))
#define XB_XGEN(j)  (2304 + 64 * (j))
#define XB_TOP      3328
#define XB_TOPGEN   3392
#define XCD_BAR_WORDS 3456
#define XB_SPIN_CAP (1u << 18)

__device__ __forceinline__ unsigned xb_ld(unsigned* p)              { return __hip_atomic_load(p, __ATOMIC_RELAXED, __HIP_MEMORY_SCOPE_AGENT); }
__device__ __forceinline__ unsigned xb_add(unsigned* p, unsigned v) { return __hip_atomic_fetch_add(p, v, __ATOMIC_RELAXED, __HIP_MEMORY_SCOPE_AGENT); }
__device__ __forceinline__ unsigned xb_xcc_id() { return (unsigned)__builtin_amdgcn_s_getreg((3 << 11) | 20) & 0xFu; }
#define XB_SPIN(cond, bar) do { unsigned _sp = 0; while (cond) { __builtin_amdgcn_s_sleep(1); \
    if ((++_sp & 255u) == 0u) { if (xb_ld(&(bar)[XB_TMO])) break; if (_sp > XB_SPIN_CAP) { atomicAdd(&(bar)[XB_TMO], 1u); break; } } } } while (0)

struct XcdBarrier {
    unsigned* bar; unsigned x;
    volatile LAS unsigned* st;
};

__device__ __forceinline__ XcdBarrier xcd_barrier_post(unsigned* bar, volatile LAS unsigned* st) {
    XcdBarrier b; b.bar = bar; b.x = xb_xcc_id(); b.st = st;
    if (threadIdx.x == 0) (void)xb_add(&bar[XB_XCNT(b.x)], 1u);
    return b;
}
__device__ __forceinline__ void xcd_barrier_complete(unsigned* bar, unsigned x, unsigned& nloc, unsigned& nx) {
    const unsigned G = gridDim.x * gridDim.y * gridDim.z;
    unsigned sum, cnt, mine, sp = 0u;
    for (;;) {
        sum = 0u; cnt = 0u; mine = 0u;
#pragma unroll
        for (unsigned j = 0; j < 16; ++j) { const unsigned c = xb_ld(&bar[XB_XCNT(j)]); sum += c; cnt += (c > 0u) ? 1u : 0u; mine = (j == x) ? c : mine; }
        if (sum == G) break;
        __builtin_amdgcn_s_sleep(1);
        if ((++sp & 255u) == 0u) { if (xb_ld(&bar[XB_TMO])) break; if (sp > XB_SPIN_CAP) { atomicAdd(&bar[XB_TMO], 1u); break; } }
    }
    nloc = mine > 0u ? mine : 1u; nx = cnt > 0u ? cnt : 1u;
}

__device__ __forceinline__ void xcd_barrier(const XcdBarrier& b) {
    asm volatile("s_waitcnt vmcnt(0)" ::: "memory");
    __syncthreads();
    if (threadIdx.x == 0) {
        unsigned* bar = b.bar;
        __builtin_amdgcn_s_waitcnt(0);
        unsigned nloc = b.st[0], nx = b.st[1];
        if (nloc == 0u) { xcd_barrier_complete(bar, b.x, nloc, nx); b.st[0] = nloc; b.st[1] = nx; }
        const unsigned old = xb_add(&bar[XB_XSUB(b.x)], 1u);
        const unsigned gen = old / nloc;
        if (old + 1u == (gen + 1u) * nloc) {
            __builtin_amdgcn_fence(__ATOMIC_RELEASE, "agent");
            asm volatile("s_waitcnt vmcnt(0)" ::: "memory");
            const unsigned og = xb_add(&bar[XB_TOP], 1u);
            const unsigned tg = og / nx;
            if (og + 1u == (tg + 1u) * nx) xb_add(&bar[XB_TOPGEN], 1u);
            else XB_SPIN(xb_ld(&bar[XB_TOPGEN]) == tg, bar);
            __builtin_amdgcn_fence(__ATOMIC_ACQUIRE, "agent");
            xb_add(&bar[XB_XGEN(b.x)], 1u);
            asm volatile("s_waitcnt vmcnt(0)" ::: "memory");
        } else {
            XB_SPIN(xb_ld(&bar[XB_XGEN(b.x)]) == gen, bar);
            __builtin_amdgcn_fence(__ATOMIC_ACQUIRE, "agent");
            asm volatile("s_waitcnt vmcnt(0)" ::: "memory");
        }
    }
    __syncthreads();
}

template <int CTRL> __device__ __forceinline__ float dppx_f(float v) { return __builtin_bit_cast(float, __builtin_amdgcn_update_dpp(0, __builtin_bit_cast(int, v), CTRL, 0xf, 0xf, true)); }
template <int CTRL> __device__ __forceinline__ float dppo_f(float old, float v) { return __builtin_bit_cast(float, __builtin_amdgcn_update_dpp(__builtin_bit_cast(int, old), __builtin_bit_cast(int, v), CTRL, 0xf, 0xf, false)); }
namespace pg8 {
#define PG8_LAS __attribute__((address_space(3)))
constexpr int BM = 256, BK = 64, HALF = 128, HTB = HALF * BK * 2  , STAGE_BYTES = 8 * HTB, NXCD = 8, WGM = 8;
__host__ __device__ __forceinline__ int lds_byte(int r, int c) { const int st = (r >> 4) * 2 + (c >> 5), rr = r & 15, cc = c & 31, ob = rr * 64 + cc * 2; return st * 1024 + (ob ^ (((ob >> 9) & 1) << 5)); }
__host__ __device__ __forceinline__ void stage_rc(int b, int& R, int& C) { const int st = b / 1024, sb = b % 1024, swz = sb ^ (((sb >> 9) & 1) << 5); R = (st >> 1) * 16 + swz / 64; C = (st & 1) * 32 + (swz % 64) / 2; }
__host__ __device__ __forceinline__ int perm32(int rho) { const int n = rho >> 4, i = rho & 15; return 8 * (i >> 2) + 4 * n + (i & 3); }
struct Unit { int pm, pn; };
struct Gemm { const half_t* A; const half_t* Bt; int M, N, K; int a_step = 256, a_off = 0; };
struct StaticOrder {
    int nM, nN, nwg, G, c;
    __host__ __device__ void init(int M, int N, int G_, int c_) { nM = M / BM; nN = N / BM; nwg = nM * nN; G = G_; c = c_; }
    __host__ __device__ bool next(int i, Unit& u) const {
        const long L = (long)i * G + c; if (L >= nwg) return false;
        int wgid = (int)L; { const int q = nwg / NXCD, r = nwg % NXCD, xcd = wgid % NXCD, off = wgid / NXCD; wgid = (xcd < r ? xcd * (q + 1) : r * (q + 1) + (xcd - r) * q) + off; }
        const int nig = WGM * nN, gid = wgid / nig, fm = gid * WGM, gsz = (nM - fm) < WGM ? (nM - fm) : WGM;
        u.pm = fm + ((wgid % nig) % gsz); u.pn = (wgid % nig) / gsz; return true;
    }
    __device__ __forceinline__ void a_ready(const Unit&) const {}
    __device__ __forceinline__ void done(const Unit&) const {}
};
struct EpiF32 {
    static constexpr bool PERM = false, AFTER_DRAIN = false;
    float* C; int ldc;
    __device__ __forceinline__ void operator()(const f32x4 (&acc)[2][2][4][2], const Unit& u, int wr, int wc, int fr, int fq) const {
        const int row0 = u.pm * BM + wr * 64 + fr, col0 = u.pn * BM + wc * 32 + 4 * fq;
#pragma unroll
        for (int ai = 0; ai < 2; ++ai)
#pragma unroll
            for (int m = 0; m < 4; ++m) { float* rowp = C + (size_t)(row0 + ai * HALF + m * 16) * ldc + col0;
#pragma unroll
                for (int bj = 0; bj < 2; ++bj)
#pragma unroll
                    for (int n = 0; n < 2; ++n) *(f32x4*)(rowp + bj * HALF + n * 16) = acc[ai][bj][m][n]; }
    }
};
template <bool SCALE>
struct EpiH16T {
    static constexpr bool PERM = true, AFTER_DRAIN = false;
    half_t* O; int ldc; const float* rs = nullptr;
    __device__ __forceinline__ void operator()(const f32x4 (&acc)[2][2][4][2], const Unit& u, int wr, int wc, int fr, int fq) const {
        const int row0 = u.pm * BM + wr * 64 + fr, col0 = u.pn * BM + wc * 32 + 8 * fq;
        float sc[2][4];
#pragma unroll
        for (int ai = 0; ai < 2; ++ai)
#pragma unroll
            for (int m = 0; m < 4; ++m) sc[ai][m] = SCALE ? rs[row0 + ai * HALF + m * 16] : 1.f;
#pragma unroll
        for (int ai = 0; ai < 2; ++ai)
#pragma unroll
            for (int m = 0; m < 4; ++m) { half_t* rowp = O + (size_t)(row0 + ai * HALF + m * 16) * ldc + col0;
#pragma unroll
                for (int bj = 0; bj < 2; ++bj) { f32x4 v0 = acc[ai][bj][m][0], v1 = acc[ai][bj][m][1];
                    if (SCALE) { v0 *= sc[ai][m]; v1 *= sc[ai][m]; }
                    u32x4 w; w.x = pkh(v0[0], v0[1]); w.y = pkh(v0[2], v0[3]); w.z = pkh(v1[0], v1[1]); w.w = pkh(v1[2], v1[3]);
                    *(u32x4*)(rowp + bj * HALF) = w; } }
    }
};
using EpiH16 = EpiH16T<false>;
struct EpiConv {
    static constexpr bool PERM = true, AFTER_DRAIN = false;
    half_t* ACT; const float* cw; PG8_LAS float* xb; int Mrows, seq, dff, nup; const float* rs;
    __device__ __forceinline__ void operator()(f32x4 (&acc)[2][2][4][2], const Unit& u, int wr, int wc, int fr, int fq) const {
        int cc0 = wc * 32 + 8 * fq;
        asm volatile("" : "+v"(cc0));
        PG8_LAS float* wl = xb + 2048; PG8_LAS float* rsl = xb + 2048 + 768;
        if (fr >= 14) {
#pragma unroll
            for (int ai = 0; ai < 2; ++ai)
#pragma unroll
                for (int bj = 0; bj < 2; ++bj)
#pragma unroll
                    for (int n = 0; n < 2; ++n) *(PG8_LAS f32x4*)(xb + ((((2 * ai + wr) * 2 + (fr - 14)) * 2 + bj) * 128) + cc0 + 4 * n) = acc[ai][bj][3][n];
        }
        { const int t = (wr * 4 + wc) * 64 + fq * 16 + fr;
          for (int idx = t; idx < 768; idx += 512) { const int j = idx >> 8, col = idx & 255; wl[idx] = cw[(size_t)j * nup + (col >> 7) * dff + 128 * u.pn + (col & 127)]; }
          if (t < 256) { int gr = 254 * u.pm - 2 + t; gr = gr < 0 ? 0 : (gr >= Mrows ? Mrows - 1 : gr); rsl[t] = rs[gr]; } }
        asm volatile("s_waitcnt vmcnt(0) lgkmcnt(0)" ::: "memory"); __builtin_amdgcn_s_barrier(); asm volatile("" ::: "memory");
        const int gr0 = 254 * u.pm - 2;
        const bool hs = ((gr0 + 255) >> 11) != ((gr0 - 2) >> 11);
#pragma unroll
        for (int ai = 0; ai < 2; ++ai) {
            const int pred = 2 * ai + wr - 1;
#pragma unroll
            for (int mm = 0; mm < 4; ++mm) {
                const int m = 3 - mm;
                const int R = 128 * ai + 64 * wr + 16 * m + fr, gr = gr0 + R, ts = gr & (seq - 1);
                if (mm == 0) { const float rc = rsl[R];
#pragma unroll
                    for (int bj = 0; bj < 2; ++bj)
#pragma unroll
                        for (int n = 0; n < 2; ++n) acc[ai][bj][3][n] *= rc; }
                if (m > 0) { const float rp = rsl[R - 16];
#pragma unroll
                    for (int bj = 0; bj < 2; ++bj)
#pragma unroll
                        for (int n = 0; n < 2; ++n) acc[ai][bj][m > 0 ? m - 1 : 0][n] *= rp; }
                float rx0 = 0.f, rx1 = 0.f;
                if (m == 0 && pred >= 0) { rx0 = rsl[64 * pred + 62]; rx1 = rsl[64 * pred + 63]; }
#pragma unroll
                for (int n = 0; n < 2; ++n) {
                    f32x4 cv[2];
#pragma unroll
                    for (int bj = 0; bj < 2; ++bj) {
                        const f32x4 cur = acc[ai][bj][m][n];
                        f32x4 p1, p2;
                        if (m > 0) {
                            const f32x4 pv = acc[ai][bj][m > 0 ? m - 1 : 0][n];
#pragma unroll
                            for (int e = 0; e < 4; ++e) { const float q1 = dppx_f<0x121>(pv[e]), q2 = dppx_f<0x122>(pv[e]);
                                p1[e] = dppo_f<0x111>(q1, cur[e]); p2[e] = dppo_f<0x112>(q2, cur[e]); }
                        } else {
                            f32x4 x0 = (f32x4){0.f, 0.f, 0.f, 0.f}, x1 = x0;
                            if (pred >= 0) { x0 = *(const PG8_LAS f32x4*)(xb + (((pred * 2 + 0) * 2 + bj) * 128) + cc0 + 4 * n); x1 = *(const PG8_LAS f32x4*)(xb + (((pred * 2 + 1) * 2 + bj) * 128) + cc0 + 4 * n); x0 *= rx0; x1 *= rx1; }
#pragma unroll
                            for (int e = 0; e < 4; ++e) { const float o2 = (fr == 0) ? x0[e] : x1[e];
                                p1[e] = dppo_f<0x111>(x1[e], cur[e]); p2[e] = dppo_f<0x112>(o2, cur[e]); }
                        }
                        if (hs) {
#pragma unroll
                            for (int e = 0; e < 4; ++e) { p1[e] = (ts >= 1) ? p1[e] : 0.f; p2[e] = (ts >= 2) ? p2[e] : 0.f; }
                        }
                        const f32x4 w0 = *(const PG8_LAS f32x4*)(wl + 0 * 256 + bj * 128 + cc0 + 4 * n), w1 = *(const PG8_LAS f32x4*)(wl + 1 * 256 + bj * 128 + cc0 + 4 * n), w2 = *(const PG8_LAS f32x4*)(wl + 2 * 256 + bj * 128 + cc0 + 4 * n);
                        cv[bj] = w0 * p2 + w1 * p1 + w2 * cur;
                    }
                    float r_[4];
#pragma unroll
                    for (int e = 0; e < 4; ++e) { const float g_ = cv[0][e]; r_[e] = g_ * __builtin_amdgcn_rcpf(1.f + __builtin_amdgcn_exp2f(-1.4426950408889634f * g_)) * cv[1][e]; }
                    u32x2 o; o.x = pkh(r_[0], r_[1]); o.y = pkh(r_[2], r_[3]);
                    if (R >= 2 && gr < Mrows) *(u32x2*)(ACT + (size_t)gr * dff + 128 * u.pn + cc0 + 4 * n) = o;
                    asm volatile("" ::: "memory"); __builtin_amdgcn_sched_barrier(0);
                }
                asm volatile("" ::: "memory"); __builtin_amdgcn_sched_barrier(0);
            }
        }
    }
};
template <class Epi, class Sched, bool ALIGN_EPI = false, bool SP2 = false>
__device__ __forceinline__ void gemm_phase(PG8_LAS unsigned char* lds, const Gemm g, const Sched& S, const Epi& E) {
    const int tid = threadIdx.x, wid = __builtin_amdgcn_readfirstlane(tid >> 6), lane = tid & 63, wr = wid >> 2, wc = wid & 3, fr = lane & 15, fq = lane >> 4;
    const int K = g.K, nt = K / BK;
    unsigned voffA[2], voffB[2];
#pragma unroll
    for (int i = 0; i < 2; ++i) { int R, C; stage_rc(tid * 16 + i * 8192, R, C); const int Rb = Epi::PERM ? ((R & ~31) + perm32(R & 31)) : R;
        voffA[i] = (unsigned)(R * K + C) * 2u; voffB[i] = (unsigned)(Rb * K + C) * 2u; }
    const size_t kstep = (size_t)(BK * 2);
    const size_t hstep = (size_t)HALF * K * 2;
    const size_t tstep = 2 * hstep;
    const unsigned ldsw = (unsigned)wid * 1024u;
    const int aoff = lds_byte(wr * 64 + fr, fq * 8), boff = lds_byte(wc * 32 + fr, fq * 8);
#define PG8_SA(b, h) (((b) * 2 + (h)) * HTB)
#define PG8_SB(b, h) ((4 + (b) * 2 + (h)) * HTB)
#define PG8_STAGE(bufoff, gbase, voff) do { _Pragma("unroll") for (int _i = 0; _i < 2; ++_i) \
        __builtin_amdgcn_global_load_lds((const unsigned*)((const char*)(gbase) + (voff)[_i]), (PG8_LAS unsigned*)(lds + (bufoff) + ldsw + _i * 8192), 16, 0, 0); } while (0)
#define PG8_LDA(dst, b, h) do { _Pragma("unroll") for (int m = 0; m < 4; ++m) _Pragma("unroll") for (int k = 0; k < 2; ++k) dst[m][k] = *(const PG8_LAS h16x8*)(lds + PG8_SA(b, h) + aoff + m * 2048 + k * 1024); } while (0)
#define PG8_LDB(dst, b, h) do { _Pragma("unroll") for (int n = 0; n < 2; ++n) _Pragma("unroll") for (int k = 0; k < 2; ++k) dst[n][k] = *(const PG8_LAS h16x8*)(lds + PG8_SB(b, h) + boff + n * 2048 + k * 1024); } while (0)
#define PG8_MMA(ai, bj, At, Bt) do { __builtin_amdgcn_s_setprio(1); _Pragma("unroll") for (int m = 0; m < 4; ++m) _Pragma("unroll") for (int n = 0; n < 2; ++n) _Pragma("unroll") for (int k = 0; k < 2; ++k) \
        acc[ai][bj][m][n] = __builtin_amdgcn_mfma_f32_16x16x32_f16(Bt[n][k], At[m][k], acc[ai][bj][m][n], 0, 0, 0); __builtin_amdgcn_s_setprio(0); } while (0)
#define PG8_WAIT_V(n) asm volatile("s_waitcnt vmcnt(" #n ")" ::: "memory")
#define PG8_WAIT_L(n) asm volatile("s_waitcnt lgkmcnt(" #n ")" ::: "memory")
#define PG8_BAR __builtin_amdgcn_s_barrier()
#define PG8_SCHED __builtin_amdgcn_sched_barrier(0)
    Unit cur, nxt; int ui = 0;
    if (!S.next(0, cur)) return;
    f32x4 acc[2][2][4][2];
#pragma unroll
    for (int a = 0; a < 2; ++a)
#pragma unroll
        for (int b = 0; b < 2; ++b)
#pragma unroll
            for (int m = 0; m < 4; ++m)
#pragma unroll
                for (int n = 0; n < 2; ++n) acc[a][b][m][n] = (f32x4){0.f, 0.f, 0.f, 0.f};
    h16x8 At[4][2], B0[2][2], B1[2][2];
    const long arow_bytes = (long)K * 2; const char* cA = (const char*)g.A + ((long)cur.pm * g.a_step + g.a_off) * arow_bytes; const char* cB = (const char*)g.Bt + (size_t)cur.pn * tstep;
    S.a_ready(cur);
    if constexpr (SP2) {
        PG8_STAGE(PG8_SB(0, 0), cB, voffB); PG8_STAGE(PG8_SB(0, 1), cB + hstep, voffB); PG8_STAGE(PG8_SA(0, 0), cA, voffA); PG8_STAGE(PG8_SA(0, 1), cA + hstep, voffA);
        if (wr == 1) PG8_BAR;
        PG8_WAIT_V(2); PG8_BAR;
        PG8_STAGE(PG8_SB(1, 0), cB + kstep, voffB); PG8_STAGE(PG8_SA(1, 0), cA + kstep, voffA); PG8_STAGE(PG8_SB(1, 1), cB + hstep + kstep, voffB);
        PG8_WAIT_V(6); PG8_BAR;
    } else {
        PG8_STAGE(PG8_SB(0, 0), cB, voffB); PG8_STAGE(PG8_SA(0, 0), cA, voffA); PG8_STAGE(PG8_SB(0, 1), cB + hstep, voffB); PG8_STAGE(PG8_SA(0, 1), cA + hstep, voffA);
        if (wr == 1) PG8_BAR;
        PG8_WAIT_V(4); PG8_BAR;
        PG8_STAGE(PG8_SB(1, 0), cB + kstep, voffB); PG8_STAGE(PG8_SA(1, 0), cA + kstep, voffA); PG8_STAGE(PG8_SB(1, 1), cB + hstep + kstep, voffB);
        PG8_WAIT_V(6); PG8_BAR;
    }
    for (;;) {
        const bool has_next = S.next(ui + 1, nxt);
        const char* nA = has_next ? (const char*)g.A + ((long)nxt.pm * g.a_step + g.a_off) * arow_bytes : cA; const char* nB = has_next ? (const char*)g.Bt + (size_t)nxt.pn * tstep : cB;
        for (int t = 0; t < nt; t += 2) {
            const bool last = (t == nt - 2);
            const char* a1 = cA + (size_t)(t + 1) * kstep;
            const char* a2 = last ? nA : cA + (size_t)(t + 2) * kstep; const char* b2 = last ? nB : cB + (size_t)(t + 2) * kstep;
            const char* a3 = a2 + kstep; const char* b3 = b2 + kstep;
            if (last && has_next) S.a_ready(nxt);
            if constexpr (SP2) {
            PG8_LDB(B0, 0, 0); PG8_LDB(B1, 0, 1); PG8_SCHED; PG8_LDA(At, 0, 0); PG8_STAGE(PG8_SA(1, 1), a1 + hstep, voffA);
            PG8_WAIT_V(8); PG8_WAIT_L(0); PG8_BAR; PG8_MMA(0, 0, At, B0); PG8_MMA(0, 1, At, B1); PG8_BAR; PG8_SCHED;
            PG8_LDA(At, 0, 1); PG8_STAGE(PG8_SB(0, 0), b2, voffB); PG8_STAGE(PG8_SB(0, 1), b2 + hstep, voffB); PG8_STAGE(PG8_SA(0, 0), a2, voffA);
            PG8_WAIT_V(8); PG8_WAIT_L(0); PG8_BAR; PG8_MMA(1, 0, At, B0); PG8_MMA(1, 1, At, B1); PG8_BAR; PG8_SCHED;
            PG8_LDB(B0, 1, 0); PG8_LDB(B1, 1, 1); PG8_SCHED; PG8_LDA(At, 1, 0); PG8_STAGE(PG8_SA(0, 1), a2 + hstep, voffA);
            PG8_WAIT_V(8); PG8_WAIT_L(0); PG8_BAR; PG8_MMA(0, 0, At, B0); PG8_MMA(0, 1, At, B1); PG8_BAR; PG8_SCHED;
            PG8_LDA(At, 1, 1); PG8_STAGE(PG8_SB(1, 0), b3, voffB); PG8_STAGE(PG8_SB(1, 1), b3 + hstep, voffB); PG8_STAGE(PG8_SA(1, 0), a3, voffA);
            PG8_WAIT_V(8); PG8_WAIT_L(0); PG8_BAR; PG8_MMA(1, 0, At, B0); PG8_MMA(1, 1, At, B1); PG8_BAR; PG8_SCHED;
            } else {
            PG8_LDB(B0, 0, 0); PG8_SCHED; PG8_LDA(At, 0, 0); PG8_STAGE(PG8_SA(1, 1), a1 + hstep, voffA);
            PG8_WAIT_L(8); PG8_BAR; PG8_WAIT_L(0); PG8_MMA(0, 0, At, B0); PG8_BAR; PG8_SCHED;
            PG8_LDB(B1, 0, 1); PG8_STAGE(PG8_SB(0, 0), b2, voffB);
            PG8_BAR; PG8_WAIT_L(0); PG8_MMA(0, 1, At, B1); PG8_BAR;
            PG8_LDA(At, 0, 1); PG8_STAGE(PG8_SA(0, 0), a2, voffA);
            PG8_BAR; PG8_WAIT_L(0); PG8_MMA(1, 0, At, B0); PG8_BAR; PG8_SCHED;
            PG8_STAGE(PG8_SB(0, 1), b2 + hstep, voffB);
            PG8_WAIT_V(6); PG8_BAR; PG8_MMA(1, 1, At, B1); PG8_BAR;
            PG8_LDB(B0, 1, 0); PG8_SCHED; PG8_LDA(At, 1, 0); PG8_STAGE(PG8_SA(0, 1), a2 + hstep, voffA);
            PG8_WAIT_L(8); PG8_BAR; PG8_WAIT_L(0); PG8_MMA(0, 0, At, B0); PG8_BAR; PG8_SCHED;
            PG8_LDB(B1, 1, 1); PG8_STAGE(PG8_SB(1, 0), b3, voffB);
            PG8_BAR; PG8_WAIT_L(0); PG8_MMA(0, 1, At, B1); PG8_BAR;
            PG8_LDA(At, 1, 1); PG8_STAGE(PG8_SA(1, 0), a3, voffA);
            PG8_BAR; PG8_WAIT_L(0); PG8_MMA(1, 0, At, B0); PG8_BAR; PG8_SCHED;
            PG8_STAGE(PG8_SB(1, 1), b3 + hstep, voffB);
            PG8_WAIT_V(6); PG8_BAR; PG8_MMA(1, 1, At, B1); PG8_BAR;
            }
        }
        if constexpr (ALIGN_EPI) { if (wr == 0) PG8_BAR; }
        if constexpr (!Epi::AFTER_DRAIN) { E(acc, cur, wr, wc, fr, fq); S.done(cur); }
#if defined(PROBE_MASK) && ((PROBE_MASK >> 11) & 1)
        if constexpr (!Epi::AFTER_DRAIN) { asm volatile("" ::: "memory"); E(acc, cur, wr, wc, fr, fq); }
#endif
        if (!has_next) break;
#pragma unroll
        for (int a = 0; a < 2; ++a)
#pragma unroll
            for (int b = 0; b < 2; ++b)
#pragma unroll
                for (int m = 0; m < 4; ++m)
#pragma unroll
                    for (int n = 0; n < 2; ++n) acc[a][b][m][n] = (f32x4){0.f, 0.f, 0.f, 0.f};
        cur = nxt; cA = nA; cB = nB; ++ui;
        if constexpr (ALIGN_EPI) { if (wr == 1) PG8_BAR; }
    }
    PG8_WAIT_V(0);
    if constexpr (!ALIGN_EPI) { if (wr == 0) PG8_BAR; }
    PG8_BAR;
    if constexpr (Epi::AFTER_DRAIN) { E.fused(acc, cur, wr, wc, fr, fq, lds, wid, lane); S.done(cur); }
#undef PG8_SA
#undef PG8_SB
#undef PG8_STAGE
#undef PG8_LDA
#undef PG8_LDB
#undef PG8_MMA
#undef PG8_WAIT_V
#undef PG8_WAIT_L
#undef PG8_BAR
#undef PG8_SCHED
}
}

namespace fp {
using namespace cfg;
constexpr int NW = 8, NTH = 512;
constexpr int RING_BYTES = 131072, MISC_OFF = RING_BYTES, LDS_BYTES = 147456;
constexpr size_t MiB = 1u << 20;
constexpr size_t WS_CTL = 0, CTL_BYTES = 1 * MiB;
constexpr size_t WS_WIN0 = 1 * MiB, WS_WIN1 = WS_WIN0 + 12 * MiB, WS_WIN2 = WS_WIN1 + 24 * MiB, WS_WIN3 = WS_WIN2 + 32 * MiB;
constexpr size_t WS_WOUT = WS_WIN3 + 17 * MiB, WOUT_STRIDE = 8 * MiB;
constexpr size_t WS_WUP = WS_WOUT + 32 * MiB, WUP_STRIDE = 44 * MiB;
constexpr size_t WS_WDN = WS_WUP + 176 * MiB, WDN_STRIDE = 22 * MiB;
constexpr size_t WS_H = WS_WDN + 88 * MiB;
constexpr size_t WS_ZU = WS_H + 32 * MiB;
constexpr size_t WS_O = WS_ZU + 176 * MiB;
constexpr size_t WS_MF = WS_O + 32 * MiB;
constexpr size_t WS_ACT = WS_MF + 64 * MiB;
constexpr size_t WS_MBITS = WS_ACT + 64 * MiB;
constexpr size_t WS_HUT = WS_ACT;
constexpr size_t WS_HDEC = WS_ACT + 64 * MiB;
constexpr size_t WS_KW = WS_MBITS + 2 * MiB;
constexpr int DSA_MAIN = 4096, KW_LD = 96;
constexpr size_t WS_X16 = WS_ACT + 88 * MiB;
constexpr size_t WS_FAST_END = WS_X16 + 32 * MiB;
static_assert(WS_WIN0 + (size_t)SWA_IN * D * 2 == WS_WIN1 && WS_WIN1 + (size_t)DIFF_IN * D * 2 == WS_WIN2 && WS_WIN2 + (size_t)HGRN_IN * D * 2 == WS_WIN3 && WS_WIN3 + (size_t)DSA_PAD * D * 2 == WS_WOUT, "weights map");
static_assert((size_t)NUP * D * 2 == WUP_STRIDE && (size_t)DFF * D * 2 == WDN_STRIDE && (size_t)M * NUP * 2 == 176 * MiB && (size_t)M * DFF * 2 == 88 * MiB, "map sizes");
constexpr size_t WS_RS = WS_CTL + 512 * 1024;
constexpr int CW_TMO = 0, CW_BAR = 4096, CW_CK = 16384;

#define LDS_BARRIER() do { asm volatile("s_waitcnt lgkmcnt(0)" ::: "memory"); __builtin_amdgcn_s_barrier(); asm volatile("" ::: "memory"); } while (0)
struct Params {
    const float* in[19];
    float* out;
    unsigned char* ws;
    int ph_lo, ph_hi;
};
struct Ctx {
    LAS unsigned char* lds;
    int tid, lane, wave, vcu, G;
};

template <int CTRL> __device__ __forceinline__ float dpp_f(float v) { return __builtin_bit_cast(float, __builtin_amdgcn_update_dpp(0, __builtin_bit_cast(int, v), CTRL, 0xf, 0xf, true)); }
template <int CTRL> __device__ __forceinline__ int dpp_i(int v) { return __builtin_amdgcn_update_dpp(0, v, CTRL, 0xf, 0xf, true); }
__device__ __forceinline__ float rsum16(float v) { v += dpp_f<0xB1>(v); v += dpp_f<0x4E>(v); v += dpp_f<0x141>(v); v += dpp_f<0x140>(v); return v; }
__device__ __forceinline__ int rsum16i(int v) { v += dpp_i<0xB1>(v); v += dpp_i<0x4E>(v); v += dpp_i<0x141>(v); v += dpp_i<0x140>(v); return v; }
__device__ __forceinline__ float wsum64(float v) {
    const int iv = __builtin_bit_cast(int, rsum16(v));
    return (__builtin_bit_cast(float, __builtin_amdgcn_readlane(iv, 0)) + __builtin_bit_cast(float, __builtin_amdgcn_readlane(iv, 16))) +
           (__builtin_bit_cast(float, __builtin_amdgcn_readlane(iv, 32)) + __builtin_bit_cast(float, __builtin_amdgcn_readlane(iv, 48)));
}
__device__ __forceinline__ int wsum64i(int v) { v = rsum16i(v); return (__builtin_amdgcn_readlane(v, 0) + __builtin_amdgcn_readlane(v, 16)) + (__builtin_amdgcn_readlane(v, 32) + __builtin_amdgcn_readlane(v, 48)); }
__device__ __forceinline__ float sum16(float v) { v += __shfl_xor(v, 1); v += __shfl_xor(v, 2); v += __shfl_xor(v, 4); v += __shfl_xor(v, 8); return v; }
__device__ __forceinline__ float max16(float v) { v = fmaxf(v, __shfl_xor(v, 1)); v = fmaxf(v, __shfl_xor(v, 2)); v = fmaxf(v, __shfl_xor(v, 4)); v = fmaxf(v, __shfl_xor(v, 8)); return v; }

template <bool MAPUP = false>
__device__ __forceinline__ void transpose_tile(const Ctx& c, const float* __restrict__ W, int K, int N, half_t* __restrict__ WT, int item, int ntn, const float* __restrict__ gk = nullptr) {
    const int kb = item / ntn, nb = item % ntn, k0 = 64 * kb, n0 = 256 * nb, lane = c.lane, w = c.wave;
    LAS half_t* T = (LAS half_t*)c.lds;
    const int n = n0 + 4 * lane;
    f32x4 v[8];
#pragma unroll
    for (int i = 0; i < 8; ++i) v[i] = (n < N) ? *(const f32x4*)(W + (size_t)(k0 + 8 * w + i) * N + n) : (f32x4){0.f, 0.f, 0.f, 0.f};
    if (gk) {
#pragma unroll
        for (int i = 0; i < 8; ++i) v[i] *= gk[k0 + 8 * w + i];
    }
#pragma unroll
    for (int e = 0; e < 4; ++e) { u32x4 o; o.x = pkh(v[0][e], v[1][e]); o.y = pkh(v[2][e], v[3][e]); o.z = pkh(v[4][e], v[5][e]); o.w = pkh(v[6][e], v[7][e]);
        *(LAS u32x4*)(T + (4 * lane + e) * 72 + 8 * w) = o; }
    LDS_BARRIER();
#pragma unroll
    for (int i = 0; i < 4; ++i) { const int id = c.tid + NTH * i, row = id >> 3, ch = id & 7;
        const u32x4 o = *(const LAS u32x4*)(T + row * 72 + 8 * ch);
        int drow = n0 + row;
        if (MAPUP) { const int nn = drow < DFF ? drow : drow - DFF; drow = 256 * (nn >> 7) + (nn & 127) + (drow < DFF ? 0 : 128); }
        *(u32x4*)(WT + (size_t)drow * K + k0 + 8 * ch) = o; }
    LDS_BARRIER();
}
__device__ __forceinline__ void norm_row_first(const float* __restrict__ xrow, half_t* __restrict__ xout, float* __restrict__ rs, int lane) {
    f32x4 v[8]; float ss = 0.f;
#pragma unroll
    for (int j = 0; j < 8; ++j) { v[j] = *(const f32x4*)(xrow + 4 * lane + 256 * j); ss += (v[j].x * v[j].x + v[j].y * v[j].y) + (v[j].z * v[j].z + v[j].w * v[j].w); }
    const float r = rsqrtf(wsum64(ss) * (1.f / D) + RMS_EPS);
    if (lane == 0) *rs = r;
#pragma unroll
    for (int j = 0; j < 8; ++j) { u32x2 xo; xo.x = pkh(v[j].x, v[j].y); xo.y = pkh(v[j].z, v[j].w); *(u32x2*)(xout + 4 * lane + 256 * j) = xo; }
}
constexpr int I_UP = 32 * (NUP / 256), I_DN = (DFF / 64) * (D / 256), FFN_TILES = I_UP + I_DN;
__device__ __forceinline__ void ffn_weight_tile(const Ctx& c, const Params& p, int l, int t) {
    unsigned char* ws = p.ws;
    if (t < I_UP) transpose_tile<true>(c, p.in[4] + (size_t)l * D * NUP, D, NUP, (half_t*)(ws + WS_WUP + l * WUP_STRIDE), t, NUP / 256, p.in[3] + (size_t)(4 * l + 2) * D);
    else transpose_tile(c, p.in[6] + (size_t)l * DFF * D, DFF, D, (half_t*)(ws + WS_WDN + l * WDN_STRIDE), t - I_UP, D / 256);
}
constexpr int DEFER_PER_WG = 10, DEFER_G1 = 128 * DEFER_PER_WG, DEFER_G3 = 84 * DEFER_PER_WG;
static_assert(DEFER_G1 + DEFER_G3 >= FFN_TILES, "layer 1's FFN weights fit the two spare slots");
__device__ __forceinline__ void spare_slot_convert(const Ctx& c, const Params& p, int l, int first, int last, int rank) {
    for (int i = 0; i < DEFER_PER_WG; ++i) { const int t = first + rank * DEFER_PER_WG + i; if (t < last) ffn_weight_tile(c, p, l, t); }
}
__device__ __forceinline__ void prologue_phase(const Ctx& c, const Params& p) {
    const int gw = c.vcu * NW + c.wave, NGW = c.G * NW;
    unsigned char* ws = p.ws;
    constexpr int I_W0 = 32 * (SWA_IN / 256), I_W1 = 32 * (DIFF_IN / 256), I_W2 = 32 * (HGRN_IN / 256), I_W3 = 32 * (DSA_PAD / 256), I_WO = 32 * (D / 256);
    constexpr int I_F23 = FFN_TILES - DEFER_G3;
    constexpr int NITEMS = I_W0 + I_W1 + I_W2 + I_W3 + 4 * I_WO + FFN_TILES + 2 * I_F23;
    const bool defer = (c.G == 256);
    const int nitems = defer ? NITEMS : NITEMS + FFN_TILES + 2 * DEFER_G3;
    for (int it = c.vcu; it < nitems; it += c.G) {
        int r = it;
        if (r < I_W0) { transpose_tile(c, p.in[7], D, SWA_IN, (half_t*)(ws + WS_WIN0), r, SWA_IN / 256, p.in[3]); continue; } r -= I_W0;
        if (r < I_W1) { transpose_tile(c, p.in[10], D, DIFF_IN, (half_t*)(ws + WS_WIN1), r, DIFF_IN / 256, p.in[3] + 4 * D); continue; } r -= I_W1;
        if (r < I_W2) { transpose_tile(c, p.in[14], D, HGRN_IN, (half_t*)(ws + WS_WIN2), r, HGRN_IN / 256, p.in[3] + 8 * D); continue; } r -= I_W2;
        if (r < I_W3) { transpose_tile(c, p.in[17], D, DSA_IN, (half_t*)(ws + WS_WIN3), r, DSA_PAD / 256, p.in[3] + 12 * D); continue; } r -= I_W3;
        if (r < 4 * I_WO) { const int l = r / I_WO; r -= l * I_WO; const float* src = l == 0 ? p.in[8] : l == 1 ? p.in[11] : l == 2 ? p.in[15] : p.in[18];
            transpose_tile(c, src, D, D, (half_t*)(ws + WS_WOUT + l * WOUT_STRIDE), r, D / 256); continue; } r -= 4 * I_WO;
        if (r < FFN_TILES) { ffn_weight_tile(c, p, 0, r); continue; } r -= FFN_TILES;
        if (r < I_F23) { ffn_weight_tile(c, p, 2, DEFER_G3 + r); continue; } r -= I_F23;
        if (r < I_F23) { ffn_weight_tile(c, p, 3, DEFER_G3 + r); continue; } r -= I_F23;
        if (r < FFN_TILES) { ffn_weight_tile(c, p, 1, r); continue; } r -= FFN_TILES;
        if (r < DEFER_G3) { ffn_weight_tile(c, p, 2, r); continue; } r -= DEFER_G3;
        ffn_weight_tile(c, p, 3, r);
    }
    const float* x = p.in[0];
    for (int m = gw; m < M; m += NGW) norm_row_first(x + (size_t)m * D, (half_t*)(ws + WS_X16) + (size_t)m * D, (float*)(ws + WS_RS) + m, c.lane);
}

__device__ __forceinline__ void resnorm_phase(const Ctx& c, half_t* __restrict__ X, const half_t* __restrict__ MF, const float* __restrict__ g1, float* __restrict__ RS, float* __restrict__ out32) {
    const int gw = c.vcu * NW + c.wave, NGW = c.G * NW, lane = c.lane;
    for (int m = gw; m < M; m += NGW) {
        const half_t* mf = MF + (size_t)m * D; half_t* xr = X + (size_t)m * D;
        f32x4 v[8]; h16x4 xh[8]; float ss = 0.f;
#pragma unroll
        for (int j = 0; j < 8; ++j) { const h16x4 hv = *(const h16x4*)(mf + 4 * lane + 256 * j); xh[j] = *(const h16x4*)(xr + 4 * lane + 256 * j); v[j] = (f32x4){(float)hv[0], (float)hv[1], (float)hv[2], (float)hv[3]};
            ss += (v[j].x * v[j].x + v[j].y * v[j].y) + (v[j].z * v[j].z + v[j].w * v[j].w); }
        const float r1 = rsqrtf(wsum64(ss) * (1.f / D) + RMS_EPS);
        float s2 = 0.f;
#pragma unroll
        for (int j = 0; j < 8; ++j) { const f32x4 gg = *(const f32x4*)(g1 + 4 * lane + 256 * j); const f32x4 xx = (f32x4){(float)xh[j][0], (float)xh[j][1], (float)xh[j][2], (float)xh[j][3]};
            v[j] = xx + v[j] * r1 * gg; s2 += (v[j].x * v[j].x + v[j].y * v[j].y) + (v[j].z * v[j].z + v[j].w * v[j].w);
            if (out32) *(f32x4*)(out32 + (size_t)m * D + 4 * lane + 256 * j) = v[j];
            else { u32x2 xo; xo.x = pkh(v[j].x, v[j].y); xo.y = pkh(v[j].z, v[j].w); *(u32x2*)(xr + 4 * lane + 256 * j) = xo; } }
        if (RS) { const float r2 = rsqrtf(wsum64(s2) * (1.f / D) + RMS_EPS); if (lane == 0) RS[m] = r2; }
    }
}
__device__ __forceinline__ void convact_phase(const Ctx& c, const half_t* __restrict__ U, const float* __restrict__ cw, half_t* __restrict__ ACT) {
    const int gw = c.vcu * NW + c.wave, NGW = c.G * NW, lane = c.lane;
    constexpr int NCC = DFF / 512, NRB = M / 16;
    for (int it = gw; it < NCC * NRB; it += NGW) {
        const int cc = it % NCC, rb = it / NCC, c0 = cc * 512 + lane * 8, r0 = rb * 16, t0 = r0 % S;
        float wg[3][8], wv[3][8];
#pragma unroll
        for (int j = 0; j < 3; ++j) {
            const f32x4 a0 = *(const f32x4*)(cw + j * NUP + c0), a1 = *(const f32x4*)(cw + j * NUP + c0 + 4);
            const f32x4 b0 = *(const f32x4*)(cw + j * NUP + DFF + c0), b1 = *(const f32x4*)(cw + j * NUP + DFF + c0 + 4);
#pragma unroll
            for (int e = 0; e < 4; ++e) { wg[j][e] = a0[e]; wg[j][4 + e] = a1[e]; wv[j][e] = b0[e]; wv[j][4 + e] = b1[e]; }
        }
        float g2[8], g1[8], v2[8], v1[8];
        if (t0 == 0) {
#pragma unroll
            for (int e = 0; e < 8; ++e) { g2[e] = 0.f; g1[e] = 0.f; v2[e] = 0.f; v1[e] = 0.f; }
        } else {
            const h16x8 a = *(const h16x8*)(U + (size_t)(r0 - 2) * NUP + c0), b = *(const h16x8*)(U + (size_t)(r0 - 1) * NUP + c0);
            const h16x8 cgv = *(const h16x8*)(U + (size_t)(r0 - 2) * NUP + DFF + c0), d = *(const h16x8*)(U + (size_t)(r0 - 1) * NUP + DFF + c0);
#pragma unroll
            for (int e = 0; e < 8; ++e) { g2[e] = (float)a[e]; g1[e] = (float)b[e]; v2[e] = (float)cgv[e]; v1[e] = (float)d[e]; }
        }
        for (int r = r0; r < r0 + 16; ++r) {
            const h16x8 gc = *(const h16x8*)(U + (size_t)r * NUP + c0), vc = *(const h16x8*)(U + (size_t)r * NUP + DFF + c0);
            float o[8];
#pragma unroll
            for (int e = 0; e < 8; ++e) {
                const float gcur = (float)gc[e], vcur = (float)vc[e];
                const float gg = wg[0][e] * g2[e] + wg[1][e] * g1[e] + wg[2][e] * gcur;
                const float vv = wv[0][e] * v2[e] + wv[1][e] * v1[e] + wv[2][e] * vcur;
                o[e] = gg * fsigm(gg) * vv;
                g2[e] = g1[e]; g1[e] = gcur; v2[e] = v1[e]; v1[e] = vcur;
            }
            u32x4 w; w.x = pkh(o[0], o[1]); w.y = pkh(o[2], o[3]); w.z = pkh(o[4], o[5]); w.w = pkh(o[6], o[7]);
            *(u32x4*)(ACT + (size_t)r * DFF + c0) = w;
        }
    }
}
__device__ __forceinline__ void hgrn_normgate_phase(const Ctx& c, const float* __restrict__ OR, const half_t* __restrict__ Z, const float* __restrict__ ng, half_t* __restrict__ O) {
    const int gw = c.vcu * NW + c.wave, NGW = c.G * NW, lane = c.lane;
    const f32x4 gn = *(const f32x4*)(ng + ((4 * lane) & 127));
    for (int m = gw; m < M; m += NGW) {
        const float* orow = OR + (size_t)m * D; const half_t* grow = Z + (size_t)m * HGRN_IN + 6144; half_t* out = O + (size_t)m * D;
        f32x4 v[8]; h16x4 gt[8];
#pragma unroll
        for (int j = 0; j < 8; ++j) { v[j] = *(const f32x4*)(orow + 4 * lane + 256 * j); gt[j] = *(const h16x4*)(grow + 4 * lane + 256 * j); }
#pragma unroll
        for (int j = 0; j < 8; ++j) {
            const int col = 4 * lane + 256 * j;
            float ss = (v[j].x * v[j].x + v[j].y * v[j].y) + (v[j].z * v[j].z + v[j].w * v[j].w);
            ss = rsum16(ss); ss += __shfl_xor(ss, 16);
            const float r = rsqrtf(ss * (1.f / 128.f) + RMS_EPS);
            float o[4];
#pragma unroll
            for (int e = 0; e < 4; ++e) { const float gv = (float)gt[j][e]; o[e] = v[j][e] * r * gn[e] * (gv * fsigm(gv)); }
            u32x2 w; w.x = pkh(o[0], o[1]); w.y = pkh(o[2], o[3]);
            *(u32x2*)(out + col) = w;
        }
    }
}

typedef float f32x16 __attribute__((ext_vector_type(16)));
#define MFMA32(a, b, c) __builtin_amdgcn_mfma_f32_32x32x16_f16((a), (b), (c), 0, 0, 0)
constexpr float LOG2E = 1.4426950408889634f, C2 = 0.125f * LOG2E, ATT_THR = 8.0f, NEGBIG = -1e30f;
__device__ __forceinline__ int crow(int r, int hi) { return (r & 3) + 8 * (r >> 2) + 4 * hi; }
__device__ __forceinline__ float xhalf_max(float m) { auto rr = __builtin_amdgcn_permlane32_swap(__float_as_uint(m), __float_as_uint(m), false, false); return fmaxf(__uint_as_float(rr[0]), __uint_as_float(rr[1])); }
__device__ __forceinline__ float xhalf_sum(float m) { auto rr = __builtin_amdgcn_permlane32_swap(__float_as_uint(m), __float_as_uint(m), false, false); return __uint_as_float(rr[0]) + __uint_as_float(rr[1]); }

typedef short v4i16_t __attribute__((ext_vector_type(4)));
template <int NDB, bool NEAR, int AM, bool SWZ = false>
__device__ __forceinline__ void attn_tile(const LAS half_t* Kt, const LAS half_t* Vr, const h16x8 (&qf)[4], float& mhat, float& lsum, f32x16 (&o)[NDB],
                                          LAS float* wsf, const LAS float* bd2, int qrel, unsigned mw0, unsigned mw1, int r32, int hi, bool start) {
    f32x16 pp[2];
    constexpr bool UPFRONT = (NDB == 2);
    if (UPFRONT) {
        const int KRS = SWZ ? 64 : 72, sw = SWZ ? ((r32 >> 1) & 7) : 0;
        const LAS half_t* kp = Kt + r32 * KRS;
        const f32x16 z = {0.f, 0.f, 0.f, 0.f, 0.f, 0.f, 0.f, 0.f, 0.f, 0.f, 0.f, 0.f, 0.f, 0.f, 0.f, 0.f};
        pp[0] = MFMA32(*(const LAS h16x8*)(kp + ((hi ^ sw) * 8)), qf[0], z); pp[1] = MFMA32(*(const LAS h16x8*)(kp + 32 * KRS + ((hi ^ sw) * 8)), qf[0], z);
#pragma unroll
        for (int ks = 1; ks < 4; ++ks) { pp[0] = MFMA32(*(const LAS h16x8*)(kp + (((2 * ks + hi) ^ sw) * 8)), qf[ks], pp[0]); pp[1] = MFMA32(*(const LAS h16x8*)(kp + 32 * KRS + (((2 * ks + hi) ^ sw) * 8)), qf[ks], pp[1]); }
#if defined(PROBE_MASK) && ((PROBE_MASK >> 13) & 1)
        { f32x16 t0 = z, t1 = z;
#pragma unroll
          for (int ks = 0; ks < 4; ++ks) { t0 = MFMA32(*(const LAS h16x8*)(kp + 16 * ks), qf[ks], t0); t1 = MFMA32(*(const LAS h16x8*)(kp + 32 * 72 + 16 * ks), qf[ks], t1); }
#pragma unroll
          for (int r = 0; r < 16; ++r) { pp[0][r] = 0.5f * (pp[0][r] + t0[r]); pp[1][r] = 0.5f * (pp[1][r] + t1[r]); } }
#endif
    }
#pragma unroll
    for (int blk = 0; blk < 2; ++blk) {
        f32x16 p;
        if (UPFRONT) p = pp[blk];
        else if (!SWZ) {
            const LAS half_t* kp = Kt + (32 * blk + r32) * 72 + 8 * hi;
            const f32x16 z = {0.f, 0.f, 0.f, 0.f, 0.f, 0.f, 0.f, 0.f, 0.f, 0.f, 0.f, 0.f, 0.f, 0.f, 0.f, 0.f};
            p = MFMA32(*(const LAS h16x8*)(kp), qf[0], z);
#pragma unroll
            for (int ks = 1; ks < 4; ++ks) p = MFMA32(*(const LAS h16x8*)(kp + 16 * ks), qf[ks], p);
        } else {
            const LAS half_t* kp = Kt + (32 * blk + r32) * 64; const int sw = (r32 >> 1) & 7;
            const f32x16 z = {0.f, 0.f, 0.f, 0.f, 0.f, 0.f, 0.f, 0.f, 0.f, 0.f, 0.f, 0.f, 0.f, 0.f, 0.f, 0.f};
            p = MFMA32(*(const LAS h16x8*)(kp + ((hi ^ sw) * 8)), qf[0], z);
#pragma unroll
            for (int ks = 1; ks < 4; ++ks) p = MFMA32(*(const LAS h16x8*)(kp + (((2 * ks + hi) ^ sw) * 8)), qf[ks], p);
        }
#pragma unroll
        for (int r = 0; r < 16; ++r) p[r] = fmaf(p[r], C2, -mhat);
        if (NEAR) {
#pragma unroll
            for (int r = 0; r < 16; ++r) {
                const int d0 = qrel - 32 * blk - ((r & 3) + 8 * (r >> 2));
                const int i0 = d0 < 0 ? 0 : (d0 > 128 ? 128 : d0);
                const bool ok0 = (AM == 0) ? (d0 >= 0 && d0 < 128) : (d0 >= 0);
                p[r] = ok0 ? p[r] + bd2[i0] : NEGBIG;
                if (NDB > 2 && (r & 7) == 7) asm volatile("" ::: "memory");
            }
        }
        if (AM == 1) {
            const unsigned ws = (blk == 0 ? mw0 : mw1) >> (4 * hi);
#pragma unroll
            for (int r = 0; r < 16; ++r) { const unsigned bit = 1u << ((r & 3) + 8 * (r >> 2)); p[r] = (ws & bit) ? p[r] : NEGBIG; }
        }
        float rm;
        { const float a0 = fmaxf(fmaxf(p[0], p[1]), fmaxf(p[2], p[3])), a1 = fmaxf(fmaxf(p[4], p[5]), fmaxf(p[6], p[7])), a2 = fmaxf(fmaxf(p[8], p[9]), fmaxf(p[10], p[11])), a3 = fmaxf(fmaxf(p[12], p[13]), fmaxf(p[14], p[15]));
          rm = fmaxf(fmaxf(a0, a1), fmaxf(a2, a3)); }
        rm = xhalf_max(rm);
        if (start && blk == 0) {
            const float dl = (rm > -1e29f) ? rm : 0.f; mhat += dl;
#pragma unroll
            for (int r = 0; r < 16; ++r) p[r] -= dl;
        } else if (__any(rm > ATT_THR)) {
            const float dl = (rm > ATT_THR) ? rm : 0.f; mhat += dl;
#pragma unroll
            for (int r = 0; r < 16; ++r) p[r] -= dl;
            const float f = fexp2(-dl); lsum *= f;
            if (hi == 0) wsf[r32] = f;
#pragma unroll
            for (int r = 0; r < 16; ++r) { const float fr_ = wsf[crow(r, hi)];
#pragma unroll
                for (int d = 0; d < NDB; ++d) o[d][r] *= fr_;
                if (NDB > 2 && (r & 3) == 3) asm volatile("" ::: "memory"); }
        }
#if defined(PROBE_MASK) && ((PROBE_MASK >> 14) & 1)
#pragma unroll
        for (int r = 0; r < 16; ++r) { float t_ = fexp2(p[r] - 40.f); asm volatile("" : "+v"(t_)); p[r] += t_ * 1e-30f; }
#endif
#pragma unroll
        for (int r = 0; r < 16; ++r) p[r] = fexp2(p[r]);
        lsum += ((p[0] + p[1]) + (p[2] + p[3])) + ((p[4] + p[5]) + (p[6] + p[7])) + (((p[8] + p[9]) + (p[10] + p[11])) + ((p[12] + p[13]) + (p[14] + p[15])));
        u32x4 pw[2];
        pw[0] = (u32x4){pkh(p[0], p[1]), pkh(p[2], p[3]), pkh(p[4], p[5]), pkh(p[6], p[7])};
        pw[1] = (u32x4){pkh(p[8], p[9]), pkh(p[10], p[11]), pkh(p[12], p[13]), pkh(p[14], p[15])};
        constexpr int VSTR = SWZ ? 32 * NDB : 32 * NDB + 32;
        const int j4 = (r32 & 15) >> 2, vsw = (NDB == 4) ? j4 : (j4 >> 1);
        const LAS half_t* vb = SWZ ? Vr + (32 * blk + 4 * hi + j4) * VSTR + 4 * (r32 & 1)
                                   : Vr + (32 * blk + 4 * hi + j4) * VSTR + 16 * (r32 >> 4) + 4 * (r32 & 3);
#pragma unroll
        for (int d = 0; d < NDB; ++d) {
            const int vco = SWZ ? ((((d ^ vsw) << 2) | (2 * (r32 >> 4)) | ((r32 & 3) >> 1)) * 8) : 32 * d;
#pragma unroll
            for (int s2 = 0; s2 < 2; ++s2) {
                const v4i16_t lo = __builtin_amdgcn_ds_read_tr16_b64_v4i16((LAS v4i16_t*)(vb + (16 * s2) * VSTR + vco));
                const v4i16_t hi2 = __builtin_amdgcn_ds_read_tr16_b64_v4i16((LAS v4i16_t*)(vb + (16 * s2 + 8) * VSTR + vco));
                typedef short s16x8 __attribute__((ext_vector_type(8)));
                const s16x8 vv = (s16x8){lo[0], lo[1], lo[2], lo[3], hi2[0], hi2[1], hi2[2], hi2[3]};
                o[d] = MFMA32(__builtin_bit_cast(h16x8, pw[s2]), __builtin_bit_cast(h16x8, vv), o[d]);
            }
            if (NDB > 2 && (d & 1)) asm volatile("" ::: "memory");
        }
    }
}

template <int AM>
__device__ __forceinline__ void gqa_phase(const Ctx& c, const half_t* __restrict__ Z, int ldz, int koff, int voff, const float* __restrict__ bias, const float* __restrict__ sinks,
                                          const unsigned* __restrict__ mbits, half_t* __restrict__ O) {
    const int tid = c.tid, lane = c.lane, w = c.wave, r32 = lane & 31, hi = lane >> 5;
    constexpr int VS = 96;
    LAS half_t* Kb = (LAS half_t*)c.lds;
    LAS half_t* Vb = Kb + 2 * 64 * 72;
    constexpr int GQA_TILE_BYTES = (2 * 64 * 72 + 2 * 64 * VS) * 2;
    LAS float* wsf = (LAS float*)(c.lds + GQA_TILE_BYTES) + w * 64;
    LAS float* btab = (LAS float*)(c.lds + GQA_TILE_BYTES + 8 * 64 * 4);
    for (int i = tid; i < 32 * 129; i += NTH) { const int h = i / 129, d = i % 129; const int bk = d < 128 ? (int)BUCKET_LUT[d] : 31; btab[h * 132 + d] = (bias[bk * 32 + h] - bias[31 * 32 + h]) * LOG2E; }
    const int skey = tid >> 3, sch = tid & 7;
    for (int U = c.vcu; U < 1024; U += c.G) {
        const int grp = U & 255, ui = U >> 8, bkv = grp >> 3, sx = grp & 7;
        const int qb = (ui == 0) ? sx : (ui == 1) ? 15 - sx : (ui == 2) ? 16 + sx : 31 - sx;
        const int b = bkv >> 3, kvh = bkv & 7, h = kvh * 4 + (w >> 1);
        const int qw0 = qb * 64 + 32 * (w & 1), q = qw0 + r32;
        const size_t rowbase = (size_t)b * S;
        h16x8 qf[4];
#pragma unroll
        for (int ks = 0; ks < 4; ++ks) qf[ks] = *(const h16x8*)(Z + (rowbase + q) * ldz + h * 64 + 16 * ks + 8 * hi);
        float mhat = 0.f, lsum = 0.f;
        if (AM == 0) { mhat = (sinks[h] - bias[31 * 32 + h]) * LOG2E; lsum = (hi == 0) ? 1.f : 0.f; }
        f32x16 o[2];
#pragma unroll
        for (int d = 0; d < 2; ++d)
#pragma unroll
            for (int r = 0; r < 16; ++r) o[d][r] = 0.f;
        const int kt_lo = (AM == 0) ? (qb >= 2 ? qb - 2 : 0) : 0;
        const LAS float* bt = btab + h * 132;
        const half_t* sbase = Z + (rowbase + skey) * ldz + kvh * 64 + sch * 8;
        const unsigned* mrow = mbits + (rowbase + q) * 64;
        u32x4 kreg = *(const u32x4*)(sbase + (size_t)(64 * kt_lo) * ldz + koff);
        h16x8 vreg = *(const h16x8*)(sbase + (size_t)(64 * kt_lo) * ldz + voff);
        u32x2 mnext = (u32x2){0xffffffffu, 0xffffffffu};
        if (AM == 1) mnext = *(const u32x2*)(mrow + 2 * kt_lo);
        LDS_BARRIER();
        {
            *(LAS u32x4*)(Kb + skey * 72 + sch * 8) = kreg;
            *(LAS h16x8*)(Vb + skey * VS + sch * 8) = vreg;
        }
        if (kt_lo < qb) { kreg = *(const u32x4*)(sbase + (size_t)(64 * (kt_lo + 1)) * ldz + koff); vreg = *(const h16x8*)(sbase + (size_t)(64 * (kt_lo + 1)) * ldz + voff); }
        LDS_BARRIER();
        for (int kt = kt_lo; kt <= qb; ++kt) {
            const int cur = (kt - kt_lo) & 1;
            const u32x2 mcur = mnext;
            if (kt < qb) {
                LAS half_t* Kn = Kb + (cur ^ 1) * (64 * 72); LAS half_t* Vn = Vb + (cur ^ 1) * (64 * VS);
                *(LAS u32x4*)(Kn + skey * 72 + sch * 8) = kreg;
                *(LAS h16x8*)(Vn + skey * VS + sch * 8) = vreg;
                if (AM == 1) mnext = *(const u32x2*)(mrow + 2 * (kt + 1));
                if (kt + 1 < qb) { kreg = *(const u32x4*)(sbase + (size_t)(64 * (kt + 2)) * ldz + koff); vreg = *(const h16x8*)(sbase + (size_t)(64 * (kt + 2)) * ldz + voff); }
            }
            const LAS half_t* Kt = Kb + cur * (64 * 72); const LAS half_t* Vt = Vb + cur * (64 * VS);
            const int qrel = q - 64 * kt - 4 * hi;
            const bool start = (AM == 1) && (kt == kt_lo);
            const bool near = (AM == 0) || (64 * kt + 191 > qw0);
            if (near) attn_tile<2, true, AM>(Kt, Vt, qf, mhat, lsum, o, wsf, bt, qrel, mcur.x, mcur.y, r32, hi, start);
            else attn_tile<2, false, AM>(Kt, Vt, qf, mhat, lsum, o, wsf, bt, qrel, mcur.x, mcur.y, r32, hi, start);
            LDS_BARRIER();
#if defined(PROBE_MASK) && ((PROBE_MASK >> 12) & 1)
            LDS_BARRIER(); LDS_BARRIER();
#endif
        }
        {
            const float lt = xhalf_sum(lsum);
            if (hi == 0) wsf[r32] = 1.f / lt;
            float inv[16];
#pragma unroll
            for (int r = 0; r < 16; ++r) inv[r] = wsf[crow(r, hi)];
#pragma unroll
            for (int r = 0; r < 16; ++r) {
                half_t* op = O + (rowbase + qw0 + crow(r, hi)) * D + h * 64 + r32;
                op[0] = (half_t)(o[0][r] * inv[r]); op[32] = (half_t)(o[1][r] * inv[r]);
            }
        }
    }
    LDS_BARRIER();
}

__device__ __forceinline__ void diff_phase(const Ctx& c, const half_t* __restrict__ Z, const float* __restrict__ bias, const float* __restrict__ lambdas, const float* __restrict__ subg,
                                           float lam_init, half_t* __restrict__ O) {
    const int tid = c.tid, lane = c.lane, w = c.wave, r32 = lane & 31, hi = lane >> 5;
    constexpr int ldz = DIFF_IN;
    constexpr int KIMG = 64 * 64, VIMG = 64 * 128, BUF_H = 2 * KIMG + VIMG;
    LAS half_t* ring = (LAS half_t*)c.lds;
    constexpr int TILE_BYTES = 3 * BUF_H * 2;
    LAS float* cb = (LAS float*)c.lds;
    static_assert(128 * 132 * 4 <= TILE_BYTES, "combine buffer");
    LAS float* wsf = (LAS float*)(c.lds + TILE_BYTES) + w * 64;
    LAS float* btab = (LAS float*)(c.lds + TILE_BYTES + 8 * 64 * 4);
    static_assert(TILE_BYTES + 8 * 64 * 4 + 32 * 132 * 4 <= RING_BYTES, "diff LDS");
    for (int i = tid; i < 32 * 129; i += NTH) { const int h = i / 129, d = i % 129; const int bk = d < 128 ? (int)BUCKET_LUT[d] : 31; btab[h * 132 + d] = (bias[bk * 32 + h] - bias[31 * 32 + h]) * LOG2E; }
    float lam;
    { float l1 = lambdas[lane] * lambdas[64 + lane], l2 = lambdas[128 + lane] * lambdas[192 + lane]; l1 = wsum64(l1); l2 = wsum64(l2); lam = expf(l1) - expf(l2) + lam_init; }
    const int mp = w & 1, rg = w >> 1;
    const int kkey = 8 * w + (lane >> 3), kch = (lane & 7) ^ ((kkey >> 1) & 7);
    const int vkey0 = 8 * w + (lane >> 4), vkey1 = vkey0 + 4, vch0 = (lane & 15) ^ (4 * (vkey0 & 3)), vch1 = (lane & 15) ^ (4 * (vkey1 & 3));
    for (int U = c.vcu; U < 1024; U += c.G) {
        const int grp = U & 255, ui = U >> 8, bh = grp >> 2, sx = grp & 3;
        const int qb = (ui == 0) ? sx : (ui == 1) ? 7 - sx : (ui == 2) ? 8 + sx : 15 - sx;
        const int b = bh >> 4, hd = bh & 15;
        const int qw0 = qb * 128 + 32 * rg, q = qw0 + r32;
        const size_t rowbase = (size_t)b * S;
        h16x8 qf[4];
#pragma unroll
        for (int ks = 0; ks < 4; ++ks) qf[ks] = *(const h16x8*)(Z + (rowbase + q) * ldz + hd * 128 + mp * 64 + 16 * ks + 8 * hi);
        float mhat = 0.f, lsum = 0.f;
        f32x16 o[4];
#pragma unroll
        for (int d = 0; d < 4; ++d)
#pragma unroll
            for (int r = 0; r < 16; ++r) o[d][r] = 0.f;
        const LAS float* bt = btab + (hd * 2 + mp) * 132;
        const int kt_hi = 2 * qb + 1;
        const half_t* gk = Z + (rowbase + kkey) * ldz + 2048 + hd * 128 + kch * 8;
        const half_t* gv0 = Z + (rowbase + vkey0) * ldz + 4096 + hd * 128 + vch0 * 8;
        const half_t* gv1 = Z + (rowbase + vkey1) * ldz + 4096 + hd * 128 + vch1 * 8;
#define DIFF_DMA(t, si) do { const size_t adv = (size_t)(64 * (t)) * ldz; LAS half_t* slot = ring + (si) * BUF_H; \
            __builtin_amdgcn_global_load_lds((const unsigned*)(gk + adv), (LAS unsigned*)(slot + w * 512), 16, 0, 0); \
            __builtin_amdgcn_global_load_lds((const unsigned*)(gk + adv + 64), (LAS unsigned*)(slot + KIMG + w * 512), 16, 0, 0); \
            __builtin_amdgcn_global_load_lds((const unsigned*)(gv0 + adv), (LAS unsigned*)(slot + 2 * KIMG + w * 1024), 16, 0, 0); \
            __builtin_amdgcn_global_load_lds((const unsigned*)(gv1 + adv), (LAS unsigned*)(slot + 2 * KIMG + w * 1024 + 512), 16, 0, 0); } while (0)
        LDS_BARRIER();
        DIFF_DMA(0, 0);
        DIFF_DMA(1, 1);
        asm volatile("s_waitcnt vmcnt(4)" ::: "memory");
        LDS_BARRIER();
        int s_cur = 0, s_nn = 2;
#pragma unroll 1
        for (int kt = 0; kt <= kt_hi; ++kt) {
            if (kt + 2 <= kt_hi) DIFF_DMA(kt + 2, s_nn);
            if (64 * kt <= qw0 + 31) {
                const LAS half_t* slot = ring + s_cur * BUF_H;
                const LAS half_t* Kt = slot + mp * KIMG; const LAS half_t* Vt = slot + 2 * KIMG;
                const int qrel = q - 64 * kt - 4 * hi;
                if (64 * kt + 191 > qw0) attn_tile<4, true, 2, true>(Kt, Vt, qf, mhat, lsum, o, wsf, bt, qrel, 0u, 0u, r32, hi, kt == 0);
                else attn_tile<4, false, 2, true>(Kt, Vt, qf, mhat, lsum, o, wsf, bt, qrel, 0u, 0u, r32, hi, kt == 0);
            }
            if (kt + 2 <= kt_hi) asm volatile("s_waitcnt vmcnt(4)" ::: "memory"); else asm volatile("s_waitcnt vmcnt(0)" ::: "memory");
            LDS_BARRIER();
            s_cur = (s_cur == 2) ? 0 : s_cur + 1; s_nn = (s_nn == 2) ? 0 : s_nn + 1;
        }
#undef DIFF_DMA
        {
            const float lt = xhalf_sum(lsum);
            if (hi == 0) wsf[r32] = 1.f / lt;
            float inv[16];
#pragma unroll
            for (int r = 0; r < 16; ++r) inv[r] = wsf[crow(r, hi)];
            if (mp == 1) {
#pragma unroll
                for (int d = 0; d < 4; ++d)
#pragma unroll
                    for (int r = 0; r < 16; ++r) cb[(32 * rg + crow(r, hi)) * 132 + 32 * d + r32] = o[d][r] * inv[r];
            }
            LDS_BARRIER();
            if (mp == 0) {
#pragma unroll
                for (int d = 0; d < 4; ++d)
#pragma unroll
                    for (int r = 0; r < 16; ++r) { LAS float* pc = cb + (32 * rg + crow(r, hi)) * 132 + 32 * d + r32; *pc = o[d][r] * inv[r] - lam * (*pc); }
            }
            LDS_BARRIER();
            const int qq = tid >> 2, q4 = tid & 3;
            f32x4 v[8]; float ss = 0.f;
#pragma unroll
            for (int i = 0; i < 8; ++i) { v[i] = *(const LAS f32x4*)(cb + qq * 132 + 32 * q4 + 4 * i); ss += (v[i].x * v[i].x + v[i].y * v[i].y) + (v[i].z * v[i].z + v[i].w * v[i].w); }
            ss += dpp_f<0xB1>(ss); ss += dpp_f<0x4E>(ss);
            const float rn = rsqrtf(ss * (1.f / 128.f) + RMS_EPS) * (1.f - lam_init);
            half_t* op = O + (rowbase + qb * 128 + qq) * D + hd * 128 + 32 * q4;
#pragma unroll
            for (int i = 0; i < 4; ++i) {
                const f32x4 g0 = *(const f32x4*)(subg + 32 * q4 + 8 * i), g1 = *(const f32x4*)(subg + 32 * q4 + 8 * i + 4);
                const f32x4 a = v[2 * i] * rn * g0, bq = v[2 * i + 1] * rn * g1;
                u32x4 wv; wv.x = pkh(a.x, a.y); wv.y = pkh(a.z, a.w); wv.z = pkh(bq.x, bq.y); wv.w = pkh(bq.z, bq.w);
                *(u32x4*)(op + 8 * i) = wv;
            }
        }
    }
    LDS_BARRIER();
}

__device__ __forceinline__ void dsa_kiwi_phase(const Ctx& c, const half_t* __restrict__ H, const float* __restrict__ RS, const half_t* __restrict__ W3, half_t* __restrict__ KW) {
    const int tid = c.tid, lane = c.lane, w = c.wave, fr = lane & 15, fq = lane >> 4;
    LAS float* red = (LAS float*)c.lds;
    for (int it = c.vcu; it < M / 32; it += c.G) {
        const int row0 = 32 * it;
        f32x4 acc[2][5];
#pragma unroll
        for (int mt = 0; mt < 2; ++mt)
#pragma unroll
            for (int nt = 0; nt < 5; ++nt) acc[mt][nt] = (f32x4){0.f, 0.f, 0.f, 0.f};
#pragma unroll 2
        for (int ks = 8 * w; ks < 8 * w + 8; ++ks) {
            h16x8 a[2];
#pragma unroll
            for (int mt = 0; mt < 2; ++mt) a[mt] = *(const h16x8*)(H + (size_t)(row0 + 16 * mt + fr) * D + 32 * ks + 8 * fq);
#pragma unroll
            for (int nt = 0; nt < 5; ++nt) { const h16x8 bw = *(const h16x8*)(W3 + (size_t)(DSA_MAIN + 16 * nt + fr) * D + 32 * ks + 8 * fq);
#pragma unroll
                for (int mt = 0; mt < 2; ++mt) acc[mt][nt] = MFMA16(a[mt], bw, acc[mt][nt]); }
        }
        LDS_BARRIER();
#pragma unroll
        for (int mt = 0; mt < 2; ++mt)
#pragma unroll
            for (int nt = 0; nt < 5; ++nt) *(LAS f32x4*)(red + ((w * 10 + mt * 5 + nt) * 64 + lane) * 4) = acc[mt][nt];
        LDS_BARRIER();
#pragma unroll
        for (int j = 0; j < 5; ++j) {
            const int idx = tid + NTH * j, t = idx >> 8, e = idx & 255;
            float s = 0.f;
#pragma unroll
            for (int w2 = 0; w2 < 8; ++w2) s += red[(w2 * 10 + t) * 256 + e];
            const int mt = t / 5, nt = t % 5, l2 = e >> 2, r = e & 3;
            const int row = row0 + 16 * mt + 4 * (l2 >> 4) + r;
            KW[(size_t)row * KW_LD + 16 * nt + (l2 & 15)] = (half_t)(s * RS[row]);
        }
    }
    LDS_BARRIER();
}

__device__ __forceinline__ void dsa_score_phase(const Ctx& c, const half_t* __restrict__ Z, const half_t* __restrict__ KW, float* __restrict__ SC) {
    const int lane = c.lane, w = c.wave, fr = lane & 15, fq = lane >> 4;
    constexpr int ldz = DSA_MAIN;
    for (int U = c.vcu; U < 512; U += c.G) {
        const int grp = U & 255, ui = U >> 8, b = grp >> 6, sx = grp & 63;
        const int qblk = (ui == 0) ? sx : 127 - sx;
        const int q0 = 16 * qblk, ng = (qblk >> 3) + 1;
        const size_t rowbase = (size_t)b * S;
        const half_t* kp = KW + (rowbase + 16 * w + fr) * KW_LD + 8 * fq;
        h16x8 k0 = *(const h16x8*)kp, k1 = *(const h16x8*)(kp + 32);
        h16x8 qf[16][2];
        { const half_t* qp = Z + (rowbase + q0 + fr) * ldz + 3072 + 8 * fq;
#pragma unroll
          for (int h = 0; h < 16; ++h)
#pragma unroll
              for (int ks = 0; ks < 2; ++ks) qf[h][ks] = *(const h16x8*)(qp + 64 * h + 32 * ks); }
        float wq[16];
        { const h16x8 w0 = *(const h16x8*)(KW + (rowbase + q0 + fr) * KW_LD + 64), w1 = *(const h16x8*)(KW + (rowbase + q0 + fr) * KW_LD + 72);
#pragma unroll
          for (int e = 0; e < 8; ++e) { wq[e] = (float)w0[e] * (1.f / 32.f); wq[8 + e] = (float)w1[e] * (1.f / 32.f); } }
        float* sp = SC + (rowbase + q0 + fr) * S + 16 * w + 4 * fq;
        __builtin_amdgcn_s_waitcnt(0x0F70);
#pragma unroll 1
        for (int g = 0; g < ng; ++g) {
            h16x8 n0 = k0, n1 = k1;
            if (g + 1 < ng) { n0 = *(const h16x8*)(kp + (size_t)(g + 1) * 128 * KW_LD); n1 = *(const h16x8*)(kp + (size_t)(g + 1) * 128 * KW_LD + 32); }
            f32x4 acc = (f32x4){0.f, 0.f, 0.f, 0.f};
#pragma unroll
            for (int h = 0; h < 16; ++h) {
                const f32x4 t = MFMA16(k1, qf[h][1], MFMA16(k0, qf[h][0], ((f32x4){0.f, 0.f, 0.f, 0.f})));
#pragma unroll
                for (int r = 0; r < 4; ++r) acc[r] += wq[h] * fmaxf(t[r], 0.f);
            }
            *(f32x4*)(sp + 128 * g) = acc;
            k0 = n0; k1 = n1;
        }
    }
}
__device__ __forceinline__ void dsa_select_phase(const Ctx& c, const float* __restrict__ SC, unsigned* __restrict__ mbits) {
    const int gw = c.vcu * NW + c.wave, NGW = c.G * NW, lane = c.lane;
    for (int R = gw; R < M; R += NGW) {
        const int q = R % S; const float* sp = SC + (size_t)R * S;
        unsigned key[32];
#pragma unroll
        for (int j = 0; j < 32; ++j) { const int s = lane + 64 * j; unsigned k = 0u;
            if (s <= q) { const unsigned u = __float_as_uint(sp[s]); k = (u & 0x80000000u) ? ~u : (u | 0x80000000u); }
            key[j] = k; }
        unsigned T = 0u;
        if (q + 1 > TOPK) {
            for (int bit = 31; bit >= 0; --bit) {
                const unsigned cand = T | (1u << bit); int cnt = 0;
#pragma unroll
                for (int j = 0; j < 32; ++j) cnt += (key[j] >= cand) ? 1 : 0;
                if (wsum64i(cnt) >= TOPK) T = cand;
            }
        }
        unsigned* mp = mbits + (size_t)R * 64;
#pragma unroll
        for (int j = 0; j < 32; ++j) { const int s = lane + 64 * j; const unsigned long long bm = __ballot(key[j] >= T && s <= q);
            if (lane == 0) { mp[2 * j] = (unsigned)bm; mp[2 * j + 1] = (unsigned)(bm >> 32); } }
    }
}

__device__ __forceinline__ void hgrn_scan_phase(const Ctx& c, const half_t* __restrict__ Z, const float* __restrict__ lb_logits, float* __restrict__ OR) {
    const int tid = c.tid, lane = c.lane, w = c.wave, fr = lane & 15, fq = lane >> 4;
    constexpr int ldz = HGRN_IN;
    LAS float* QD = (LAS float*)c.lds;
    LAS half_t* QS = (LAS half_t*)(c.lds + 33792);
    LAS half_t* KS = QS + 64 * 136;
    LAS half_t* Vt = KS + 64 * 136;
    LAS half_t* At = Vt + 32 * 72;
    LAS half_t* St = At + 64 * 72;
    LAS float* Tot = (LAS float*)(St + 32 * 136);
    LAS float* TE = Tot + 4 * 128;
    LAS float* TF = TE + 4 * 128;
    LAS float* TD = TF + 4 * 128;
    LAS float* TDEC = TD + 3 * 128;
    const int k = tid & 127, tq = tid >> 7;
    for (int U = c.vcu; U < 256; U += c.G) {
        const int b = U >> 6, hd = (U >> 2) & 15, vs = U & 3;
        float lb;
        { const int ch = hd * 128 + k; const float a0 = lb_logits[ch], a1 = lb_logits[2048 + ch], a2 = lb_logits[4096 + ch], a3 = lb_logits[6144 + ch];
          const float mm = fmaxf(fmaxf(a0, a1), fmaxf(a2, a3)); const float e0 = expf(a0 - mm), e1 = expf(a1 - mm), e2 = expf(a2 - mm), e3 = expf(a3 - mm);
          lb = (e1 + e2) / (e0 + e1 + e2 + e3); }
        LDS_BARRIER();
        for (int i = tid; i < 64 * 72; i += NTH) At[i] = (half_t)0.f;
        for (int i = tid; i < 32 * 136; i += NTH) St[i] = (half_t)0.f;
        f32x4 sacc[2]; sacc[0] = (f32x4){0.f, 0.f, 0.f, 0.f}; sacc[1] = (f32x4){0.f, 0.f, 0.f, 0.f};
        u32x4 qv_[2], zv_[2]; h16x4 vraw;
        const half_t* zp0 = Z + ((size_t)b * S + (tid >> 4)) * ldz + hd * 128 + (tid & 15) * 8;
        const half_t* vp0 = Z + ((size_t)b * S + (tid >> 3)) * ldz + 4096 + hd * 128 + vs * 32 + (tid & 7) * 4;
#define HG_LOAD(ck_) do { const half_t* zp = zp0 + (size_t)(64 * (ck_)) * ldz; \
            qv_[0] = *(const u32x4*)(zp); zv_[0] = *(const u32x4*)(zp + 2048); qv_[1] = *(const u32x4*)(zp + (size_t)32 * ldz); zv_[1] = *(const u32x4*)(zp + (size_t)32 * ldz + 2048); \
            vraw = *(const h16x4*)(vp0 + (size_t)(64 * (ck_)) * ldz); } while (0)
#define HG_SB() do { asm volatile("" ::: "memory"); __builtin_amdgcn_sched_barrier(0); } while (0)
        HG_LOAD(0);
        for (int ck = 0; ck < S / 64; ++ck) {
            const size_t row0 = (size_t)b * S + 64 * ck;
            LDS_BARRIER();
            {
                const int t = tid >> 4, k8 = (tid & 15) * 8;
                *(LAS u32x4*)(QS + t * 136 + k8) = qv_[0]; *(LAS u32x4*)(KS + t * 136 + k8) = zv_[0];
                *(LAS u32x4*)(QS + (t + 32) * 136 + k8) = qv_[1]; *(LAS u32x4*)(KS + (t + 32) * 136 + k8) = zv_[1];
                const int tv = tid >> 3, v4 = (tid & 7) * 4;
#pragma unroll
                for (int j = 0; j < 4; ++j) Vt[(v4 + j) * 72 + tv] = vraw[j];
                if (ck + 1 < S / 64) HG_LOAD(ck + 1);
            }
            LDS_BARRIER();
            {
                float fv[16]; float prod = 1.f;
#pragma unroll
                for (int tt = 0; tt < 16; ++tt) { const float sg = fsigm((float)KS[(16 * tq + tt) * 136 + k]); fv[tt] = lb + (1.f - lb) * sg; prod *= fv[tt]; }
                prod = fmaxf(prod, 1e-30f);
                Tot[tq * 128 + k] = __logf(prod);
                LDS_BARRIER();
                const float t0 = Tot[k], t1 = Tot[128 + k], t2 = Tot[256 + k], t3 = Tot[384 + k];
                const float be1 = t0, be2 = t0 + t1, be3 = be2 + t2, be4 = be3 + t3;
                if (tq == 0) { TE[k] = 1.f; TE[128 + k] = fexp(be1); TE[256 + k] = fexp(be2); TE[384 + k] = fexp(be3); }
                else if (tq == 1) { TF[k] = fexp(be4 - be1); TF[128 + k] = fexp(be4 - be2); TF[256 + k] = fexp(be4 - be3); TF[384 + k] = 1.f; }
                else if (tq == 2) { TD[k] = fexp(be2 - be1); TD[128 + k] = fexp(be3 - be1); TD[256 + k] = fexp(be3 - be2); }
                else TDEC[k] = fexp(be4);
                const float ip16 = __builtin_amdgcn_rcpf(prod);
                float P = 1.f;
#pragma unroll
                for (int tt = 0; tt < 16; ++tt) {
                    const float qv = (float)QS[(16 * tq + tt) * 136 + k];
                    P = fmaxf(P * fv[tt], 1e-30f);
                    const float qp = qv * fsigm(qv), ky = 1.f - fv[tt];
                    const int t = 16 * tq + tt;
                    const float qsv = qp * P;
                    QS[t * 136 + k] = (half_t)qsv;
                    QD[t * 132 + k] = qsv * ip16;
                    KS[t * 136 + k] = (half_t)(ky * prod * __builtin_amdgcn_rcpf(P));
                    if ((tt & 3) == 3) HG_SB();
                }
            }
            LDS_BARRIER();
            if (w < 4) {
                const int I = w;
                f32x4 acc = (f32x4){0.f, 0.f, 0.f, 0.f}, acc2 = acc;
#pragma unroll 2
                for (int m = 0; m < 8; m += 2) {
                    const int k0 = 16 * m + 4 * fq;
                    const f32x4 qd = *(const LAS f32x4*)(QD + (16 * I + fr) * 132 + k0), qd2 = *(const LAS f32x4*)(QD + (16 * I + fr) * 132 + k0 + 16);
                    const h16x4 kv = *(const LAS h16x4*)(KS + (16 * I + fr) * 136 + k0), kv2 = *(const LAS h16x4*)(KS + (16 * I + fr) * 136 + k0 + 16);
#pragma unroll
                    for (int e = 0; e < 4; ++e) { acc = __builtin_amdgcn_mfma_f32_16x16x4f32(qd[e], (float)kv[e], acc, 0, 0, 0);
                                                  acc2 = __builtin_amdgcn_mfma_f32_16x16x4f32(qd2[e], (float)kv2[e], acc2, 0, 0, 0); }
                }
#pragma unroll
                for (int r = 0; r < 4; ++r) { const int tl = 4 * fq + r; At[(16 * I + tl) * 72 + 16 * I + fr] = (half_t)((fr <= tl) ? (acc[r] + acc2[r]) : 0.f); }
            } else {
                const int nb = (w < 6) ? 2 : 1;
                for (int bi = 0; bi < nb; ++bi) {
                    const int I = (w == 4) ? (bi == 0 ? 1 : 3) : (w == 5) ? (bi == 0 ? 2 : 3) : (w == 6) ? 3 : 2;
                    const int J = (w == 4) ? (bi == 0 ? 0 : 1) : (w == 5) ? (bi == 0 ? 1 : 0) : (w == 6) ? 2 : 0;
                    const int dsel = (I == 2) ? 0 : (J == 0 ? 1 : 2);
                    f32x4 acc = (f32x4){0.f, 0.f, 0.f, 0.f};
#pragma unroll
                    for (int ks = 0; ks < 4; ++ks) {
                        const int k0 = 32 * ks + 8 * fq;
                        h16x8 a = *(const LAS h16x8*)(QS + (16 * I + fr) * 136 + k0);
                        const h16x8 bb = *(const LAS h16x8*)(KS + (16 * J + fr) * 136 + k0);
                        if (I - J >= 2) {
                            const f32x4 d0 = *(const LAS f32x4*)(TD + dsel * 128 + k0), d1 = *(const LAS f32x4*)(TD + dsel * 128 + k0 + 4);
#pragma unroll
                            for (int j = 0; j < 4; ++j) { a[j] = (half_t)((float)a[j] * d0[j]); a[4 + j] = (half_t)((float)a[4 + j] * d1[j]); }
                        }
                        acc = MFMA16(a, bb, acc);
                    }
#pragma unroll
                    for (int r = 0; r < 4; ++r) At[(16 * I + 4 * fq + r) * 72 + 16 * J + fr] = (half_t)acc[r];
                }
            }
            const int mt = w - 4;
            f32x4 oacc[2]; oacc[0] = (f32x4){0.f, 0.f, 0.f, 0.f}; oacc[1] = oacc[0];
            if (w >= 4) {
#pragma unroll
                for (int ks = 0; ks < 4; ++ks) {
                    h16x8 a = *(const LAS h16x8*)(QS + (16 * mt + fr) * 136 + 32 * ks + 8 * fq);
                    if (mt > 0) {
                        const f32x4 e0 = *(const LAS f32x4*)(TE + mt * 128 + 32 * ks + 8 * fq), e1 = *(const LAS f32x4*)(TE + mt * 128 + 32 * ks + 8 * fq + 4);
#pragma unroll
                        for (int j = 0; j < 4; ++j) { a[j] = (half_t)((float)a[j] * e0[j]); a[4 + j] = (half_t)((float)a[4 + j] * e1[j]); }
                    }
#pragma unroll
                    for (int nt = 0; nt < 2; ++nt) { const h16x8 sb = *(const LAS h16x8*)(St + (16 * nt + fr) * 136 + 32 * ks + 8 * fq); oacc[nt] = MFMA16(a, sb, oacc[nt]); }
                }
            }
            LDS_BARRIER();
            if (w >= 4) {
#pragma unroll
                for (int ks = 0; ks < 2; ++ks) {
                    const h16x8 a = *(const LAS h16x8*)(At + (16 * mt + fr) * 72 + 32 * ks + 8 * fq);
#pragma unroll
                    for (int nt = 0; nt < 2; ++nt) { const h16x8 vb = *(const LAS h16x8*)(Vt + (16 * nt + fr) * 72 + 32 * ks + 8 * fq); oacc[nt] = MFMA16(a, vb, oacc[nt]); }
                }
#pragma unroll
                for (int nt = 0; nt < 2; ++nt)
#pragma unroll
                    for (int r = 0; r < 4; ++r) OR[(row0 + 16 * mt + 4 * fq + r) * D + hd * 128 + vs * 32 + 16 * nt + fr] = oacc[nt][r];
            }
            {
#pragma unroll
                for (int r = 0; r < 4; ++r) { const float dec = TDEC[16 * w + 4 * fq + r]; sacc[0][r] *= dec; sacc[1][r] *= dec; }
                const int kr = 16 * w + fr;
#pragma unroll
                for (int ks = 0; ks < 2; ++ks) {
                    const float fj = TF[(2 * ks + (fq >> 1)) * 128 + kr];
                    h16x8 a;
#pragma unroll
                    for (int j = 0; j < 8; ++j) { const int s2 = 32 * ks + 8 * fq + j; a[j] = (half_t)((float)KS[s2 * 136 + kr] * fj); }
#pragma unroll
                    for (int n2 = 0; n2 < 2; ++n2) { const h16x8 vb = *(const LAS h16x8*)(Vt + (16 * n2 + fr) * 72 + 32 * ks + 8 * fq); sacc[n2] = MFMA16(a, vb, sacc[n2]); }
                }
#pragma unroll
                for (int n2 = 0; n2 < 2; ++n2) { u32x2 pk; pk.x = pkh(sacc[n2][0], sacc[n2][1]); pk.y = pkh(sacc[n2][2], sacc[n2][3]);
                    *(LAS u32x2*)(St + (16 * n2 + fr) * 136 + 16 * w + 4 * fq) = pk; }
            }
        }
#undef HG_LOAD
#undef HG_SB
    }
    LDS_BARRIER();
}
__device__ __forceinline__ float hgrn_lb(const float* __restrict__ lb_logits, int ch) {
    const float a0 = lb_logits[ch], a1 = lb_logits[2048 + ch], a2 = lb_logits[4096 + ch], a3 = lb_logits[6144 + ch];
    const float mm = fmaxf(fmaxf(a0, a1), fmaxf(a2, a3)); const float e0 = expf(a0 - mm), e1 = expf(a1 - mm), e2 = expf(a2 - mm), e3 = expf(a3 - mm);
    return (e1 + e2) / (e0 + e1 + e2 + e3);
}
constexpr int HG_VS = 144;
__device__ __forceinline__ h16x8 hgrn_vfrag(const LAS half_t* Vr, int fr, int fq, int ks, int nt) {
    const LAS half_t* p = Vr + (32 * ks + 8 * fq + (fr >> 2)) * HG_VS + 16 * nt + 4 * (fr & 3);
    const v4i16_t lo = __builtin_amdgcn_ds_read_tr16_b64_v4i16((LAS v4i16_t*)p);
    const v4i16_t hi2 = __builtin_amdgcn_ds_read_tr16_b64_v4i16((LAS v4i16_t*)(p + 4 * HG_VS));
    typedef short s16x8 __attribute__((ext_vector_type(8)));
    const s16x8 vv = (s16x8){lo[0], lo[1], lo[2], lo[3], hi2[0], hi2[1], hi2[2], hi2[3]};
    return __builtin_bit_cast(h16x8, vv);
}

__device__ __forceinline__ void hgrn_local_phase(const Ctx& c, const half_t* __restrict__ Z, const float* __restrict__ lb_logits, half_t* __restrict__ UT, float* __restrict__ DEC) {
    const int tid = c.tid, lane = c.lane, w = c.wave, fr = lane & 15, fq = lane >> 4;
    constexpr int ldz = HGRN_IN;
    LAS half_t* KS = (LAS half_t*)c.lds;
    LAS half_t* Vr = KS + 64 * 136;
    LAS float* Tot = (LAS float*)(Vr + 64 * HG_VS);
    LAS float* TF = Tot + 4 * 128;
    const int k = tid & 127, tq = tid >> 7;
    const int st = tid >> 4, sk8 = (tid & 15) * 8;
    u32x4 zv_[2], vv_[2];
#define HA_LOAD(u_) do { const int b_ = (u_) >> 9, hd_ = ((u_) >> 5) & 15, ck_ = (u_) & 31; const half_t* zp = Z + ((size_t)b_ * S + 64 * ck_ + st) * ldz + hd_ * 128 + sk8; \
        zv_[0] = *(const u32x4*)(zp + 2048); zv_[1] = *(const u32x4*)(zp + (size_t)32 * ldz + 2048); vv_[0] = *(const u32x4*)(zp + 4096); vv_[1] = *(const u32x4*)(zp + (size_t)32 * ldz + 4096); } while (0)
    int U = c.vcu;
    if (U < 2048) HA_LOAD(U);
    for (; U < 2048; U += c.G) {
        const int hd = (U >> 5) & 15;
        const float lb = hgrn_lb(lb_logits, hd * 128 + k);
        LDS_BARRIER();
        *(LAS u32x4*)(KS + st * 136 + sk8) = zv_[0]; *(LAS u32x4*)(KS + (st + 32) * 136 + sk8) = zv_[1];
        *(LAS u32x4*)(Vr + st * HG_VS + sk8) = vv_[0]; *(LAS u32x4*)(Vr + (st + 32) * HG_VS + sk8) = vv_[1];
        if (U + c.G < 2048) HA_LOAD(U + c.G);
        LDS_BARRIER();
        float fv[16]; float prod = 1.f;
#pragma unroll
        for (int tt = 0; tt < 16; ++tt) { const float sg = fsigm((float)KS[(16 * tq + tt) * 136 + k]); fv[tt] = lb + (1.f - lb) * sg; prod *= fv[tt]; }
        prod = fmaxf(prod, 1e-30f);
        Tot[tq * 128 + k] = __logf(prod);
        LDS_BARRIER();
        {
            const float t0 = Tot[k], t1 = Tot[128 + k], t2 = Tot[256 + k], t3 = Tot[384 + k];
            const float be1 = t0, be2 = t0 + t1, be3 = be2 + t2, be4 = be3 + t3;
            if (tq == 1) { TF[k] = fexp(be4 - be1); TF[128 + k] = fexp(be4 - be2); TF[256 + k] = fexp(be4 - be3); TF[384 + k] = 1.f; }
            if (tq == 3) DEC[(size_t)U * 128 + k] = fexp(be4);
            float P = 1.f;
#pragma unroll
            for (int tt = 0; tt < 16; ++tt) { P = fmaxf(P * fv[tt], 1e-30f); KS[(16 * tq + tt) * 136 + k] = (half_t)((1.f - fv[tt]) * prod * __builtin_amdgcn_rcpf(P)); }
        }
        LDS_BARRIER();
        f32x4 acc[8];
#pragma unroll
        for (int nt = 0; nt < 8; ++nt) acc[nt] = (f32x4){0.f, 0.f, 0.f, 0.f};
        const int kr = 16 * w + fr;
#pragma unroll
        for (int ks = 0; ks < 2; ++ks) {
            const float fj = TF[(2 * ks + (fq >> 1)) * 128 + kr];
            h16x8 a;
#pragma unroll
            for (int j = 0; j < 8; ++j) { const int s2 = 32 * ks + 8 * fq + j; a[j] = (half_t)((float)KS[s2 * 136 + kr] * fj); }
#pragma unroll
            for (int nt = 0; nt < 8; ++nt) acc[nt] = MFMA16(a, hgrn_vfrag(Vr, fr, fq, ks, nt), acc[nt]);
        }
        half_t* ut = UT + (size_t)U * 16384;
#pragma unroll
        for (int nt = 0; nt < 8; ++nt) { u32x2 pk; pk.x = pkh(acc[nt][0], acc[nt][1]); pk.y = pkh(acc[nt][2], acc[nt][3]);
            *(u32x2*)(ut + (16 * nt + fr) * 128 + 16 * w + 4 * fq) = pk; }
    }
#undef HA_LOAD
    LDS_BARRIER();
}

__device__ __forceinline__ void hgrn_carry_phase(const Ctx& c, const half_t* __restrict__ UT, const float* __restrict__ DEC, half_t* __restrict__ SS) {
    for (int g = c.vcu * NTH + c.tid; g < 64 * 2048; g += c.G * NTH) {
        const int bh = g >> 11, p8 = (g & 2047) * 8, k0 = p8 & 127;
        float s[8];
#pragma unroll
        for (int e = 0; e < 8; ++e) s[e] = 0.f;
#pragma unroll 4
        for (int ck = 0; ck < 32; ++ck) {
            const size_t u = (size_t)bh * 32 + ck;
            const h16x8 uv = *(const h16x8*)(UT + u * 16384 + p8);
            const f32x4 d0 = *(const f32x4*)(DEC + u * 128 + k0), d1 = *(const f32x4*)(DEC + u * 128 + k0 + 4);
            u32x4 o; o.x = pkh(s[0], s[1]); o.y = pkh(s[2], s[3]); o.z = pkh(s[4], s[5]); o.w = pkh(s[6], s[7]);
            *(u32x4*)(SS + u * 16384 + p8) = o;
#pragma unroll
            for (int e = 0; e < 4; ++e) { s[e] = fmaf(d0[e], s[e], (float)uv[e]); s[4 + e] = fmaf(d1[e], s[4 + e], (float)uv[4 + e]); }
        }
    }
}

__device__ __forceinline__ void hgrn_out_phase(const Ctx& c, const half_t* __restrict__ Z, const float* __restrict__ lb_logits, const half_t* __restrict__ SS, const float* __restrict__ ng,
                                               half_t* __restrict__ O) {
    const int tid = c.tid, lane = c.lane, w = c.wave, fr = lane & 15, fq = lane >> 4;
    constexpr int ldz = HGRN_IN;
    LAS float* QD = (LAS float*)c.lds;
    LAS half_t* KS = (LAS half_t*)(c.lds + 33792);
    LAS half_t* Vr = KS + 64 * 136;
    LAS half_t* At = Vr + 64 * HG_VS;
    LAS half_t* St = At + 64 * 72;
    LAS float* Tot = (LAS float*)(St + 128 * 136);
    LAS float* TX = Tot + 4 * 128;
    LAS float* TE = TX + 7 * 128;
    LAS float* RS = TE + 4 * 128;
    static_assert(33792 + (64 * 136 + 64 * HG_VS + 64 * 72 + 128 * 136) * 2 + (4 + 7 + 4) * 128 * 4 + 64 * 2 * 4 <= RING_BYTES, "hgrn_out LDS");
    const int k = tid & 127, tq = tid >> 7;
    const int st = tid >> 4, sk8 = (tid & 15) * 8;
    for (int i = tid; i < 64 * 72; i += NTH) At[i] = (half_t)0.f;
    u32x4 qv_[2], zv_[2], vv_[2], sv_[4];
#define HC_LOAD(u_) do { const int b_ = (u_) >> 9, hd_ = ((u_) >> 5) & 15, ck_ = (u_) & 31; const half_t* zp = Z + ((size_t)b_ * S + 64 * ck_ + st) * ldz + hd_ * 128 + sk8; \
        qv_[0] = *(const u32x4*)(zp); qv_[1] = *(const u32x4*)(zp + (size_t)32 * ldz); zv_[0] = *(const u32x4*)(zp + 2048); zv_[1] = *(const u32x4*)(zp + (size_t)32 * ldz + 2048); \
        vv_[0] = *(const u32x4*)(zp + 4096); vv_[1] = *(const u32x4*)(zp + (size_t)32 * ldz + 4096); \
        const half_t* sp = SS + (size_t)(u_) * 16384 + st * 128 + sk8; \
        _Pragma("unroll") for (int i_ = 0; i_ < 4; ++i_) sv_[i_] = *(const u32x4*)(sp + i_ * 32 * 128); } while (0)
    int U = c.vcu;
    if (U < 2048) HC_LOAD(U);
    for (; U < 2048; U += c.G) {
        const int b = U >> 9, hd = (U >> 5) & 15, ck = U & 31;
        const size_t row0 = (size_t)b * S + 64 * ck;
        const float lb = hgrn_lb(lb_logits, hd * 128 + k);
        LDS_BARRIER();
#pragma unroll
        for (int i = 0; i < 2; ++i) { const h16x8 qh = __builtin_bit_cast(h16x8, qv_[i]); f32x4 a0, a1;
#pragma unroll
            for (int e = 0; e < 4; ++e) { const float x0 = (float)qh[e], x1 = (float)qh[4 + e]; a0[e] = x0 * fsigm(x0); a1[e] = x1 * fsigm(x1); }
            *(LAS f32x4*)(QD + (st + 32 * i) * 132 + sk8) = a0; *(LAS f32x4*)(QD + (st + 32 * i) * 132 + sk8 + 4) = a1; }
        *(LAS u32x4*)(KS + st * 136 + sk8) = zv_[0]; *(LAS u32x4*)(KS + (st + 32) * 136 + sk8) = zv_[1];
        *(LAS u32x4*)(Vr + st * HG_VS + sk8) = vv_[0]; *(LAS u32x4*)(Vr + (st + 32) * HG_VS + sk8) = vv_[1];
#pragma unroll
        for (int i = 0; i < 4; ++i) *(LAS u32x4*)(St + (st + 32 * i) * 136 + sk8) = sv_[i];
        if (U + c.G < 2048) HC_LOAD(U + c.G);
        LDS_BARRIER();
        float fv[16]; float prod = 1.f;
#pragma unroll
        for (int tt = 0; tt < 16; ++tt) { const float sg = fsigm((float)KS[(16 * tq + tt) * 136 + k]); fv[tt] = lb + (1.f - lb) * sg; prod *= fv[tt]; }
        prod = fmaxf(prod, 1e-30f);
        Tot[tq * 128 + k] = __logf(prod);
        LDS_BARRIER();
        {
            const float t0 = Tot[k], t1 = Tot[128 + k], t2 = Tot[256 + k], t3 = Tot[384 + k];
            const float be1 = t0, be2 = t0 + t1, be3 = be2 + t2, be4 = be3 + t3;
            if (tq == 0) { TE[k] = fexp(be1); TE[128 + k] = fexp(be2); TE[256 + k] = fexp(be3); TE[384 + k] = fexp(be4); }
            else if (tq == 1) { TX[k] = fexp(be2 - be1); TX[128 + k] = fexp(be3 - be1); TX[256 + k] = fexp(be3 - be2); }
            else if (tq == 2) { TX[384 + k] = fexp(be4 - be1); TX[512 + k] = fexp(be4 - be2); TX[640 + k] = fexp(be4 - be3); }
            const float ip16 = __builtin_amdgcn_rcpf(prod);
            float P = 1.f;
#pragma unroll
            for (int tt = 0; tt < 16; ++tt) {
                const int t = 16 * tq + tt;
                P = fmaxf(P * fv[tt], 1e-30f);
                QD[t * 132 + k] *= P * ip16;
                KS[t * 136 + k] = (half_t)((1.f - fv[tt]) * prod * __builtin_amdgcn_rcpf(P));
                if ((tt & 3) == 3) { asm volatile("" ::: "memory"); __builtin_amdgcn_sched_barrier(0); }
            }
        }
        LDS_BARRIER();
        if (w < 4) {
            const int I = w;
            f32x4 acc = (f32x4){0.f, 0.f, 0.f, 0.f}, acc2 = acc;
#pragma unroll 2
            for (int m = 0; m < 8; m += 2) {
                const int k0 = 16 * m + 4 * fq;
                const f32x4 qd = *(const LAS f32x4*)(QD + (16 * I + fr) * 132 + k0), qd2 = *(const LAS f32x4*)(QD + (16 * I + fr) * 132 + k0 + 16);
                const h16x4 kv = *(const LAS h16x4*)(KS + (16 * I + fr) * 136 + k0), kv2 = *(const LAS h16x4*)(KS + (16 * I + fr) * 136 + k0 + 16);
#pragma unroll
                for (int e = 0; e < 4; ++e) { acc = __builtin_amdgcn_mfma_f32_16x16x4f32(qd[e], (float)kv[e], acc, 0, 0, 0);
                                              acc2 = __builtin_amdgcn_mfma_f32_16x16x4f32(qd2[e], (float)kv2[e], acc2, 0, 0, 0); }
            }
#pragma unroll
            for (int r = 0; r < 4; ++r) { const int tl = 4 * fq + r; At[(16 * I + tl) * 72 + 16 * I + fr] = (half_t)((fr <= tl) ? (acc[r] + acc2[r]) : 0.f); }
        } else {
            const int nb = (w < 6) ? 2 : 1;
            for (int bi = 0; bi < nb; ++bi) {
                const int I = (w == 4) ? (bi == 0 ? 1 : 3) : (w == 5) ? (bi == 0 ? 2 : 3) : (w == 6) ? 3 : 2;
                const int J = (w == 4) ? (bi == 0 ? 0 : 1) : (w == 5) ? (bi == 0 ? 1 : 0) : (w == 6) ? 2 : 0;
                const LAS float* tx = TX + (I * (I - 1) / 2 + J) * 128;
                f32x4 acc = (f32x4){0.f, 0.f, 0.f, 0.f};
#pragma unroll
                for (int ks = 0; ks < 4; ++ks) {
                    const int k0 = 32 * ks + 8 * fq;
                    const f32x4 q0 = *(const LAS f32x4*)(QD + (16 * I + fr) * 132 + k0), q1 = *(const LAS f32x4*)(QD + (16 * I + fr) * 132 + k0 + 4);
                    const f32x4 x0 = *(const LAS f32x4*)(tx + k0), x1 = *(const LAS f32x4*)(tx + k0 + 4);
                    const h16x8 bb = *(const LAS h16x8*)(KS + (16 * J + fr) * 136 + k0);
                    h16x8 a;
#pragma unroll
                    for (int j = 0; j < 4; ++j) { a[j] = (half_t)(q0[j] * x0[j]); a[4 + j] = (half_t)(q1[j] * x1[j]); }
                    acc = MFMA16(a, bb, acc);
                }
#pragma unroll
                for (int r = 0; r < 4; ++r) At[(16 * I + 4 * fq + r) * 72 + 16 * J + fr] = (half_t)acc[r];
            }
        }
        const int mt = w >> 1, nh = w & 1;
        f32x4 oacc[4];
#pragma unroll
        for (int n = 0; n < 4; ++n) oacc[n] = (f32x4){0.f, 0.f, 0.f, 0.f};
        half_t gt[4][4];
#pragma unroll
        for (int n = 0; n < 4; ++n)
#pragma unroll
            for (int r = 0; r < 4; ++r) gt[n][r] = Z[(row0 + 16 * mt + 4 * fq + r) * ldz + 6144 + hd * 128 + 64 * nh + 16 * n + fr];
#pragma unroll
        for (int ks = 0; ks < 4; ++ks) {
            const int k0 = 32 * ks + 8 * fq;
            const f32x4 q0 = *(const LAS f32x4*)(QD + (16 * mt + fr) * 132 + k0), q1 = *(const LAS f32x4*)(QD + (16 * mt + fr) * 132 + k0 + 4);
            const f32x4 x0 = *(const LAS f32x4*)(TE + mt * 128 + k0), x1 = *(const LAS f32x4*)(TE + mt * 128 + k0 + 4);
            h16x8 a;
#pragma unroll
            for (int j = 0; j < 4; ++j) { a[j] = (half_t)(q0[j] * x0[j]); a[4 + j] = (half_t)(q1[j] * x1[j]); }
#pragma unroll
            for (int n = 0; n < 4; ++n) { const h16x8 sb = *(const LAS h16x8*)(St + (64 * nh + 16 * n + fr) * 136 + k0); oacc[n] = MFMA16(a, sb, oacc[n]); }
        }
        LDS_BARRIER();
#pragma unroll
        for (int ks = 0; ks < 2; ++ks) {
            const h16x8 a = *(const LAS h16x8*)(At + (16 * mt + fr) * 72 + 32 * ks + 8 * fq);
#pragma unroll
            for (int n = 0; n < 4; ++n) oacc[n] = MFMA16(a, hgrn_vfrag(Vr, fr, fq, ks, 4 * nh + n), oacc[n]);
        }
        {
            float ssq[4];
#pragma unroll
            for (int r = 0; r < 4; ++r) { float s_ = 0.f;
#pragma unroll
                for (int n = 0; n < 4; ++n) s_ += oacc[n][r] * oacc[n][r];
                ssq[r] = rsum16(s_); }
            if (fr == 0) {
#pragma unroll
                for (int r = 0; r < 4; ++r) RS[(16 * mt + 4 * fq + r) * 2 + nh] = ssq[r];
            }
            LDS_BARRIER();
#pragma unroll
            for (int r = 0; r < 4; ++r) {
                const int t = 16 * mt + 4 * fq + r;
                const float rn = rsqrtf((RS[t * 2] + RS[t * 2 + 1]) * (1.f / 128.f) + RMS_EPS);
                half_t* op = O + (row0 + t) * D + hd * 128 + 64 * nh + fr;
#pragma unroll
                for (int n = 0; n < 4; ++n) { const float gv = (float)gt[n][r]; op[16 * n] = (half_t)(oacc[n][r] * rn * ng[64 * nh + 16 * n + fr] * (gv * fsigm(gv))); }
            }
        }
    }
#undef HC_LOAD
    LDS_BARRIER();
}

}

namespace fp {
constexpr int N_PHASES = 41;
#ifndef PROBE_MASK
#define PROBE_MASK 0
#endif
#define FP_PHASE_G(id, grp, ...) do { if (lo <= (id) && (id) < hi) { \
        if constexpr (((PROBE_MASK) >> (grp)) & 1) { _Pragma("unroll 1") for (int rep_ = 0; rep_ < 2; ++rep_) { asm volatile("" : "+s"(rep_)); __VA_ARGS__; if (rep_ == 0) xcd_barrier(bar); } } \
        else { __VA_ARGS__; } \
        if ((id) + 1 < hi) { xcd_barrier(bar); if constexpr (((PROBE_MASK) >> 10) & 1) xcd_barrier(bar); } } } while (0)
#define FP_PHASE(id, ...) FP_PHASE_G(id, 31, __VA_ARGS__)

template <int L>
__device__ __forceinline__ void layer_phases(const Ctx& c, const Params& p, const XcdBarrier& bar, int lo, int hi) {
    constexpr int KIND = L % 4, PB = 1 + 10 * L;
    constexpr int NIN = KIND == 0 ? SWA_IN : KIND == 1 ? DIFF_IN : KIND == 2 ? HGRN_IN : DSA_MAIN;
    constexpr size_t WIN_OFF = KIND == 0 ? WS_WIN0 : KIND == 1 ? WS_WIN1 : KIND == 2 ? WS_WIN2 : WS_WIN3;
    unsigned char* ws = p.ws;
    half_t* H = (half_t*)(ws + WS_X16); float* RS = (float*)(ws + WS_RS); half_t* ZU = (half_t*)(ws + WS_ZU); half_t* O = (half_t*)(ws + WS_O); float* MF = (float*)(ws + WS_MF); half_t* ACT = (half_t*)(ws + WS_ACT);
    const float* ng = p.in[3] + (size_t)L * 4 * D;
    const float* bias = p.in[1];
    FP_PHASE_G(PB + 0, 0, { if constexpr (KIND == 3) dsa_kiwi_phase(c, H, RS, (const half_t*)(ws + WS_WIN3), (half_t*)(ws + WS_KW));
                       pg8::Gemm g{H, (const half_t*)(ws + WIN_OFF), M, NIN, D}; pg8::StaticOrder so; so.init(M, NIN, c.G, (int)blockIdx.x); pg8::EpiH16T<true> E{ZU, NIN, RS};
                       pg8::gemm_phase<pg8::EpiH16T<true>, pg8::StaticOrder, true, true>(c.lds, g, so, E);
                       if constexpr (L == 0) { if (c.G == 256 && (int)blockIdx.x >= so.nwg - c.G) spare_slot_convert(c, p, 1, 0, DEFER_G1, (int)blockIdx.x - (so.nwg - c.G)); } });
    if constexpr (KIND == 0) {
        FP_PHASE_G(PB + 1, 1, gqa_phase<0>(c, ZU, SWA_IN, 2048, 2560, bias, p.in[9], nullptr, O));
    } else if constexpr (KIND == 1) {
        FP_PHASE_G(PB + 1, 2, diff_phase(c, ZU, bias, p.in[12], p.in[13], 0.8f - 0.6f * 0.74081822068f  , O));
    } else if constexpr (KIND == 2) {
        FP_PHASE_G(PB + 1, 3, hgrn_local_phase(c, ZU, p.in[2], (half_t*)(ws + WS_HUT), (float*)(ws + WS_HDEC)));
        FP_PHASE_G(PB + 2, 7, hgrn_carry_phase(c, (const half_t*)(ws + WS_HUT), (const float*)(ws + WS_HDEC), (half_t*)MF));
        FP_PHASE_G(PB + 3, 3, hgrn_out_phase(c, ZU, p.in[2], (const half_t*)MF, p.in[16], O));
    } else {
        FP_PHASE_G(PB + 1, 8, dsa_score_phase(c, ZU, (const half_t*)(ws + WS_KW), (float*)(ws + WS_ACT)));
        FP_PHASE_G(PB + 2, 9, dsa_select_phase(c, (const float*)(ws + WS_ACT), (unsigned*)(ws + WS_MBITS)));
        FP_PHASE_G(PB + 3, 4, gqa_phase<1>(c, ZU, DSA_MAIN, 2048, 2560, bias, nullptr, (const unsigned*)(ws + WS_MBITS), O));
    }
    FP_PHASE_G(PB + 4, 0, { pg8::Gemm g{O, (const half_t*)(ws + WS_WOUT + L * WOUT_STRIDE), M, D, D}; pg8::StaticOrder so; so.init(M, D, c.G, (int)blockIdx.x); pg8::EpiH16 E{(half_t*)MF, D};
                       pg8::gemm_phase<pg8::EpiH16, pg8::StaticOrder, true, true>(c.lds, g, so, E); });
    FP_PHASE(PB + 5, resnorm_phase(c, (half_t*)(ws + WS_X16), (const half_t*)MF, ng + D, RS, nullptr));
    FP_PHASE_G(PB + 6, 0, { constexpr int MT = (M + 253) / 254; pg8::Gemm g{H, (const half_t*)(ws + WS_WUP + L * WUP_STRIDE), MT * 256, NUP, D, 254, -2}; pg8::StaticOrder so; so.init(MT * 256, NUP, c.G, (int)blockIdx.x);
                       pg8::EpiConv E{ACT, p.in[5] + (size_t)L * 3 * NUP, (LAS float*)(c.lds + MISC_OFF + 256), M, S, DFF, NUP, RS};
                       pg8::gemm_phase<pg8::EpiConv, pg8::StaticOrder, true, true>(c.lds, g, so, E);
                       if constexpr (L < 3) { const int nfull = so.nwg % c.G;
                           if (c.G == 256 && nfull == 256 - 84 && (int)blockIdx.x >= nfull) spare_slot_convert(c, p, L + 1, L == 0 ? DEFER_G1 : 0, L == 0 ? FFN_TILES : DEFER_G3, (int)blockIdx.x - nfull); } });
    FP_PHASE_G(PB + 8, 0, { pg8::Gemm g{ACT, (const half_t*)(ws + WS_WDN + L * WDN_STRIDE), M, D, DFF}; pg8::StaticOrder so; so.init(M, D, c.G, (int)blockIdx.x); pg8::EpiH16 E{(half_t*)MF, D};
                       pg8::gemm_phase<pg8::EpiH16, pg8::StaticOrder, true, true>(c.lds, g, so, E); });
    FP_PHASE(PB + 9, resnorm_phase(c, (half_t*)(ws + WS_X16), (const half_t*)MF, ng + 3 * D, (L < 3) ? RS : (float*)nullptr, (L < 3) ? (float*)nullptr : p.out));
}

__global__ void __launch_bounds__(NTH, 2) fwd_kernel(Params p) {
    extern __shared__ __attribute__((aligned(16))) unsigned char lds_raw[];
    Ctx c;
    c.lds = (LAS unsigned char*)lds_raw;
    c.tid = threadIdx.x; c.lane = c.tid & 63; c.wave = __builtin_amdgcn_readfirstlane(c.tid >> 6);
    c.G = gridDim.x; { const int bx = blockIdx.x; c.vcu = (c.G % 8 == 0) ? (bx % 8) * (c.G / 8) + bx / 8 : bx; }
    volatile LAS unsigned* misc = (volatile LAS unsigned*)(c.lds + MISC_OFF);
    if (c.tid < 4) misc[c.tid] = 0u;
    __syncthreads();
    XcdBarrier bar = xcd_barrier_post((unsigned*)(p.ws + WS_CTL) + CW_BAR, misc);
    const int lo = p.ph_lo, hi = p.ph_hi;
    FP_PHASE_G(0, 6, prologue_phase(c, p));
#ifndef ONLY_LAYER
#define ONLY_LAYER -1
#endif
    if constexpr (ONLY_LAYER < 0 || ONLY_LAYER == 0) layer_phases<0>(c, p, bar, lo, hi);
    if constexpr (ONLY_LAYER < 0 || ONLY_LAYER == 1) layer_phases<1>(c, p, bar, lo, hi);
    if constexpr (ONLY_LAYER < 0 || ONLY_LAYER == 2) layer_phases<2>(c, p, bar, lo, hi);
    if constexpr (ONLY_LAYER < 0 || ONLY_LAYER == 3) layer_phases<3>(c, p, bar, lo, hi);
}

static int g_grid = 0;
static int fast_setup() {
    if (g_grid == 0) {
        int dev = 0, cus = 0, per_cu = 0;
        if (hipGetDevice(&dev) != hipSuccess || hipDeviceGetAttribute(&cus, hipDeviceAttributeMultiprocessorCount, dev) != hipSuccess) { fprintf(stderr, "kernel_launch: device query failed\n"); g_grid = -1; return g_grid; }
        if (hipFuncSetAttribute((const void*)fwd_kernel, hipFuncAttributeMaxDynamicSharedMemorySize, LDS_BYTES) != hipSuccess) { fprintf(stderr, "kernel_launch: hipFuncSetAttribute failed\n"); g_grid = -1; return g_grid; }
        if (hipOccupancyMaxActiveBlocksPerMultiprocessor(&per_cu, (const void*)fwd_kernel, NTH, LDS_BYTES) != hipSuccess || per_cu < 1) fprintf(stderr, "kernel_launch: occupancy query says %d\n", per_cu);
        (void)hipGetLastError();
        g_grid = cus;
    }
    return g_grid;
}
static void fast_launch(void* const* d_in, void* d_out, void* d_ws, int lo, int hi, hipStream_t stream) {
    Params p{};
    for (int i = 0; i < 19; ++i) p.in[i] = (const float*)d_in[i];
    p.out = (float*)d_out; p.ws = (unsigned char*)d_ws; p.ph_lo = lo; p.ph_hi = hi;
#if MODE == 2
    (void)hipMemsetAsync((char*)d_ws + WS_CTL + CW_BAR * 4, 0, XCD_BAR_WORDS * 4, stream);
#endif
    hipLaunchKernelGGL(fwd_kernel, dim3(g_grid), dim3(NTH), LDS_BYTES, stream, p);
}
}

#if MODE == 0
extern "C" void kernel_launch(void* const* d_in, const int* in_sizes, int n_in, void* d_out, int out_size, void* d_ws, size_t ws_size, hipStream_t stream) {
    if (fp::fast_setup() <= 0) return;
    (void)hipMemsetAsync((char*)d_ws + fp::WS_CTL, 0, fp::CTL_BYTES, stream);
    fp::fast_launch(d_in, d_out, d_ws, 0, fp::N_PHASES, stream);
}
#endif

#if MODE == 2
namespace dbg {
using namespace cfg;
template <bool HALF>
__global__ void __launch_bounds__(256) cmp_kernel(const void* f, int ldf, const float* o, int ldo, int rows, int cols, float* sums) {
    float sd = 0.f, so = 0.f;
    const size_t n = (size_t)rows * cols;
    for (size_t i = (size_t)blockIdx.x * 256 + threadIdx.x; i < n; i += (size_t)gridDim.x * 256) {
        const int r = (int)(i / cols), cc = (int)(i % cols);
        const float fv = HALF ? (float)((const half_t*)f)[(size_t)r * ldf + cc] : ((const float*)f)[(size_t)r * ldf + cc];
        const float ov = o[(size_t)r * ldo + cc];
        const float d = fv - ov; sd += d * d; so += ov * ov;
    }
    for (int off = 32; off >= 1; off >>= 1) { sd += __shfl_xor(sd, off); so += __shfl_xor(so, off); }
    if ((threadIdx.x & 63) == 0) { atomicAdd(sums, sd); atomicAdd(sums + 1, so); }
}
__global__ void __launch_bounds__(256) report_kernel(const float* sums, int nck, float* out, size_t n) {
    int bad = 0; float V = 0.f;
    for (int k = 0; k < nck; ++k) {
        const float sd = sums[2 * k], so = sums[2 * k + 1];
        if (so == 0.f && sd == 0.f) continue;
        const float rvr = sd / so;
        const float tol = (k == 23) ? 2e-2f : (k > 23) ? 5e-3f : 3e-4f;
        if (!(rvr < tol)) {
            int e = 15;
            if (rvr == rvr) { e = (int)floorf(1.f - log10f(rvr)); e = e < 0 ? 0 : (e > 12 ? 12 : e); }
            V = (float)(10 + k + 1) * powf(10.f, (float)(4 + e)); bad = 1; break;
        }
    }
    if (!bad) return;
    for (size_t i = (size_t)blockIdx.x * 256 + threadIdx.x; i < n; i += (size_t)gridDim.x * 256) out[i] = (i == 0) ? V : 0.f;
}
}

extern "C" void kernel_launch(void* const* d_in, const int* in_sizes, int n_in, void* d_out, int out_size, void* d_ws, size_t ws_size, hipStream_t stream) {
    using namespace cfg;
    if (fp::fast_setup() <= 0) return;
    unsigned char* ws = (unsigned char*)d_ws;
    (void)hipMemsetAsync(ws + fp::WS_CTL, 0, fp::CTL_BYTES, stream);
    float* sums = (float*)(ws + fp::WS_CTL) + fp::CW_CK;
    constexpr size_t MiB = 1u << 20;
    size_t off = fp::WS_FAST_END + 2 * MiB;
    orc::Bufs bf;
    bf.X = (float*)(ws + off); off += 64 * MiB;
    bf.O = (float*)(ws + off); off += 64 * MiB;
    bf.MF = (float*)(ws + off); off += 64 * MiB;
    bf.H = (float*)(ws + off); off += 16 * MiB;
    bf.Z = (float*)(ws + off); off += 64 * MiB;
    bf.U = (float*)(ws + off); off += 88 * MiB;
    bf.A = (float*)(ws + off); off += 44 * MiB;
    if (off > ws_size) { fprintf(stderr, "kernel_launch: workspace too small (%zu > %zu)\n", off, ws_size); return; }
    (void)hipMemcpyAsync(bf.X, d_in[0], (size_t)M * D * 4, hipMemcpyDeviceToDevice, stream);
    half_t* fZU = (half_t*)(ws + fp::WS_ZU); half_t* fO = (half_t*)(ws + fp::WS_O); half_t* fACT = (half_t*)(ws + fp::WS_ACT);
    float* fX = (float*)d_out;
    fp::fast_launch(d_in, d_out, d_ws, 0, 1, stream);
    for (int L = 0; L < 4; ++L) {
        const int kind = L % 4, PB = 1 + 10 * L;
        const int nin = kind == 0 ? SWA_IN : kind == 1 ? DIFF_IN : kind == 2 ? HGRN_IN : DSA_IN;
        const int ninp = kind == 3 ? fp::DSA_MAIN : nin;
        float* ck = sums + 2 * 7 * L;
        fp::fast_launch(d_in, d_out, d_ws, PB, PB + 1, stream);
        for (int b = 0; b < B; ++b)
            orc::run_mixer(bf, d_in, L, b, 1, stream, [&](int stage) {
                if (b != 0) return;
                if (stage == 1) dbg::cmp_kernel<true><<<1024, 256, 0, stream>>>(fZU, ninp, bf.Z, nin, S, nin < ninp ? nin : ninp, ck + 2);
            });
        fp::fast_launch(d_in, d_out, d_ws, PB + 1, PB + 4, stream);
        dbg::cmp_kernel<true><<<1024, 256, 0, stream>>>(fO, D, bf.O, D, M, D, ck + 4);
        fp::fast_launch(d_in, d_out, d_ws, PB + 4, PB + 5, stream);
        fp::fast_launch(d_in, d_out, d_ws, PB + 5, PB + 6, stream);
        dbg::cmp_kernel<true><<<1024, 256, 0, stream>>>(ws + fp::WS_X16, D, bf.X, D, M, D, ck + 6);
        fp::fast_launch(d_in, d_out, d_ws, PB + 6, PB + 7, stream);
        for (int b = 0; b < B; ++b)
            orc::run_ffn(bf, d_in, L, b, 1, stream, [&](int stage) {
                if (b != 0) return;
                if (stage == 2) { (void)fZU; }
                if (stage == 3) dbg::cmp_kernel<true><<<1024, 256, 0, stream>>>(fACT, DFF, bf.A, DFF, S, DFF, ck + 10);
            });
        fp::fast_launch(d_in, d_out, d_ws, PB + 8, PB + 9, stream);
        fp::fast_launch(d_in, d_out, d_ws, PB + 9, PB + 10, stream);
        if (L < 3) dbg::cmp_kernel<true><<<1024, 256, 0, stream>>>(ws + fp::WS_X16, D, bf.X, D, M, D, ck + 12);
        else dbg::cmp_kernel<false><<<1024, 256, 0, stream>>>(fX, D, bf.X, D, M, D, ck + 12);
    }
    dbg::report_kernel<<<1024, 256, 0, stream>>>(sums, 28, fX, (size_t)M * D);
}
#endif
#endif
#if MODE == 1
extern "C" void kernel_launch(void* const* d_in, const int* in_sizes, int n_in, void* d_out, int out_size, void* d_ws, size_t ws_size, hipStream_t stream) {
    using namespace cfg;
    float* ws = (float*)d_ws;
    orc::Bufs bf;
    bf.X = (float*)d_out;
    size_t off = 0;
    bf.H = ws + off; off += (size_t)M * D;
    bf.O = ws + off; off += (size_t)M * D;
    bf.MF = ws + off; off += (size_t)M * D;
    bf.Z = ws + off; off += (size_t)M * 8192;
    bf.U = ws + off; off += (size_t)M * NUP;
    bf.A = ws + off; off += (size_t)M * DFF;
    hipMemcpyAsync(bf.X, d_in[0], (size_t)M * D * 4, hipMemcpyDeviceToDevice, stream);
    for (int layer = 0; layer < 4; ++layer) {
        orc::run_mixer(bf, d_in, layer, 0, B, stream, orc::NoHook());
        orc::run_ffn(bf, d_in, layer, 0, B, stream, orc::NoHook());
    }
}
#endif
```

```cpp
#define MODE 0
#include <hip/hip_runtime.h>
#include <stdint.h>
#include <stdio.h>
#include <math.h>

#ifndef MODE
#define MODE 1
#endif

namespace cfg {
constexpr int B = 4, S = 2048, D = 2048, M = B * S, DFF = 5632, NUP = 2 * DFF, TOPK = 256;
constexpr int SWA_IN = 3072, DIFF_IN = 6144, HGRN_IN = 8192, DSA_IN = 4176, DSA_PAD = 4352;
constexpr float RMS_EPS = 1e-6f;
}
__constant__ unsigned char BUCKET_LUT[128] = {0,1,2,3,4,5,6,7,8,9,10,11,12,13,14,15,16,16,16,17,17,18,18,18,19,19,19,20,20,20,20,21,21,21,21,22,22,22,22,22,23,23,23,23,23,23,24,24,24,24,24,24,25,25,25,25,25,25,25,26,26,26,26,26,26,26,26,27,27,27,27,27,27,27,27,27,27,28,28,28,28,28,28,28,28,28,28,29,29,29,29,29,29,29,29,29,29,29,29,30,30,30,30,30,30,30,30,30,30,30,30,30,30,31,31,31,31,31,31,31,31,31,31,31,31,31,31,31};
#if MODE != 0
namespace orc {
using namespace cfg;

__device__ __forceinline__ float sigm(float x) { return 1.f / (1.f + expf(-x)); }
__device__ __forceinline__ int bucket(int n) { return n < 128 ? (int)BUCKET_LUT[n] : 31; }

__device__ __forceinline__ float wave_sum(float v) {
#pragma unroll
    for (int o = 32; o >= 1; o >>= 1) v += __shfl_xor(v, o);
    return v;
}
__device__ __forceinline__ float wave_max(float v) {
#pragma unroll
    for (int o = 32; o >= 1; o >>= 1) v = fmaxf(v, __shfl_xor(v, o));
    return v;
}
__device__ __forceinline__ float block_sum(float v, float* red) {
    v = wave_sum(v);
    const int w = threadIdx.x >> 6, nw = blockDim.x >> 6;
    __syncthreads();
    if ((threadIdx.x & 63) == 0) red[w] = v;
    __syncthreads();
    float r = 0.f;
    for (int i = 0; i < nw; ++i) r += red[i];
    return r;
}
__device__ __forceinline__ float block_max(float v, float* red) {
    v = wave_max(v);
    const int w = threadIdx.x >> 6, nw = blockDim.x >> 6;
    __syncthreads();
    if ((threadIdx.x & 63) == 0) red[w] = v;
    __syncthreads();
    float r = red[0];
    for (int i = 1; i < nw; ++i) r = fmaxf(r, red[i]);
    return r;
}

__global__ void __launch_bounds__(256) o_gemm(const float* __restrict__ A, int lda, const float* __restrict__ W, int ldw,
                                              float* __restrict__ C, int ldc, int N, int K) {
    __shared__ float As[16][132];
    __shared__ float Ws[16][132];
    const int tid = threadIdx.x, tx = tid & 15, ty = tid >> 4;
    const int m0 = blockIdx.y * 128, n0 = blockIdx.x * 128;
    float acc[8][8];
#pragma unroll
    for (int i = 0; i < 8; ++i)
#pragma unroll
        for (int j = 0; j < 8; ++j) acc[i][j] = 0.f;
    for (int k0 = 0; k0 < K; k0 += 16) {
#pragma unroll
        for (int i = 0; i < 8; ++i) { const int idx = tid + i * 256, r = idx >> 4, c = idx & 15; As[c][r] = A[(size_t)(m0 + r) * lda + k0 + c]; }
#pragma unroll
        for (int i = 0; i < 8; ++i) { const int idx = tid + i * 256, r = idx >> 7, c = idx & 127; Ws[r][c] = (n0 + c < N) ? W[(size_t)(k0 + r) * ldw + n0 + c] : 0.f; }
        __syncthreads();
#pragma unroll
        for (int kk = 0; kk < 16; ++kk) {
            float a[8], b[8];
#pragma unroll
            for (int i = 0; i < 8; ++i) { a[i] = As[kk][ty * 8 + i]; b[i] = Ws[kk][tx * 8 + i]; }
#pragma unroll
            for (int i = 0; i < 8; ++i)
#pragma unroll
                for (int j = 0; j < 8; ++j) acc[i][j] = fmaf(a[i], b[j], acc[i][j]);
        }
        __syncthreads();
    }
#pragma unroll
    for (int i = 0; i < 8; ++i)
#pragma unroll
        for (int j = 0; j < 8; ++j) { const int n = n0 + tx * 8 + j; if (n < N) C[(size_t)(m0 + ty * 8 + i) * ldc + n] = acc[i][j]; }
}

template <bool ADD>
__global__ void __launch_bounds__(256) o_rmsnorm(const float* __restrict__ in, const float* __restrict__ g, float* __restrict__ out) {
    __shared__ float red[16];
    const size_t row = blockIdx.x;
    const float* x = in + row * D;
    float ss = 0.f;
    for (int c = threadIdx.x; c < D; c += 256) ss += x[c] * x[c];
    ss = block_sum(ss, red);
    const float r = rsqrtf(ss / (float)D + RMS_EPS);
    for (int c = threadIdx.x; c < D; c += 256) { const float y = x[c] * r * g[c]; if (ADD) out[row * D + c] += y; else out[row * D + c] = y; }
}

__global__ void __launch_bounds__(128) o_swa(const float* __restrict__ Z, const float* __restrict__ bias, const float* __restrict__ sinks, float* __restrict__ O, int b0) {
    __shared__ float qs[64], ps[128], red[16];
    const int t = blockIdx.x, h = blockIdx.y, bl = blockIdx.z, kvh = h >> 2, tid = threadIdx.x;
    const size_t zr = (size_t)bl * S + t;
    const float* zq = Z + zr * 3072;
    if (tid < 64) qs[tid] = zq[h * 64 + tid];
    __syncthreads();
    const int j = tid, s = t - j;
    float sc = -INFINITY;
    if (s >= 0) {
        const float* kp = Z + (zr - j) * 3072 + 2048 + kvh * 64;
        float d = 0.f;
        for (int e = 0; e < 64; ++e) d = fmaf(qs[e], kp[e], d);
        sc = d * 0.125f + bias[bucket(j) * 32 + h];
    }
    const float sink = sinks[h];
    const float mx = fmaxf(block_max(sc, red), sink);
    const float p = (s >= 0) ? expf(sc - mx) : 0.f;
    const float den = block_sum(p, red) + expf(sink - mx);
    ps[j] = p / den;
    __syncthreads();
    if (tid < 64) {
        float o = 0.f;
        const int nj = t < 127 ? t + 1 : 128;
        for (int jj = 0; jj < nj; ++jj) o = fmaf(ps[jj], Z[(zr - jj) * 3072 + 2560 + kvh * 64 + tid], o);
        O[((size_t)(b0 + bl) * S + t) * D + h * 64 + tid] = o;
    }
}

__global__ void __launch_bounds__(256) o_diff(const float* __restrict__ Z, const float* __restrict__ bias, const float* __restrict__ lambdas, const float* __restrict__ subg,
                                              float* __restrict__ O, int b0, float lam_init) {
    __shared__ float qs[128], sc[2][2048], part[256], red[16];
    const int t = blockIdx.x, h = blockIdx.y, bl = blockIdx.z, tid = threadIdx.x;
    const size_t zr0 = (size_t)bl * S;
    const float* zq = Z + (zr0 + t) * 6144;
    if (tid < 128) qs[tid] = zq[h * 128 + tid];
    float l1 = 0.f, l2 = 0.f;
    if (tid < 64) { l1 = lambdas[tid] * lambdas[64 + tid]; l2 = lambdas[128 + tid] * lambdas[192 + tid]; }
    l1 = block_sum(l1, red); l2 = block_sum(l2, red);
    const float lam = expf(l1) - expf(l2) + lam_init;
    float mx[2], sm[2];
    for (int m = 0; m < 2; ++m) {
        float lmx = -INFINITY;
        for (int s = tid; s <= t; s += 256) {
            const float* kp = Z + (zr0 + s) * 6144 + 2048 + h * 128 + m * 64;
            float d = 0.f;
            for (int e = 0; e < 64; ++e) d = fmaf(qs[m * 64 + e], kp[e], d);
            const float v = d * 0.125f + bias[bucket(t - s) * 32 + h * 2 + m];
            sc[m][s] = v; lmx = fmaxf(lmx, v);
        }
        mx[m] = block_max(lmx, red);
        float ls = 0.f;
        for (int s = tid; s <= t; s += 256) ls += expf(sc[m][s] - mx[m]);
        sm[m] = block_sum(ls, red);
    }
    for (int s = tid; s <= t; s += 256) sc[0][s] = expf(sc[0][s] - mx[0]) / sm[0] - lam * (expf(sc[1][s] - mx[1]) / sm[1]);
    __syncthreads();
    const int e = tid & 127, half = tid >> 7;
    float o = 0.f;
    for (int s = half; s <= t; s += 2) o = fmaf(sc[0][s], Z[(zr0 + s) * 6144 + 4096 + h * 128 + e], o);
    part[tid] = o;
    __syncthreads();
    float ov = 0.f, ss = 0.f;
    if (tid < 128) { ov = part[tid] + part[tid + 128]; ss = ov * ov; }
    ss = block_sum(ss, red);
    if (tid < 128) {
        const float r = rsqrtf(ss / 128.f + RMS_EPS);
        O[((size_t)(b0 + bl) * S + t) * D + h * 128 + e] = ov * r * subg[e] * (1.f - lam_init);
    }
}

__global__ void __launch_bounds__(256) o_hgrn(const float* __restrict__ Z, const float* __restrict__ lb_logits, const float* __restrict__ ng, float* __restrict__ O, int b0) {
    __shared__ float qs[128], fs[128], ks[128], part[256], red[16];
    const int h = blockIdx.x, bl = blockIdx.z, tid = threadIdx.x, v = tid & 127, kh = tid >> 7;
    float lb = 0.f;
    if (tid < 128) {
        const int c = h * 128 + tid;
        const float a0 = lb_logits[c], a1 = lb_logits[2048 + c], a2 = lb_logits[4096 + c], a3 = lb_logits[6144 + c];
        const float mm = fmaxf(fmaxf(a0, a1), fmaxf(a2, a3));
        const float e0 = expf(a0 - mm), e1 = expf(a1 - mm), e2 = expf(a2 - mm), e3 = expf(a3 - mm);
        lb = (e1 + e2) / (e0 + e1 + e2 + e3);
    }
    float St[64];
#pragma unroll
    for (int i = 0; i < 64; ++i) St[i] = 0.f;
    const float gn = ng[v];
    for (int t = 0; t < S; ++t) {
        const float* zr = Z + ((size_t)bl * S + t) * 8192;
        if (tid < 128) {
            const float qv = zr[h * 128 + tid]; qs[tid] = qv * sigm(qv);
            const float z = zr[2048 + h * 128 + tid];
            fs[tid] = lb + (1.f - lb) * sigm(z);
            ks[tid] = (1.f - lb) * sigm(-z);
        }
        const float iv = zr[4096 + h * 128 + v];
        __syncthreads();
        float p = 0.f;
#pragma unroll
        for (int kk = 0; kk < 64; ++kk) { const int k = kh * 64 + kk; St[kk] = fmaf(fs[k], St[kk], ks[k] * iv); p = fmaf(qs[k], St[kk], p); }
        part[tid] = p;
        __syncthreads();
        float ov = 0.f, ss = 0.f;
        if (tid < 128) { ov = part[tid] + part[tid + 128]; ss = ov * ov; }
        ss = block_sum(ss, red);
        if (tid < 128) {
            const float r = rsqrtf(ss / 128.f + RMS_EPS);
            const float gt = zr[6144 + h * 128 + v];
            O[((size_t)(b0 + bl) * S + t) * D + h * 128 + v] = ov * r * gn * (gt * sigm(gt));
        }
        __syncthreads();
    }
}

__global__ void __launch_bounds__(256) o_dsa(const float* __restrict__ Z, const float* __restrict__ bias, float* __restrict__ O, int b0) {
    __shared__ float qi[1024], wi[16], sc[2048], q[2048], pj[256], red[16];
    __shared__ int idx[256];
    __shared__ unsigned char sel[2048];
    __shared__ int nsel_s;
    const int t = blockIdx.x, bl = blockIdx.z, tid = threadIdx.x;
    const size_t zr0 = (size_t)bl * S;
    const int LD = 4176;
    const float* zq = Z + (zr0 + t) * LD;
    for (int i = tid; i < 1024; i += 256) qi[i] = zq[3072 + i];
    for (int i = tid; i < 2048; i += 256) q[i] = zq[i];
    if (tid < 16) wi[tid] = zq[4160 + tid] * 0.25f;
    __syncthreads();
    for (int s = tid; s < S; s += 256) {
        float a = -INFINITY;
        if (s <= t) {
            const float* kp = Z + (zr0 + s) * LD + 4096;
            a = 0.f;
            for (int hh = 0; hh < 16; ++hh) {
                float d = 0.f;
                for (int e = 0; e < 64; ++e) d = fmaf(qi[hh * 64 + e], kp[e], d);
                d *= 0.125f;
                a += wi[hh] * fmaxf(d, 0.f);
            }
        }
        sc[s] = a;
    }
    __syncthreads();
    for (int s = tid; s < S; s += 256) {
        const float v = sc[s];
        int r = 0;
        for (int s2 = 0; s2 < S; ++s2) { const float v2 = sc[s2]; r += (v2 > v || (v2 == v && s2 < s)) ? 1 : 0; }
        sel[s] = (r < TOPK && s <= t) ? 1 : 0;
    }
    __syncthreads();
    if (tid == 0) { int n = 0; for (int s = 0; s < S; ++s) if (sel[s]) { if (n < 256) idx[n] = s; ++n; } nsel_s = n < 256 ? n : 256; }
    __syncthreads();
    const int nsel = nsel_s;
    for (int h = 0; h < 32; ++h) {
        const int kvh = h >> 2;
        float scv = -INFINITY; int s = 0;
        if (tid < nsel) {
            s = idx[tid];
            const float* kp = Z + (zr0 + s) * LD + 2048 + kvh * 64;
            float d = 0.f;
            for (int e = 0; e < 64; ++e) d = fmaf(q[h * 64 + e], kp[e], d);
            scv = d * 0.125f + bias[bucket(t - s) * 32 + h];
        }
        const float mx = block_max(scv, red);
        const float ev = (tid < nsel) ? expf(scv - mx) : 0.f;
        const float sm = block_sum(ev, red);
        pj[tid] = ev / sm;
        __syncthreads();
        if (tid < 64) {
            float o = 0.f;
            for (int j = 0; j < nsel; ++j) o = fmaf(pj[j], Z[(zr0 + idx[j]) * LD + 2560 + kvh * 64 + tid], o);
            O[((size_t)(b0 + bl) * S + t) * D + h * 64 + tid] = o;
        }
        __syncthreads();
    }
}

__global__ void __launch_bounds__(256) o_convact(const float* __restrict__ U, const float* __restrict__ cw, float* __restrict__ A) {
    const int c = blockIdx.x * 256 + threadIdx.x; const size_t r = blockIdx.y; const int t = (int)(r % S);
    float g = 0.f, v = 0.f;
#pragma unroll
    for (int j = 0; j < 3; ++j) {
        const int tt = t - 2 + j;
        if (tt >= 0) { const float* u = U + (r - 2 + j) * NUP; g = fmaf(cw[j * NUP + c], u[c], g); v = fmaf(cw[j * NUP + DFF + c], u[DFF + c], v); }
    }
    A[r * DFF + c] = g * sigm(g) * v;
}

struct Bufs { float *X, *H, *Z, *O, *MF, *U, *A; };

template <class Hook> static void run_mixer(const Bufs& bf, void* const* d_in, int layer, int b0, int nb, hipStream_t st, Hook hook) {
    const float* ng = (const float*)d_in[3] + (size_t)layer * 4 * D;
    const int rows = nb * S; const size_t r0 = (size_t)b0 * S;
    const float* bias = (const float*)d_in[1];
    o_rmsnorm<false><<<rows, 256, 0, st>>>(bf.X + r0 * D, ng, bf.H);
    hook(0);
    const int kind = layer % 4;
    const float* win = (const float*)d_in[kind == 0 ? 7 : kind == 1 ? 10 : kind == 2 ? 14 : 17];
    const float* wout = (const float*)d_in[kind == 0 ? 8 : kind == 1 ? 11 : kind == 2 ? 15 : 18];
    const int nin = kind == 0 ? SWA_IN : kind == 1 ? DIFF_IN : kind == 2 ? HGRN_IN : DSA_IN;
    o_gemm<<<dim3((nin + 127) / 128, rows / 128), 256, 0, st>>>(bf.H, D, win, nin, bf.Z, nin, nin, D);
    hook(1);
    if (kind == 0) o_swa<<<dim3(S, 32, nb), 128, 0, st>>>(bf.Z, bias, (const float*)d_in[9], bf.O, b0);
    else if (kind == 1) o_diff<<<dim3(S, 16, nb), 256, 0, st>>>(bf.Z, bias, (const float*)d_in[12], (const float*)d_in[13], bf.O, b0, 0.8f - 0.6f * expf(-0.3f * (float)layer));
    else if (kind == 2) o_hgrn<<<dim3(16, 1, nb), 256, 0, st>>>(bf.Z, (const float*)d_in[2], (const float*)d_in[16], bf.O, b0);
    else o_dsa<<<dim3(S, 1, nb), 256, 0, st>>>(bf.Z, bias, bf.O, b0);
    o_gemm<<<dim3(D / 128, rows / 128), 256, 0, st>>>(bf.O + r0 * D, D, wout, D, bf.MF + r0 * D, D, D, D);
    o_rmsnorm<true><<<rows, 256, 0, st>>>(bf.MF + r0 * D, ng + D, bf.X + r0 * D);
}
template <class Hook> static void run_ffn(const Bufs& bf, void* const* d_in, int layer, int b0, int nb, hipStream_t st, Hook hook) {
    const float* ng = (const float*)d_in[3] + (size_t)layer * 4 * D;
    const int rows = nb * S; const size_t r0 = (size_t)b0 * S;
    o_rmsnorm<false><<<rows, 256, 0, st>>>(bf.X + r0 * D, ng + 2 * D, bf.H);
    o_gemm<<<dim3(NUP / 128, rows / 128), 256, 0, st>>>(bf.H, D, (const float*)d_in[4] + (size_t)layer * D * NUP, NUP, bf.U, NUP, NUP, D);
    hook(2);
    o_convact<<<dim3(DFF / 256, rows), 256, 0, st>>>(bf.U, (const float*)d_in[5] + (size_t)layer * 3 * NUP, bf.A);
    hook(3);
    o_gemm<<<dim3(D / 128, rows / 128), 256, 0, st>>>(bf.A, DFF, (const float*)d_in[6] + (size_t)layer * DFF * D, D, bf.MF + r0 * D, D, D, DFF);
    o_rmsnorm<true><<<rows, 256, 0, st>>>(bf.MF + r0 * D, ng + 3 * D, bf.X + r0 * D);
}
struct NoHook { void operator()(int) const {} };
}

#endif

#if MODE != 1
#define GAS __attribute__((address_space(1)))
#define LAS __attribute__((address_space(3)))
typedef _Float16 half_t;
typedef _Float16 h16x8 __attribute__((ext_vector_type(8)));
typedef _Float16 h16x4 __attribute__((ext_vector_type(4)));
typedef _Float16 h16x2 __attribute__((ext_vector_type(2)));
typedef float f32x4 __attribute__((ext_vector_type(4)));
typedef float f32x2 __attribute__((ext_vector_type(2)));
typedef unsigned u32x4 __attribute__((ext_vector_type(4)));
typedef unsigned u32x2 __attribute__((ext_vector_type(2)));
#define MFMA16(a, b, c) __builtin_amdgcn_mfma_f32_16x16x32_f16((a), (b), (c), 0, 0, 0)
__device__ __forceinline__ unsigned pkh(float lo, float hi) { h16x2 v; v.x = (_Float16)lo; v.y = (_Float16)hi; return __builtin_bit_cast(unsigned, v); }
__device__ __forceinline__ float fexp2(float x) { return __builtin_amdgcn_exp2f(x); }
__device__ __forceinline__ float fexp(float x) { return __builtin_amdgcn_exp2f(x * 1.4426950408889634f); }
__device__ __forceinline__ float fsigm(float x) { return __builtin_amdgcn_rcpf(1.f + fexp(-x)); }

#define XB_TMO      128
#define XB_XCNT(j)  (256  + 64 * (j))
#define XB_XSUB(j)  (1280 + 64 * (j))
#define XB_XGEN(j)  (2304 + 64 * (j))
#define XB_TOP      3328
#define XB_TOPGEN   3392
#define XCD_BAR_WORDS 3456
#define XB_SPIN_CAP (1u << 18)

__device__ __forceinline__ unsigned xb_ld(unsigned* p)              { return __hip_atomic_load(p, __ATOMIC_RELAXED, __HIP_MEMORY_SCOPE_AGENT); }
__device__ __forceinline__ unsigned xb_add(unsigned* p, unsigned v) { return __hip_atomic_fetch_add(p, v, __ATOMIC_RELAXED, __HIP_MEMORY_SCOPE_AGENT); }
__device__ __forceinline__ unsigned xb_xcc_id() { return (unsigned)__builtin_amdgcn_s_getreg((3 << 11) | 20) & 0xFu; }
#define XB_SPIN(cond, bar) do { unsigned _sp = 0; while (cond) { __builtin_amdgcn_s_sleep(1); \
    if ((++_sp & 255u) == 0u) { if (xb_ld(&(bar)[XB_TMO])) break; if (_sp > XB_SPIN_CAP) { atomicAdd(&(bar)[XB_TMO], 1u); break; } } } } while (0)

struct XcdBarrier {
    unsigned* bar; unsigned x;
    volatile LAS unsigned* st;
};

__device__ __forceinline__ XcdBarrier xcd_barrier_post(unsigned* bar, volatile LAS unsigned* st) {
    XcdBarrier b; b.bar = bar; b.x = xb_xcc_id(); b.st = st;
    if (threadIdx.x == 0) (void)xb_add(&bar[XB_XCNT(b.x)], 1u);
    return b;
}
__device__ __forceinline__ void xcd_barrier_complete(unsigned* bar, unsigned x, unsigned& nloc, unsigned& nx) {
    const unsigned G = gridDim.x * gridDim.y * gridDim.z;
    unsigned sum, cnt, mine, sp = 0u;
    for (;;) {
        sum = 0u; cnt = 0u; mine = 0u;
#pragma unroll
        for (unsigned j = 0; j < 16; ++j) { const unsigned c = xb_ld(&bar[XB_XCNT(j)]); sum += c; cnt += (c > 0u) ? 1u : 0u; mine = (j == x) ? c : mine; }
        if (sum == G) break;
        __builtin_amdgcn_s_sleep(1);
        if ((++sp & 255u) == 0u) { if (xb_ld(&bar[XB_TMO])) break; if (sp > XB_SPIN_CAP) { atomicAdd(&bar[XB_TMO], 1u); break; } }
    }
    nloc = mine > 0u ? mine : 1u; nx = cnt > 0u ? cnt : 1u;
}

__device__ __forceinline__ void xcd_barrier(const XcdBarrier& b) {
    asm volatile("s_waitcnt vmcnt(0)" ::: "memory");
    __syncthreads();
    if (threadIdx.x == 0) {
        unsigned* bar = b.bar;
        __builtin_amdgcn_s_waitcnt(0);
        unsigned nloc = b.st[0], nx = b.st[1];
        if (nloc == 0u) { xcd_barrier_complete(bar, b.x, nloc, nx); b.st[0] = nloc; b.st[1] = nx; }
        const unsigned old = xb_add(&bar[XB_XSUB(b.x)], 1u);
        const unsigned gen = old / nloc;
        if (old + 1u == (gen + 1u) * nloc) {
            __builtin_amdgcn_fence(__ATOMIC_RELEASE, "agent");
            asm volatile("s_waitcnt vmcnt(0)" ::: "memory");
            const unsigned og = xb_add(&bar[XB_TOP], 1u);
            const unsigned tg = og / nx;
            if (og + 1u == (tg + 1u) * nx) xb_add(&bar[XB_TOPGEN], 1u);
            else XB_SPIN(xb_ld(&bar[XB_TOPGEN]) == tg, bar);
            __builtin_amdgcn_fence(__ATOMIC_ACQUIRE, "agent");
            xb_add(&bar[XB_XGEN(b.x)], 1u);
            asm volatile("s_waitcnt vmcnt(0)" ::: "memory");
        } else {
            XB_SPIN(xb_ld(&bar[XB_XGEN(b.x)]) == gen, bar);
            __builtin_amdgcn_fence(__ATOMIC_ACQUIRE, "agent");
            asm volatile("s_waitcnt vmcnt(0)" ::: "memory");
        }
    }
    __syncthreads();
}

template <int CTRL> __device__ __forceinline__ float dppx_f(float v) { return __builtin_bit_cast(float, __builtin_amdgcn_update_dpp(0, __builtin_bit_cast(int, v), CTRL, 0xf, 0xf, true)); }
template <int CTRL> __device__ __forceinline__ float dppo_f(float old, float v) { return __builtin_bit_cast(float, __builtin_amdgcn_update_dpp(__builtin_bit_cast(int, old), __builtin_bit_cast(int, v), CTRL, 0xf, 0xf, false)); }
namespace pg8 {
#define PG8_LAS __attribute__((address_space(3)))
constexpr int BM = 256, BK = 64, HALF = 128, HTB = HALF * BK * 2  , STAGE_BYTES = 8 * HTB, NXCD = 8, WGM = 8;
__host__ __device__ __forceinline__ int lds_byte(int r, int c) { const int st = (r >> 4) * 2 + (c >> 5), rr = r & 15, cc = c & 31, ob = rr * 64 + cc * 2; return st * 1024 + (ob ^ (((ob >> 9) & 1) << 5)); }
__host__ __device__ __forceinline__ void stage_rc(int b, int& R, int& C) { const int st = b / 1024, sb = b % 1024, swz = sb ^ (((sb >> 9) & 1) << 5); R = (st >> 1) * 16 + swz / 64; C = (st & 1) * 32 + (swz % 64) / 2; }
__host__ __device__ __forceinline__ int perm32(int rho) { const int n = rho >> 4, i = rho & 15; return 8 * (i >> 2) + 4 * n + (i & 3); }
struct Unit { int pm, pn; };
struct Gemm { const half_t* A; const half_t* Bt; int M, N, K; int a_step = 256, a_off = 0; };
struct StaticOrder {
    int nM, nN, nwg, G, c;
    __host__ __device__ void init(int M, int N, int G_, int c_) { nM = M / BM; nN = N / BM; nwg = nM * nN; G = G_; c = c_; }
    __host__ __device__ bool next(int i, Unit& u) const {
        const long L = (long)i * G + c; if (L >= nwg) return false;
        int wgid = (int)L; { const int q = nwg / NXCD, r = nwg % NXCD, xcd = wgid % NXCD, off = wgid / NXCD; wgid = (xcd < r ? xcd * (q + 1) : r * (q + 1) + (xcd - r) * q) + off; }
        const int nig = WGM * nN, gid = wgid / nig, fm = gid * WGM, gsz = (nM - fm) < WGM ? (nM - fm) : WGM;
        u.pm = fm + ((wgid % nig) % gsz); u.pn = (wgid % nig) / gsz; return true;
    }
    __device__ __forceinline__ void a_ready(const Unit&) const {}
    __device__ __forceinline__ void done(const Unit&) const {}
};
struct EpiF32 {
    static constexpr bool PERM = false, AFTER_DRAIN = false;
    float* C; int ldc;
    __device__ __forceinline__ void operator()(const f32x4 (&acc)[2][2][4][2], const Unit& u, int wr, int wc, int fr, int fq) const {
        const int row0 = u.pm * BM + wr * 64 + fr, col0 = u.pn * BM + wc * 32 + 4 * fq;
#pragma unroll
        for (int ai = 0; ai < 2; ++ai)
#pragma unroll
            for (int m = 0; m < 4; ++m) { float* rowp = C + (size_t)(row0 + ai * HALF + m * 16) * ldc + col0;
#pragma unroll
                for (int bj = 0; bj < 2; ++bj)
#pragma unroll
                    for (int n = 0; n < 2; ++n) *(f32x4*)(rowp + bj * HALF + n * 16) = acc[ai][bj][m][n]; }
    }
};
template <bool SCALE>
struct EpiH16T {
    static constexpr bool PERM = true, AFTER_DRAIN = false;
    half_t* O; int ldc; const float* rs = nullptr;
    __device__ __forceinline__ void operator()(const f32x4 (&acc)[2][2][4][2], const Unit& u, int wr, int wc, int fr, int fq) const {
        const int row0 = u.pm * BM + wr * 64 + fr, col0 = u.pn * BM + wc * 32 + 8 * fq;
        float sc[2][4];
#pragma unroll
        for (int ai = 0; ai < 2; ++ai)
#pragma unroll
            for (int m = 0; m < 4; ++m) sc[ai][m] = SCALE ? rs[row0 + ai * HALF + m * 16] : 1.f;
#pragma unroll
        for (int ai = 0; ai < 2; ++ai)
#pragma unroll
            for (int m = 0; m < 4; ++m) { half_t* rowp = O + (size_t)(row0 + ai * HALF + m * 16) * ldc + col0;
#pragma unroll
                for (int bj = 0; bj < 2; ++bj) { f32x4 v0 = acc[ai][bj][m][0], v1 = acc[ai][bj][m][1];
                    if (SCALE) { v0 *= sc[ai][m]; v1 *= sc[ai][m]; }
                    u32x4 w; w.x = pkh(v0[0], v0[1]); w.y = pkh(v0[2], v0[3]); w.z = pkh(v1[0], v1[1]); w.w = pkh(v1[2], v1[3]);
                    *(u32x4*)(rowp + bj * HALF) = w; } }
    }
};
using EpiH16 = EpiH16T<false>;
struct EpiConv {
    static constexpr bool PERM = true, AFTER_DRAIN = false;
    half_t* ACT; const float* cw; PG8_LAS float* xb; int Mrows, seq, dff, nup; const float* rs;
    __device__ __forceinline__ void operator()(f32x4 (&acc)[2][2][4][2], const Unit& u, int wr, int wc, int fr, int fq) const {
        int cc0 = wc * 32 + 8 * fq;
        asm volatile("" : "+v"(cc0));
        PG8_LAS float* wl = xb + 2048; PG8_LAS float* rsl = xb + 2048 + 768;
        if (fr >= 14) {
#pragma unroll
            for (int ai = 0; ai < 2; ++ai)
#pragma unroll
                for (int bj = 0; bj < 2; ++bj)
#pragma unroll
                    for (int n = 0; n < 2; ++n) *(PG8_LAS f32x4*)(xb + ((((2 * ai + wr) * 2 + (fr - 14)) * 2 + bj) * 128) + cc0 + 4 * n) = acc[ai][bj][3][n];
        }
        { const int t = (wr * 4 + wc) * 64 + fq * 16 + fr;
          for (int idx = t; idx < 768; idx += 512) { const int j = idx >> 8, col = idx & 255; wl[idx] = cw[(size_t)j * nup + (col >> 7) * dff + 128 * u.pn + (col & 127)]; }
          if (t < 256) { int gr = 254 * u.pm - 2 + t; gr = gr < 0 ? 0 : (gr >= Mrows ? Mrows - 1 : gr); rsl[t] = rs[gr]; } }
        asm volatile("s_waitcnt vmcnt(0) lgkmcnt(0)" ::: "memory"); __builtin_amdgcn_s_barrier(); asm volatile("" ::: "memory");
        const int gr0 = 254 * u.pm - 2;
        const bool hs = ((gr0 + 255) >> 11) != ((gr0 - 2) >> 11);
#pragma unroll
        for (int ai = 0; ai < 2; ++ai) {
            const int pred = 2 * ai + wr - 1;
#pragma unroll
            for (int mm = 0; mm < 4; ++mm) {
                const int m = 3 - mm;
                const int R = 128 * ai + 64 * wr + 16 * m + fr, gr = gr0 + R, ts = gr & (seq - 1);
                if (mm == 0) { const float rc = rsl[R];
#pragma unroll
                    for (int bj = 0; bj < 2; ++bj)
#pragma unroll
                        for (int n = 0; n < 2; ++n) acc[ai][bj][3][n] *= rc; }
                if (m > 0) { const float rp = rsl[R - 16];
#pragma unroll
                    for (int bj = 0; bj < 2; ++bj)
#pragma unroll
                        for (int n = 0; n < 2; ++n) acc[ai][bj][m > 0 ? m - 1 : 0][n] *= rp; }
                float rx0 = 0.f, rx1 = 0.f;
                if (m == 0 && pred >= 0) { rx0 = rsl[64 * pred + 62]; rx1 = rsl[64 * pred + 63]; }
#pragma unroll
                for (int n = 0; n < 2; ++n) {
                    f32x4 cv[2];
#pragma unroll
                    for (int bj = 0; bj < 2; ++bj) {
                        const f32x4 cur = acc[ai][bj][m][n];
                        f32x4 p1, p2;
                        if (m > 0) {
                            const f32x4 pv = acc[ai][bj][m > 0 ? m - 1 : 0][n];
#pragma unroll
                            for (int e = 0; e < 4; ++e) { const float q1 = dppx_f<0x121>(pv[e]), q2 = dppx_f<0x122>(pv[e]);
                                p1[e] = dppo_f<0x111>(q1, cur[e]); p2[e] = dppo_f<0x112>(q2, cur[e]); }
                        } else {
                            f32x4 x0 = (f32x4){0.f, 0.f, 0.f, 0.f}, x1 = x0;
                            if (pred >= 0) { x0 = *(const PG8_LAS f32x4*)(xb + (((pred * 2 + 0) * 2 + bj) * 128) + cc0 + 4 * n); x1 = *(const PG8_LAS f32x4*)(xb + (((pred * 2 + 1) * 2 + bj) * 128) + cc0 + 4 * n); x0 *= rx0; x1 *= rx1; }
#pragma unroll
                            for (int e = 0; e < 4; ++e) { const float o2 = (fr == 0) ? x0[e] : x1[e];
                                p1[e] = dppo_f<0x111>(x1[e], cur[e]); p2[e] = dppo_f<0x112>(o2, cur[e]); }
                        }
                        if (hs) {
#pragma unroll
                            for (int e = 0; e < 4; ++e) { p1[e] = (ts >= 1) ? p1[e] : 0.f; p2[e] = (ts >= 2) ? p2[e] : 0.f; }
                        }
                        const f32x4 w0 = *(const PG8_LAS f32x4*)(wl + 0 * 256 + bj * 128 + cc0 + 4 * n), w1 = *(const PG8_LAS f32x4*)(wl + 1 * 256 + bj * 128 + cc0 + 4 * n), w2 = *(const PG8_LAS f32x4*)(wl + 2 * 256 + bj * 128 + cc0 + 4 * n);
                        cv[bj] = w0 * p2 + w1 * p1 + w2 * cur;
                    }
                    float r_[4];
#pragma unroll
                    for (int e = 0; e < 4; ++e) { const float g_ = cv[0][e]; r_[e] = g_ * __builtin_amdgcn_rcpf(1.f + __builtin_amdgcn_exp2f(-1.4426950408889634f * g_)) * cv[1][e]; }
                    u32x2 o; o.x = pkh(r_[0], r_[1]); o.y = pkh(r_[2], r_[3]);
                    if (R >= 2 && gr < Mrows) *(u32x2*)(ACT + (size_t)gr * dff + 128 * u.pn + cc0 + 4 * n) = o;
                    asm volatile("" ::: "memory"); __builtin_amdgcn_sched_barrier(0);
                }
                asm volatile("" ::: "memory"); __builtin_amdgcn_sched_barrier(0);
            }
        }
    }
};
template <class Epi, class Sched, bool ALIGN_EPI = false, bool SP2 = false>
__device__ __forceinline__ void gemm_phase(PG8_LAS unsigned char* lds, const Gemm g, const Sched& S, const Epi& E) {
    const int tid = threadIdx.x, wid = __builtin_amdgcn_readfirstlane(tid >> 6), lane = tid & 63, wr = wid >> 2, wc = wid & 3, fr = lane & 15, fq = lane >> 4;
    const int K = g.K, nt = K / BK;
    unsigned voffA[2], voffB[2];
#pragma unroll
    for (int i = 0; i < 2; ++i) { int R, C; stage_rc(tid * 16 + i * 8192, R, C); const int Rb = Epi::PERM ? ((R & ~31) + perm32(R & 31)) : R;
        voffA[i] = (unsigned)(R * K + C) * 2u; voffB[i] = (unsigned)(Rb * K + C) * 2u; }
    const size_t kstep = (size_t)(BK * 2);
    const size_t hstep = (size_t)HALF * K * 2;
    const size_t tstep = 2 * hstep;
    const unsigned ldsw = (unsigned)wid * 1024u;
    const int aoff = lds_byte(wr * 64 + fr, fq * 8), boff = lds_byte(wc * 32 + fr, fq * 8);
#define PG8_SA(b, h) (((b) * 2 + (h)) * HTB)
#define PG8_SB(b, h) ((4 + (b) * 2 + (h)) * HTB)
#define PG8_STAGE(bufoff, gbase, voff) do { _Pragma("unroll") for (int _i = 0; _i < 2; ++_i) \
        __builtin_amdgcn_global_load_lds((const unsigned*)((const char*)(gbase) + (voff)[_i]), (PG8_LAS unsigned*)(lds + (bufoff) + ldsw + _i * 8192), 16, 0, 0); } while (0)
#define PG8_LDA(dst, b, h) do { _Pragma("unroll") for (int m = 0; m < 4; ++m) _Pragma("unroll") for (int k = 0; k < 2; ++k) dst[m][k] = *(const PG8_LAS h16x8*)(lds + PG8_SA(b, h) + aoff + m * 2048 + k * 1024); } while (0)
#define PG8_LDB(dst, b, h) do { _Pragma("unroll") for (int n = 0; n < 2; ++n) _Pragma("unroll") for (int k = 0; k < 2; ++k) dst[n][k] = *(const PG8_LAS h16x8*)(lds + PG8_SB(b, h) + boff + n * 2048 + k * 1024); } while (0)
#define PG8_MMA(ai, bj, At, Bt) do { __builtin_amdgcn_s_setprio(1); _Pragma("unroll") for (int m = 0; m < 4; ++m) _Pragma("unroll") for (int n = 0; n < 2; ++n) _Pragma("unroll") for (int k = 0; k < 2; ++k) \
        acc[ai][bj][m][n] = __builtin_amdgcn_mfma_f32_16x16x32_f16(Bt[n][k], At[m][k], acc[ai][bj][m][n], 0, 0, 0); __builtin_amdgcn_s_setprio(0); } while (0)
#define PG8_WAIT_V(n) asm volatile("s_waitcnt vmcnt(" #n ")" ::: "memory")
#define PG8_WAIT_L(n) asm volatile("s_waitcnt lgkmcnt(" #n ")" ::: "memory")
#define PG8_BAR __builtin_amdgcn_s_barrier()
#define PG8_SCHED __builtin_amdgcn_sched_barrier(0)
    Unit cur, nxt; int ui = 0;
    if (!S.next(0, cur)) return;
    f32x4 acc[2][2][4][2];
#pragma unroll
    for (int a = 0; a < 2; ++a)
#pragma unroll
        for (int b = 0; b < 2; ++b)
#pragma unroll
            for (int m = 0; m < 4; ++m)
#pragma unroll
                for (int n = 0; n < 2; ++n) acc[a][b][m][n] = (f32x4){0.f, 0.f, 0.f, 0.f};
    h16x8 At[4][2], B0[2][2], B1[2][2];
    const long arow_bytes = (long)K * 2; const char* cA = (const char*)g.A + ((long)cur.pm * g.a_step + g.a_off) * arow_bytes; const char* cB = (const char*)g.Bt + (size_t)cur.pn * tstep;
    S.a_ready(cur);
    if constexpr (SP2) {
        PG8_STAGE(PG8_SB(0, 0), cB, voffB); PG8_STAGE(PG8_SB(0, 1), cB + hstep, voffB); PG8_STAGE(PG8_SA(0, 0), cA, voffA); PG8_STAGE(PG8_SA(0, 1), cA + hstep, voffA);
        if (wr == 1) PG8_BAR;
        PG8_WAIT_V(2); PG8_BAR;
        PG8_STAGE(PG8_SB(1, 0), cB + kstep, voffB); PG8_STAGE(PG8_SA(1, 0), cA + kstep, voffA); PG8_STAGE(PG8_SB(1, 1), cB + hstep + kstep, voffB);
        PG8_WAIT_V(6); PG8_BAR;
    } else {
        PG8_STAGE(PG8_SB(0, 0), cB, voffB); PG8_STAGE(PG8_SA(0, 0), cA, voffA); PG8_STAGE(PG8_SB(0, 1), cB + hstep, voffB); PG8_STAGE(PG8_SA(0, 1), cA + hstep, voffA);
        if (wr == 1) PG8_BAR;
        PG8_WAIT_V(4); PG8_BAR;
        PG8_STAGE(PG8_SB(1, 0), cB + kstep, voffB); PG8_STAGE(PG8_SA(1, 0), cA + kstep, voffA); PG8_STAGE(PG8_SB(1, 1), cB + hstep + kstep, voffB);
        PG8_WAIT_V(6); PG8_BAR;
    }
    for (;;) {
        const bool has_next = S.next(ui + 1, nxt);
        const char* nA = has_next ? (const char*)g.A + ((long)nxt.pm * g.a_step + g.a_off) * arow_bytes : cA; const char* nB = has_next ? (const char*)g.Bt + (size_t)nxt.pn * tstep : cB;
        for (int t = 0; t < nt; t += 2) {
            const bool last = (t == nt - 2);
            const char* a1 = cA + (size_t)(t + 1) * kstep;
            const char* a2 = last ? nA : cA + (size_t)(t + 2) * kstep; const char* b2 = last ? nB : cB + (size_t)(t + 2) * kstep;
            const char* a3 = a2 + kstep; const char* b3 = b2 + kstep;
            if (last && has_next) S.a_ready(nxt);
            if constexpr (SP2) {
            PG8_LDB(B0, 0, 0); PG8_LDB(B1, 0, 1); PG8_SCHED; PG8_LDA(At, 0, 0); PG8_STAGE(PG8_SA(1, 1), a1 + hstep, voffA);
            PG8_WAIT_V(8); PG8_WAIT_L(0); PG8_BAR; PG8_MMA(0, 0, At, B0); PG8_MMA(0, 1, At, B1); PG8_BAR; PG8_SCHED;
            PG8_LDA(At, 0, 1); PG8_STAGE(PG8_SB(0, 0), b2, voffB); PG8_STAGE(PG8_SB(0, 1), b2 + hstep, voffB); PG8_STAGE(PG8_SA(0, 0), a2, voffA);
            PG8_WAIT_V(8); PG8_WAIT_L(0); PG8_BAR; PG8_MMA(1, 0, At, B0); PG8_MMA(1, 1, At, B1); PG8_BAR; PG8_SCHED;
            PG8_LDB(B0, 1, 0); PG8_LDB(B1, 1, 1); PG8_SCHED; PG8_LDA(At, 1, 0); PG8_STAGE(PG8_SA(0, 1), a2 + hstep, voffA);
            PG8_WAIT_V(8); PG8_WAIT_L(0); PG8_BAR; PG8_MMA(0, 0, At, B0); PG8_MMA(0, 1, At, B1); PG8_BAR; PG8_SCHED;
            PG8_LDA(At, 1, 1); PG8_STAGE(PG8_SB(1, 0), b3, voffB); PG8_STAGE(PG8_SB(1, 1), b3 + hstep, voffB); PG8_STAGE(PG8_SA(1, 0), a3, voffA);
            PG8_WAIT_V(8); PG8_WAIT_L(0); PG8_BAR; PG8_MMA(1, 0, At, B0); PG8_MMA(1, 1, At, B1); PG8_BAR; PG8_SCHED;
            } else {
            PG8_LDB(B0, 0, 0); PG8_SCHED; PG8_LDA(At, 0, 0); PG8_STAGE(PG8_SA(1, 1), a1 + hstep, voffA);
            PG8_WAIT_L(8); PG8_BAR; PG8_WAIT_L(0); PG8_MMA(0, 0, At, B0); PG8_BAR; PG8_SCHED;
            PG8_LDB(B1, 0, 1); PG8_STAGE(PG8_SB(0, 0), b2, voffB);
            PG8_BAR; PG8_WAIT_L(0); PG8_MMA(0, 1, At, B1); PG8_BAR;
            PG8_LDA(At, 0, 1); PG8_STAGE(PG8_SA(0, 0), a2, voffA);
            PG8_BAR; PG8_WAIT_L(0); PG8_MMA(1, 0, At, B0); PG8_BAR; PG8_SCHED;
            PG8_STAGE(PG8_SB(0, 1), b2 + hstep, voffB);
            PG8_WAIT_V(6); PG8_BAR; PG8_MMA(1, 1, At, B1); PG8_BAR;
            PG8_LDB(B0, 1, 0); PG8_SCHED; PG8_LDA(At, 1, 0); PG8_STAGE(PG8_SA(0, 1), a2 + hstep, voffA);
            PG8_WAIT_L(8); PG8_BAR; PG8_WAIT_L(0); PG8_MMA(0, 0, At, B0); PG8_BAR; PG8_SCHED;
            PG8_LDB(B1, 1, 1); PG8_STAGE(PG8_SB(1, 0), b3, voffB);
            PG8_BAR; PG8_WAIT_L(0); PG8_MMA(0, 1, At, B1); PG8_BAR;
            PG8_LDA(At, 1, 1); PG8_STAGE(PG8_SA(1, 0), a3, voffA);
            PG8_BAR; PG8_WAIT_L(0); PG8_MMA(1, 0, At, B0); PG8_BAR; PG8_SCHED;
            PG8_STAGE(PG8_SB(1, 1), b3 + hstep, voffB);
            PG8_WAIT_V(6); PG8_BAR; PG8_MMA(1, 1, At, B1); PG8_BAR;
            }
        }
        if constexpr (ALIGN_EPI) { if (wr == 0) PG8_BAR; }
        if constexpr (!Epi::AFTER_DRAIN) { E(acc, cur, wr, wc, fr, fq); S.done(cur); }
#if defined(PROBE_MASK) && ((PROBE_MASK >> 11) & 1)
        if constexpr (!Epi::AFTER_DRAIN) { asm volatile("" ::: "memory"); E(acc, cur, wr, wc, fr, fq); }
#endif
        if (!has_next) break;
#pragma unroll
        for (int a = 0; a < 2; ++a)
#pragma unroll
            for (int b = 0; b < 2; ++b)
#pragma unroll
                for (int m = 0; m < 4; ++m)
#pragma unroll
                    for (int n = 0; n < 2; ++n) acc[a][b][m][n] = (f32x4){0.f, 0.f, 0.f, 0.f};
        cur = nxt; cA = nA; cB = nB; ++ui;
        if constexpr (ALIGN_EPI) { if (wr == 1) PG8_BAR; }
    }
    PG8_WAIT_V(0);
    if constexpr (!ALIGN_EPI) { if (wr == 0) PG8_BAR; }
    PG8_BAR;
    if constexpr (Epi::AFTER_DRAIN) { E.fused(acc, cur, wr, wc, fr, fq, lds, wid, lane); S.done(cur); }
#undef PG8_SA
#undef PG8_SB
#undef PG8_STAGE
#undef PG8_LDA
#undef PG8_LDB
#undef PG8_MMA
#undef PG8_WAIT_V
#undef PG8_WAIT_L
#undef PG8_BAR
#undef PG8_SCHED
}
}

namespace fp {
using namespace cfg;
constexpr int NW = 8, NTH = 512;
constexpr int RING_BYTES = 131072, MISC_OFF = RING_BYTES, LDS_BYTES = 147456;
constexpr size_t MiB = 1u << 20;
constexpr size_t WS_CTL = 0, CTL_BYTES = 1 * MiB;
constexpr size_t WS_WIN0 = 1 * MiB, WS_WIN1 = WS_WIN0 + 12 * MiB, WS_WIN2 = WS_WIN1 + 24 * MiB, WS_WIN3 = WS_WIN2 + 32 * MiB;
constexpr size_t WS_WOUT = WS_WIN3 + 17 * MiB, WOUT_STRIDE = 8 * MiB;
constexpr size_t WS_WUP = WS_WOUT + 32 * MiB, WUP_STRIDE = 44 * MiB;
constexpr size_t WS_WDN = WS_WUP + 176 * MiB, WDN_STRIDE = 22 * MiB;
constexpr size_t WS_H = WS_WDN + 88 * MiB;
constexpr size_t WS_ZU = WS_H + 32 * MiB;
constexpr size_t WS_O = WS_ZU + 176 * MiB;
constexpr size_t WS_MF = WS_O + 32 * MiB;
constexpr size_t WS_ACT = WS_MF + 64 * MiB;
constexpr size_t WS_MBITS = WS_ACT + 64 * MiB;
constexpr size_t WS_HUT = WS_ACT;
constexpr size_t WS_HDEC = WS_ACT + 64 * MiB;
constexpr size_t WS_KW = WS_MBITS + 2 * MiB;
constexpr int DSA_MAIN = 4096, KW_LD = 96;
constexpr size_t WS_X16 = WS_ACT + 88 * MiB;
constexpr size_t WS_FAST_END = WS_X16 + 32 * MiB;
static_assert(WS_WIN0 + (size_t)SWA_IN * D * 2 == WS_WIN1 && WS_WIN1 + (size_t)DIFF_IN * D * 2 == WS_WIN2 && WS_WIN2 + (size_t)HGRN_IN * D * 2 == WS_WIN3 && WS_WIN3 + (size_t)DSA_PAD * D * 2 == WS_WOUT, "weights map");
static_assert((size_t)NUP * D * 2 == WUP_STRIDE && (size_t)DFF * D * 2 == WDN_STRIDE && (size_t)M * NUP * 2 == 176 * MiB && (size_t)M * DFF * 2 == 88 * MiB, "map sizes");
constexpr size_t WS_RS = WS_CTL + 512 * 1024;
constexpr int CW_TMO = 0, CW_BAR = 4096, CW_CK = 16384;

#define LDS_BARRIER() do { asm volatile("s_waitcnt lgkmcnt(0)" ::: "memory"); __builtin_amdgcn_s_barrier(); asm volatile("" ::: "memory"); } while (0)
struct Params {
    const float* in[19];
    float* out;
    unsigned char* ws;
    int ph_lo, ph_hi;
};
struct Ctx {
    LAS unsigned char* lds;
    int tid, lane, wave, vcu, G;
};

template <int CTRL> __device__ __forceinline__ float dpp_f(float v) { return __builtin_bit_cast(float, __builtin_amdgcn_update_dpp(0, __builtin_bit_cast(int, v), CTRL, 0xf, 0xf, true)); }
template <int CTRL> __device__ __forceinline__ int dpp_i(int v) { return __builtin_amdgcn_update_dpp(0, v, CTRL, 0xf, 0xf, true); }
__device__ __forceinline__ float rsum16(float v) { v += dpp_f<0xB1>(v); v += dpp_f<0x4E>(v); v += dpp_f<0x141>(v); v += dpp_f<0x140>(v); return v; }
__device__ __forceinline__ int rsum16i(int v) { v += dpp_i<0xB1>(v); v += dpp_i<0x4E>(v); v += dpp_i<0x141>(v); v += dpp_i<0x140>(v); return v; }
__device__ __forceinline__ float wsum64(float v) {
    const int iv = __builtin_bit_cast(int, rsum16(v));
    return (__builtin_bit_cast(float, __builtin_amdgcn_readlane(iv, 0)) + __builtin_bit_cast(float, __builtin_amdgcn_readlane(iv, 16))) +
           (__builtin_bit_cast(float, __builtin_amdgcn_readlane(iv, 32)) + __builtin_bit_cast(float, __builtin_amdgcn_readlane(iv, 48)));
}
__device__ __forceinline__ int wsum64i(int v) { v = rsum16i(v); return (__builtin_amdgcn_readlane(v, 0) + __builtin_amdgcn_readlane(v, 16)) + (__builtin_amdgcn_readlane(v, 32) + __builtin_amdgcn_readlane(v, 48)); }
__device__ __forceinline__ float sum16(float v) { v += __shfl_xor(v, 1); v += __shfl_xor(v, 2); v += __shfl_xor(v, 4); v += __shfl_xor(v, 8); return v; }
__device__ __forceinline__ float max16(float v) { v = fmaxf(v, __shfl_xor(v, 1)); v = fmaxf(v, __shfl_xor(v, 2)); v = fmaxf(v, __shfl_xor(v, 4)); v = fmaxf(v, __shfl_xor(v, 8)); return v; }

template <bool MAPUP = false>
__device__ __forceinline__ void transpose_tile(const Ctx& c, const float* __restrict__ W, int K, int N, half_t* __restrict__ WT, int item, int ntn, const float* __restrict__ gk = nullptr) {
    const int kb = item / ntn, nb = item % ntn, k0 = 64 * kb, n0 = 256 * nb, lane = c.lane, w = c.wave;
    LAS half_t* T = (LAS half_t*)c.lds;
    const int n = n0 + 4 * lane;
    f32x4 v[8];
#pragma unroll
    for (int i = 0; i < 8; ++i) v[i] = (n < N) ? *(const f32x4*)(W + (size_t)(k0 + 8 * w + i) * N + n) : (f32x4){0.f, 0.f, 0.f, 0.f};
    if (gk) {
#pragma unroll
        for (int i = 0; i < 8; ++i) v[i] *= gk[k0 + 8 * w + i];
    }
#pragma unroll
    for (int e = 0; e < 4; ++e) { u32x4 o; o.x = pkh(v[0][e], v[1][e]); o.y = pkh(v[2][e], v[3][e]); o.z = pkh(v[4][e], v[5][e]); o.w = pkh(v[6][e], v[7][e]);
        *(LAS u32x4*)(T + (4 * lane + e) * 72 + 8 * w) = o; }
    LDS_BARRIER();
#pragma unroll
    for (int i = 0; i < 4; ++i) { const int id = c.tid + NTH * i, row = id >> 3, ch = id & 7;
        const u32x4 o = *(const LAS u32x4*)(T + row * 72 + 8 * ch);
        int drow = n0 + row;
        if (MAPUP) { const int nn = drow < DFF ? drow : drow - DFF; drow = 256 * (nn >> 7) + (nn & 127) + (drow < DFF ? 0 : 128); }
        *(u32x4*)(WT + (size_t)drow * K + k0 + 8 * ch) = o; }
    LDS_BARRIER();
}
__device__ __forceinline__ void norm_row_first(const float* __restrict__ xrow, half_t* __restrict__ xout, float* __restrict__ rs, int lane) {
    f32x4 v[8]; float ss = 0.f;
#pragma unroll
    for (int j = 0; j < 8; ++j) { v[j] = *(const f32x4*)(xrow + 4 * lane + 256 * j); ss += (v[j].x * v[j].x + v[j].y * v[j].y) + (v[j].z * v[j].z + v[j].w * v[j].w); }
    const float r = rsqrtf(wsum64(ss) * (1.f / D) + RMS_EPS);
    if (lane == 0) *rs = r;
#pragma unroll
    for (int j = 0; j < 8; ++j) { u32x2 xo; xo.x = pkh(v[j].x, v[j].y); xo.y = pkh(v[j].z, v[j].w); *(u32x2*)(xout + 4 * lane + 256 * j) = xo; }
}
constexpr int I_UP = 32 * (NUP / 256), I_DN = (DFF / 64) * (D / 256), FFN_TILES = I_UP + I_DN;
__device__ __forceinline__ void ffn_weight_tile(const Ctx& c, const Params& p, int l, int t) {
    unsigned char* ws = p.ws;
    if (t < I_UP) transpose_tile<true>(c, p.in[4] + (size_t)l * D * NUP, D, NUP, (half_t*)(ws + WS_WUP + l * WUP_STRIDE), t, NUP / 256, p.in[3] + (size_t)(4 * l + 2) * D);
    else transpose_tile(c, p.in[6] + (size_t)l * DFF * D, DFF, D, (half_t*)(ws + WS_WDN + l * WDN_STRIDE), t - I_UP, D / 256);
}
constexpr int DEFER_PER_WG = 10, DEFER_G1 = 128 * DEFER_PER_WG, DEFER_G3 = 84 * DEFER_PER_WG;
static_assert(DEFER_G1 + DEFER_G3 >= FFN_TILES, "layer 1's FFN weights fit the two spare slots");
__device__ __forceinline__ void spare_slot_convert(const Ctx& c, const Params& p, int l, int first, int last, int rank) {
    for (int i = 0; i < DEFER_PER_WG; ++i) { const int t = first + rank * DEFER_PER_WG + i; if (t < last) ffn_weight_tile(c, p, l, t); }
}
__device__ __forceinline__ void prologue_phase(const Ctx& c, const Params& p) {
    const int gw = c.vcu * NW + c.wave, NGW = c.G * NW;
    unsigned char* ws = p.ws;
    constexpr int I_W0 = 32 * (SWA_IN / 256), I_W1 = 32 * (DIFF_IN / 256), I_W2 = 32 * (HGRN_IN / 256), I_W3 = 32 * (DSA_PAD / 256), I_WO = 32 * (D / 256);
    constexpr int I_F23 = FFN_TILES - DEFER_G3;
    constexpr int NITEMS = I_W0 + I_W1 + I_W2 + I_W3 + 4 * I_WO + FFN_TILES + 2 * I_F23;
    const bool defer = (c.G == 256);
    const int nitems = defer ? NITEMS : NITEMS + FFN_TILES + 2 * DEFER_G3;
    for (int it = c.vcu; it < nitems; it += c.G) {
        int r = it;
        if (r < I_W0) { transpose_tile(c, p.in[7], D, SWA_IN, (half_t*)(ws + WS_WIN0), r, SWA_IN / 256, p.in[3]); continue; } r -= I_W0;
        if (r < I_W1) { transpose_tile(c, p.in[10], D, DIFF_IN, (half_t*)(ws + WS_WIN1), r, DIFF_IN / 256, p.in[3] + 4 * D); continue; } r -= I_W1;
        if (r < I_W2) { transpose_tile(c, p.in[14], D, HGRN_IN, (half_t*)(ws + WS_WIN2), r, HGRN_IN / 256, p.in[3] + 8 * D); continue; } r -= I_W2;
        if (r < I_W3) { transpose_tile(c, p.in[17], D, DSA_IN, (half_t*)(ws + WS_WIN3), r, DSA_PAD / 256, p.in[3] + 12 * D); continue; } r -= I_W3;
        if (r < 4 * I_WO) { const int l = r / I_WO; r -= l * I_WO; const float* src = l == 0 ? p.in[8] : l == 1 ? p.in[11] : l == 2 ? p.in[15] : p.in[18];
            transpose_tile(c, src, D, D, (half_t*)(ws + WS_WOUT + l * WOUT_STRIDE), r, D / 256); continue; } r -= 4 * I_WO;
        if (r < FFN_TILES) { ffn_weight_tile(c, p, 0, r); continue; } r -= FFN_TILES;
        if (r < I_F23) { ffn_weight_tile(c, p, 2, DEFER_G3 + r); continue; } r -= I_F23;
        if (r < I_F23) { ffn_weight_tile(c, p, 3, DEFER_G3 + r); continue; } r -= I_F23;
        if (r < FFN_TILES) { ffn_weight_tile(c, p, 1, r); continue; } r -= FFN_TILES;
        if (r < DEFER_G3) { ffn_weight_tile(c, p, 2, r); continue; } r -= DEFER_G3;
        ffn_weight_tile(c, p, 3, r);
    }
    const float* x = p.in[0];
    for (int m = gw; m < M; m += NGW) norm_row_first(x + (size_t)m * D, (half_t*)(ws + WS_X16) + (size_t)m * D, (float*)(ws + WS_RS) + m, c.lane);
}

__device__ __forceinline__ void resnorm_phase(const Ctx& c, half_t* __restrict__ X, const half_t* __restrict__ MF, const float* __restrict__ g1, float* __restrict__ RS, float* __restrict__ out32) {
    const int gw = c.vcu * NW + c.wave, NGW = c.G * NW, lane = c.lane;
    for (int m = gw; m < M; m += NGW) {
        const half_t* mf = MF + (size_t)m * D; half_t* xr = X + (size_t)m * D;
        f32x4 v[8]; h16x4 xh[8]; float ss = 0.f;
#pragma unroll
        for (int j = 0; j < 8; ++j) { const h16x4 hv = *(const h16x4*)(mf + 4 * lane + 256 * j); xh[j] = *(const h16x4*)(xr + 4 * lane + 256 * j); v[j] = (f32x4){(float)hv[0], (float)hv[1], (float)hv[2], (float)hv[3]};
            ss += (v[j].x * v[j].x + v[j].y * v[j].y) + (v[j].z * v[j].z + v[j].w * v[j].w); }
        const float r1 = rsqrtf(wsum64(ss) * (1.f / D) + RMS_EPS);
        float s2 = 0.f;
#pragma unroll
        for (int j = 0; j < 8; ++j) { const f32x4 gg = *(const f32x4*)(g1 + 4 * lane + 256 * j); const f32x4 xx = (f32x4){(float)xh[j][0], (float)xh[j][1], (float)xh[j][2], (float)xh[j][3]};
            v[j] = xx + v[j] * r1 * gg; s2 += (v[j].x * v[j].x + v[j].y * v[j].y) + (v[j].z * v[j].z + v[j].w * v[j].w);
            if (out32) *(f32x4*)(out32 + (size_t)m * D + 4 * lane + 256 * j) = v[j];
            else { u32x2 xo; xo.x = pkh(v[j].x, v[j].y); xo.y = pkh(v[j].z, v[j].w); *(u32x2*)(xr + 4 * lane + 256 * j) = xo; } }
        if (RS) { const float r2 = rsqrtf(wsum64(s2) * (1.f / D) + RMS_EPS); if (lane == 0) RS[m] = r2; }
    }
}
__device__ __forceinline__ void convact_phase(const Ctx& c, const half_t* __restrict__ U, const float* __restrict__ cw, half_t* __restrict__ ACT) {
    const int gw = c.vcu * NW + c.wave, NGW = c.G * NW, lane = c.lane;
    constexpr int NCC = DFF / 512, NRB = M / 16;
    for (int it = gw; it < NCC * NRB; it += NGW) {
        const int cc = it % NCC, rb = it / NCC, c0 = cc * 512 + lane * 8, r0 = rb * 16, t0 = r0 % S;
        float wg[3][8], wv[3][8];
#pragma unroll
        for (int j = 0; j < 3; ++j) {
            const f32x4 a0 = *(const f32x4*)(cw + j * NUP + c0), a1 = *(const f32x4*)(cw + j * NUP + c0 + 4);
            const f32x4 b0 = *(const f32x4*)(cw + j * NUP + DFF + c0), b1 = *(const f32x4*)(cw + j * NUP + DFF + c0 + 4);
#pragma unroll
            for (int e = 0; e < 4; ++e) { wg[j][e] = a0[e]; wg[j][4 + e] = a1[e]; wv[j][e] = b0[e]; wv[j][4 + e] = b1[e]; }
        }
        float g2[8], g1[8], v2[8], v1[8];
        if (t0 == 0) {
#pragma unroll
            for (int e = 0; e < 8; ++e) { g2[e] = 0.f; g1[e] = 0.f; v2[e] = 0.f; v1[e] = 0.f; }
        } else {
            const h16x8 a = *(const h16x8*)(U + (size_t)(r0 - 2) * NUP + c0), b = *(const h16x8*)(U + (size_t)(r0 - 1) * NUP + c0);
            const h16x8 cgv = *(const h16x8*)(U + (size_t)(r0 - 2) * NUP + DFF + c0), d = *(const h16x8*)(U + (size_t)(r0 - 1) * NUP + DFF + c0);
#pragma unroll
            for (int e = 0; e < 8; ++e) { g2[e] = (float)a[e]; g1[e] = (float)b[e]; v2[e] = (float)cgv[e]; v1[e] = (float)d[e]; }
        }
        for (int r = r0; r < r0 + 16; ++r) {
            const h16x8 gc = *(const h16x8*)(U + (size_t)r * NUP + c0), vc = *(const h16x8*)(U + (size_t)r * NUP + DFF + c0);
            float o[8];
#pragma unroll
            for (int e = 0; e < 8; ++e) {
                const float gcur = (float)gc[e], vcur = (float)vc[e];
                const float gg = wg[0][e] * g2[e] + wg[1][e] * g1[e] + wg[2][e] * gcur;
                const float vv = wv[0][e] * v2[e] + wv[1][e] * v1[e] + wv[2][e] * vcur;
                o[e] = gg * fsigm(gg) * vv;
                g2[e] = g1[e]; g1[e] = gcur; v2[e] = v1[e]; v1[e] = vcur;
            }
            u32x4 w; w.x = pkh(o[0], o[1]); w.y = pkh(o[2], o[3]); w.z = pkh(o[4], o[5]); w.w = pkh(o[6], o[7]);
            *(u32x4*)(ACT + (size_t)r * DFF + c0) = w;
        }
    }
}
__device__ __forceinline__ void hgrn_normgate_phase(const Ctx& c, const float* __restrict__ OR, const half_t* __restrict__ Z, const float* __restrict__ ng, half_t* __restrict__ O) {
    const int gw = c.vcu * NW + c.wave, NGW = c.G * NW, lane = c.lane;
    const f32x4 gn = *(const f32x4*)(ng + ((4 * lane) & 127));
    for (int m = gw; m < M; m += NGW) {
        const float* orow = OR + (size_t)m * D; const half_t* grow = Z + (size_t)m * HGRN_IN + 6144; half_t* out = O + (size_t)m * D;
        f32x4 v[8]; h16x4 gt[8];
#pragma unroll
        for (int j = 0; j < 8; ++j) { v[j] = *(const f32x4*)(orow + 4 * lane + 256 * j); gt[j] = *(const h16x4*)(grow + 4 * lane + 256 * j); }
#pragma unroll
        for (int j = 0; j < 8; ++j) {
            const int col = 4 * lane + 256 * j;
            float ss = (v[j].x * v[j].x + v[j].y * v[j].y) + (v[j].z * v[j].z + v[j].w * v[j].w);
            ss = rsum16(ss); ss += __shfl_xor(ss, 16);
            const float r = rsqrtf(ss * (1.f / 128.f) + RMS_EPS);
            float o[4];
#pragma unroll
            for (int e = 0; e < 4; ++e) { const float gv = (float)gt[j][e]; o[e] = v[j][e] * r * gn[e] * (gv * fsigm(gv)); }
            u32x2 w; w.x = pkh(o[0], o[1]); w.y = pkh(o[2], o[3]);
            *(u32x2*)(out + col) = w;
        }
    }
}

typedef float f32x16 __attribute__((ext_vector_type(16)));
#define MFMA32(a, b, c) __builtin_amdgcn_mfma_f32_32x32x16_f16((a), (b), (c), 0, 0, 0)
constexpr float LOG2E = 1.4426950408889634f, C2 = 0.125f * LOG2E, ATT_THR = 8.0f, NEGBIG = -1e30f;
__device__ __forceinline__ int crow(int r, int hi) { return (r & 3) + 8 * (r >> 2) + 4 * hi; }
__device__ __forceinline__ float xhalf_max(float m) { auto rr = __builtin_amdgcn_permlane32_swap(__float_as_uint(m), __float_as_uint(m), false, false); return fmaxf(__uint_as_float(rr[0]), __uint_as_float(rr[1])); }
__device__ __forceinline__ float xhalf_sum(float m) { auto rr = __builtin_amdgcn_permlane32_swap(__float_as_uint(m), __float_as_uint(m), false, false); return __uint_as_float(rr[0]) + __uint_as_float(rr[1]); }

typedef short v4i16_t __attribute__((ext_vector_type(4)));
template <int NDB, bool NEAR, int AM, bool SWZ = false>
__device__ __forceinline__ void attn_tile(const LAS half_t* Kt, const LAS half_t* Vr, const h16x8 (&qf)[4], float& mhat, float& lsum, f32x16 (&o)[NDB],
                                          LAS float* wsf, const LAS float* bd2, int qrel, unsigned mw0, unsigned mw1, int r32, int hi, bool start) {
    f32x16 pp[2];
    constexpr bool UPFRONT = (NDB == 2);
    if (UPFRONT) {
        const int KRS = SWZ ? 64 : 72, sw = SWZ ? ((r32 >> 1) & 7) : 0;
        const LAS half_t* kp = Kt + r32 * KRS;
        const f32x16 z = {0.f, 0.f, 0.f, 0.f, 0.f, 0.f, 0.f, 0.f, 0.f, 0.f, 0.f, 0.f, 0.f, 0.f, 0.f, 0.f};
        pp[0] = MFMA32(*(const LAS h16x8*)(kp + ((hi ^ sw) * 8)), qf[0], z); pp[1] = MFMA32(*(const LAS h16x8*)(kp + 32 * KRS + ((hi ^ sw) * 8)), qf[0], z);
#pragma unroll
        for (int ks = 1; ks < 4; ++ks) { pp[0] = MFMA32(*(const LAS h16x8*)(kp + (((2 * ks + hi) ^ sw) * 8)), qf[ks], pp[0]); pp[1] = MFMA32(*(const LAS h16x8*)(kp + 32 * KRS + (((2 * ks + hi) ^ sw) * 8)), qf[ks], pp[1]); }
#if defined(PROBE_MASK) && ((PROBE_MASK >> 13) & 1)
        { f32x16 t0 = z, t1 = z;
#pragma unroll
          for (int ks = 0; ks < 4; ++ks) { t0 = MFMA32(*(const LAS h16x8*)(kp + 16 * ks), qf[ks], t0); t1 = MFMA32(*(const LAS h16x8*)(kp + 32 * 72 + 16 * ks), qf[ks], t1); }
#pragma unroll
          for (int r = 0; r < 16; ++r) { pp[0][r] = 0.5f * (pp[0][r] + t0[r]); pp[1][r] = 0.5f * (pp[1][r] + t1[r]); } }
#endif
    }
#pragma unroll
    for (int blk = 0; blk < 2; ++blk) {
        f32x16 p;
        if (UPFRONT) p = pp[blk];
        else if (!SWZ) {
            const LAS half_t* kp = Kt + (32 * blk + r32) * 72 + 8 * hi;
            const f32x16 z = {0.f, 0.f, 0.f, 0.f, 0.f, 0.f, 0.f, 0.f, 0.f, 0.f, 0.f, 0.f, 0.f, 0.f, 0.f, 0.f};
            p = MFMA32(*(const LAS h16x8*)(kp), qf[0], z);
#pragma unroll
            for (int ks = 1; ks < 4; ++ks) p = MFMA32(*(const LAS h16x8*)(kp + 16 * ks), qf[ks], p);
        } else {
            const LAS half_t* kp = Kt + (32 * blk + r32) * 64; const int sw = (r32 >> 1) & 7;
            const f32x16 z = {0.f, 0.f, 0.f, 0.f, 0.f, 0.f, 0.f, 0.f, 0.f, 0.f, 0.f, 0.f, 0.f, 0.f, 0.f, 0.f};
            p = MFMA32(*(const LAS h16x8*)(kp + ((hi ^ sw) * 8)), qf[0], z);
#pragma unroll
            for (int ks = 1; ks < 4; ++ks) p = MFMA32(*(const LAS h16x8*)(kp + (((2 * ks + hi) ^ sw) * 8)), qf[ks], p);
        }
#pragma unroll
        for (int r = 0; r < 16; ++r) p[r] = fmaf(p[r], C2, -mhat);
        if (NEAR) {
#pragma unroll
            for (int r = 0; r < 16; ++r) {
                const int d0 = qrel - 32 * blk - ((r & 3) + 8 * (r >> 2));
                const int i0 = d0 < 0 ? 0 : (d0 > 128 ? 128 : d0);
                const bool ok0 = (AM == 0) ? (d0 >= 0 && d0 < 128) : (d0 >= 0);
                p[r] = ok0 ? p[r] + bd2[i0] : NEGBIG;
                if (NDB > 2 && (r & 7) == 7) asm volatile("" ::: "memory");
            }
        }
        if (AM == 1) {
            const unsigned ws = (blk == 0 ? mw0 : mw1) >> (4 * hi);
#pragma unroll
            for (int r = 0; r < 16; ++r) { const unsigned bit = 1u << ((r & 3) + 8 * (r >> 2)); p[r] = (ws & bit) ? p[r] : NEGBIG; }
        }
        float rm;
        { const float a0 = fmaxf(fmaxf(p[0], p[1]), fmaxf(p[2], p[3])), a1 = fmaxf(fmaxf(p[4], p[5]), fmaxf(p[6], p[7])), a2 = fmaxf(fmaxf(p[8], p[9]), fmaxf(p[10], p[11])), a3 = fmaxf(fmaxf(p[12], p[13]), fmaxf(p[14], p[15]));
          rm = fmaxf(fmaxf(a0, a1), fmaxf(a2, a3)); }
        rm = xhalf_max(rm);
        if (start && blk == 0) {
            const float dl = (rm > -1e29f) ? rm : 0.f; mhat += dl;
#pragma unroll
            for (int r = 0; r < 16; ++r) p[r] -= dl;
        } else if (__any(rm > ATT_THR)) {
            const float dl = (rm > ATT_THR) ? rm : 0.f; mhat += dl;
#pragma unroll
            for (int r = 0; r < 16; ++r) p[r] -= dl;
            const float f = fexp2(-dl); lsum *= f;
            if (hi == 0) wsf[r32] = f;
#pragma unroll
            for (int r = 0; r < 16; ++r) { const float fr_ = wsf[crow(r, hi)];
#pragma unroll
                for (int d = 0; d < NDB; ++d) o[d][r] *= fr_;
                if (NDB > 2 && (r & 3) == 3) asm volatile("" ::: "memory"); }
        }
#if defined(PROBE_MASK) && ((PROBE_MASK >> 14) & 1)
#pragma unroll
        for (int r = 0; r < 16; ++r) { float t_ = fexp2(p[r] - 40.f); asm volatile("" : "+v"(t_)); p[r] += t_ * 1e-30f; }
#endif
#pragma unroll
        for (int r = 0; r < 16; ++r) p[r] = fexp2(p[r]);
        lsum += ((p[0] + p[1]) + (p[2] + p[3])) + ((p[4] + p[5]) + (p[6] + p[7])) + (((p[8] + p[9]) + (p[10] + p[11])) + ((p[12] + p[13]) + (p[14] + p[15])));
        u32x4 pw[2];
        pw[0] = (u32x4){pkh(p[0], p[1]), pkh(p[2], p[3]), pkh(p[4], p[5]), pkh(p[6], p[7])};
        pw[1] = (u32x4){pkh(p[8], p[9]), pkh(p[10], p[11]), pkh(p[12], p[13]), pkh(p[14], p[15])};
        constexpr int VSTR = SWZ ? 32 * NDB : 32 * NDB + 32;
        const int j4 = (r32 & 15) >> 2, vsw = (NDB == 4) ? j4 : (j4 >> 1);
        const LAS half_t* vb = SWZ ? Vr + (32 * blk + 4 * hi + j4) * VSTR + 4 * (r32 & 1)
                                   : Vr + (32 * blk + 4 * hi + j4) * VSTR + 16 * (r32 >> 4) + 4 * (r32 & 3);
#pragma unroll
        for (int d = 0; d < NDB; ++d) {
            const int vco = SWZ ? ((((d ^ vsw) << 2) | (2 * (r32 >> 4)) | ((r32 & 3) >> 1)) * 8) : 32 * d;
#pragma unroll
            for (int s2 = 0; s2 < 2; ++s2) {
                const v4i16_t lo = __builtin_amdgcn_ds_read_tr16_b64_v4i16((LAS v4i16_t*)(vb + (16 * s2) * VSTR + vco));
                const v4i16_t hi2 = __builtin_amdgcn_ds_read_tr16_b64_v4i16((LAS v4i16_t*)(vb + (16 * s2 + 8) * VSTR + vco));
                typedef short s16x8 __attribute__((ext_vector_type(8)));
                const s16x8 vv = (s16x8){lo[0], lo[1], lo[2], lo[3], hi2[0], hi2[1], hi2[2], hi2[3]};
                o[d] = MFMA32(__builtin_bit_cast(h16x8, pw[s2]), __builtin_bit_cast(h16x8, vv), o[d]);
            }
            if (NDB > 2 && (d & 1)) asm volatile("" ::: "memory");
        }
    }
}

template <int AM>
__device__ __forceinline__ void gqa_phase(const Ctx& c, const half_t* __restrict__ Z, int ldz, int koff, int voff, const float* __restrict__ bias, const float* __restrict__ sinks,
                                          const unsigned* __restrict__ mbits, half_t* __restrict__ O) {
    const int tid = c.tid, lane = c.lane, w = c.wave, r32 = lane & 31, hi = lane >> 5;
    constexpr int VS = 96;
    LAS half_t* Kb = (LAS half_t*)c.lds;
    LAS half_t* Vb = Kb + 2 * 64 * 72;
    constexpr int GQA_TILE_BYTES = (2 * 64 * 72 + 2 * 64 * VS) * 2;
    LAS float* wsf = (LAS float*)(c.lds + GQA_TILE_BYTES) + w * 64;
    LAS float* btab = (LAS float*)(c.lds + GQA_TILE_BYTES + 8 * 64 * 4);
    for (int i = tid; i < 32 * 129; i += NTH) { const int h = i / 129, d = i % 129; const int bk = d < 128 ? (int)BUCKET_LUT[d] : 31; btab[h * 132 + d] = (bias[bk * 32 + h] - bias[31 * 32 + h]) * LOG2E; }
    const int skey = tid >> 3, sch = tid & 7;
    for (int U = c.vcu; U < 1024; U += c.G) {
        const int grp = U & 255, ui = U >> 8, bkv = grp >> 3, sx = grp & 7;
        const int qb = (ui == 0) ? sx : (ui == 1) ? 15 - sx : (ui == 2) ? 16 + sx : 31 - sx;
        const int b = bkv >> 3, kvh = bkv & 7, h = kvh * 4 + (w >> 1);
        const int qw0 = qb * 64 + 32 * (w & 1), q = qw0 + r32;
        const size_t rowbase = (size_t)b * S;
        h16x8 qf[4];
#pragma unroll
        for (int ks = 0; ks < 4; ++ks) qf[ks] = *(const h16x8*)(Z + (rowbase + q) * ldz + h * 64 + 16 * ks + 8 * hi);
        float mhat = 0.f, lsum = 0.f;
        if (AM == 0) { mhat = (sinks[h] - bias[31 * 32 + h]) * LOG2E; lsum = (hi == 0) ? 1.f : 0.f; }
        f32x16 o[2];
#pragma unroll
        for (int d = 0; d < 2; ++d)
#pragma unroll
            for (int r = 0; r < 16; ++r) o[d][r] = 0.f;
        const int kt_lo = (AM == 0) ? (qb >= 2 ? qb - 2 : 0) : 0;
        const LAS float* bt = btab + h * 132;
        const half_t* sbase = Z + (rowbase + skey) * ldz + kvh * 64 + sch * 8;
        const unsigned* mrow = mbits + (rowbase + q) * 64;
        u32x4 kreg = *(const u32x4*)(sbase + (size_t)(64 * kt_lo) * ldz + koff);
        h16x8 vreg = *(const h16x8*)(sbase + (size_t)(64 * kt_lo) * ldz + voff);
        u32x2 mnext = (u32x2){0xffffffffu, 0xffffffffu};
        if (AM == 1) mnext = *(const u32x2*)(mrow + 2 * kt_lo);
        LDS_BARRIER();
        {
            *(LAS u32x4*)(Kb + skey * 72 + sch * 8) = kreg;
            *(LAS h16x8*)(Vb + skey * VS + sch * 8) = vreg;
        }
        if (kt_lo < qb) { kreg = *(const u32x4*)(sbase + (size_t)(64 * (kt_lo + 1)) * ldz + koff); vreg = *(const h16x8*)(sbase + (size_t)(64 * (kt_lo + 1)) * ldz + voff); }
        LDS_BARRIER();
        for (int kt = kt_lo; kt <= qb; ++kt) {
            const int cur = (kt - kt_lo) & 1;
            const u32x2 mcur = mnext;
            if (kt < qb) {
                LAS half_t* Kn = Kb + (cur ^ 1) * (64 * 72); LAS half_t* Vn = Vb + (cur ^ 1) * (64 * VS);
                *(LAS u32x4*)(Kn + skey * 72 + sch * 8) = kreg;
                *(LAS h16x8*)(Vn + skey * VS + sch * 8) = vreg;
                if (AM == 1) mnext = *(const u32x2*)(mrow + 2 * (kt + 1));
                if (kt + 1 < qb) { kreg = *(const u32x4*)(sbase + (size_t)(64 * (kt + 2)) * ldz + koff); vreg = *(const h16x8*)(sbase + (size_t)(64 * (kt + 2)) * ldz + voff); }
            }
            const LAS half_t* Kt = Kb + cur * (64 * 72); const LAS half_t* Vt = Vb + cur * (64 * VS);
            const int qrel = q - 64 * kt - 4 * hi;
            const bool start = (AM == 1) && (kt == kt_lo);
            const bool near = (AM == 0) || (64 * kt + 191 > qw0);
            if (near) attn_tile<2, true, AM>(Kt, Vt, qf, mhat, lsum, o, wsf, bt, qrel, mcur.x, mcur.y, r32, hi, start);
            else attn_tile<2, false, AM>(Kt, Vt, qf, mhat, lsum, o, wsf, bt, qrel, mcur.x, mcur.y, r32, hi, start);
            LDS_BARRIER();
#if defined(PROBE_MASK) && ((PROBE_MASK >> 12) & 1)
            LDS_BARRIER(); LDS_BARRIER();
#endif
        }
        {
            const float lt = xhalf_sum(lsum);
            if (hi == 0) wsf[r32] = 1.f / lt;
            float inv[16];
#pragma unroll
            for (int r = 0; r < 16; ++r) inv[r] = wsf[crow(r, hi)];
#pragma unroll
            for (int r = 0; r < 16; ++r) {
                half_t* op = O + (rowbase + qw0 + crow(r, hi)) * D + h * 64 + r32;
                op[0] = (half_t)(o[0][r] * inv[r]); op[32] = (half_t)(o[1][r] * inv[r]);
            }
        }
    }
    LDS_BARRIER();
}

__device__ __forceinline__ void diff_phase(const Ctx& c, const half_t* __restrict__ Z, const float* __restrict__ bias, const float* __restrict__ lambdas, const float* __restrict__ subg,
                                           float lam_init, half_t* __restrict__ O) {
    const int tid = c.tid, lane = c.lane, w = c.wave, r32 = lane & 31, hi = lane >> 5;
    constexpr int ldz = DIFF_IN;
    constexpr int KIMG = 64 * 64, VIMG = 64 * 128, BUF_H = 2 * KIMG + VIMG;
    LAS half_t* ring = (LAS half_t*)c.lds;
    constexpr int TILE_BYTES = 3 * BUF_H * 2;
    LAS float* cb = (LAS float*)c.lds;
    static_assert(128 * 132 * 4 <= TILE_BYTES, "combine buffer");
    LAS float* wsf = (LAS float*)(c.lds + TILE_BYTES) + w * 64;
    LAS float* btab = (LAS float*)(c.lds + TILE_BYTES + 8 * 64 * 4);
    static_assert(TILE_BYTES + 8 * 64 * 4 + 32 * 132 * 4 <= RING_BYTES, "diff LDS");
    for (int i = tid; i < 32 * 129; i += NTH) { const int h = i / 129, d = i % 129; const int bk = d < 128 ? (int)BUCKET_LUT[d] : 31; btab[h * 132 + d] = (bias[bk * 32 + h] - bias[31 * 32 + h]) * LOG2E; }
    float lam;
    { float l1 = lambdas[lane] * lambdas[64 + lane], l2 = lambdas[128 + lane] * lambdas[192 + lane]; l1 = wsum64(l1); l2 = wsum64(l2); lam = expf(l1) - expf(l2) + lam_init; }
    const int mp = w & 1, rg = w >> 1;
    const int kkey = 8 * w + (lane >> 3), kch = (lane & 7) ^ ((kkey >> 1) & 7);
    const int vkey0 = 8 * w + (lane >> 4), vkey1 = vkey0 + 4, vch0 = (lane & 15) ^ (4 * (vkey0 & 3)), vch1 = (lane & 15) ^ (4 * (vkey1 & 3));
    for (int U = c.vcu; U < 1024; U += c.G) {
        const int grp = U & 255, ui = U >> 8, bh = grp >> 2, sx = grp & 3;
        const int qb = (ui == 0) ? sx : (ui == 1) ? 7 - sx : (ui == 2) ? 8 + sx : 15 - sx;
        const int b = bh >> 4, hd = bh & 15;
        const int qw0 = qb * 128 + 32 * rg, q = qw0 + r32;
        const size_t rowbase = (size_t)b * S;
        h16x8 qf[4];
#pragma unroll
        for (int ks = 0; ks < 4; ++ks) qf[ks] = *(const h16x8*)(Z + (rowbase + q) * ldz + hd * 128 + mp * 64 + 16 * ks + 8 * hi);
        float mhat = 0.f, lsum = 0.f;
        f32x16 o[4];
#pragma unroll
        for (int d = 0; d < 4; ++d)
#pragma unroll
            for (int r = 0; r < 16; ++r) o[d][r] = 0.f;
        const LAS float* bt = btab + (hd * 2 + mp) * 132;
        const int kt_hi = 2 * qb + 1;
        const half_t* gk = Z + (rowbase + kkey) * ldz + 2048 + hd * 128 + kch * 8;
        const half_t* gv0 = Z + (rowbase + vkey0) * ldz + 4096 + hd * 128 + vch0 * 8;
        const half_t* gv1 = Z + (rowbase + vkey1) * ldz + 4096 + hd * 128 + vch1 * 8;
#define DIFF_DMA(t, si) do { const size_t adv = (size_t)(64 * (t)) * ldz; LAS half_t* slot = ring + (si) * BUF_H; \
            __builtin_amdgcn_global_load_lds((const unsigned*)(gk + adv), (LAS unsigned*)(slot + w * 512), 16, 0, 0); \
            __builtin_amdgcn_global_load_lds((const unsigned*)(gk + adv + 64), (LAS unsigned*)(slot + KIMG + w * 512), 16, 0, 0); \
            __builtin_amdgcn_global_load_lds((const unsigned*)(gv0 + adv), (LAS unsigned*)(slot + 2 * KIMG + w * 1024), 16, 0, 0); \
            __builtin_amdgcn_global_load_lds((const unsigned*)(gv1 + adv), (LAS unsigned*)(slot + 2 * KIMG + w * 1024 + 512), 16, 0, 0); } while (0)
        LDS_BARRIER();
        DIFF_DMA(0, 0);
        DIFF_DMA(1, 1);
        asm volatile("s_waitcnt vmcnt(4)" ::: "memory");
        LDS_BARRIER();
        int s_cur = 0, s_nn = 2;
#pragma unroll 1
        for (int kt = 0; kt <= kt_hi; ++kt) {
            if (kt + 2 <= kt_hi) DIFF_DMA(kt + 2, s_nn);
            if (64 * kt <= qw0 + 31) {
                const LAS half_t* slot = ring + s_cur * BUF_H;
                const LAS half_t* Kt = slot + mp * KIMG; const LAS half_t* Vt = slot + 2 * KIMG;
                const int qrel = q - 64 * kt - 4 * hi;
                if (64 * kt + 191 > qw0) attn_tile<4, true, 2, true>(Kt, Vt, qf, mhat, lsum, o, wsf, bt, qrel, 0u, 0u, r32, hi, kt == 0);
                else attn_tile<4, false, 2, true>(Kt, Vt, qf, mhat, lsum, o, wsf, bt, qrel, 0u, 0u, r32, hi, kt == 0);
            }
            if (kt + 2 <= kt_hi) asm volatile("s_waitcnt vmcnt(4)" ::: "memory"); else asm volatile("s_waitcnt vmcnt(0)" ::: "memory");
            LDS_BARRIER();
            s_cur = (s_cur == 2) ? 0 : s_cur + 1; s_nn = (s_nn == 2) ? 0 : s_nn + 1;
        }
#undef DIFF_DMA
        {
            const float lt = xhalf_sum(lsum);
            if (hi == 0) wsf[r32] = 1.f / lt;
            float inv[16];
#pragma unroll
            for (int r = 0; r < 16; ++r) inv[r] = wsf[crow(r, hi)];
            if (mp == 1) {
#pragma unroll
                for (int d = 0; d < 4; ++d)
#pragma unroll
                    for (int r = 0; r < 16; ++r) cb[(32 * rg + crow(r, hi)) * 132 + 32 * d + r32] = o[d][r] * inv[r];
            }
            LDS_BARRIER();
            if (mp == 0) {
#pragma unroll
                for (int d = 0; d < 4; ++d)
#pragma unroll
                    for (int r = 0; r < 16; ++r) { LAS float* pc = cb + (32 * rg + crow(r, hi)) * 132 + 32 * d + r32; *pc = o[d][r] * inv[r] - lam * (*pc); }
            }
            LDS_BARRIER();
            const int qq = tid >> 2, q4 = tid & 3;
            f32x4 v[8]; float ss = 0.f;
#pragma unroll
            for (int i = 0; i < 8; ++i) { v[i] = *(const LAS f32x4*)(cb + qq * 132 + 32 * q4 + 4 * i); ss += (v[i].x * v[i].x + v[i].y * v[i].y) + (v[i].z * v[i].z + v[i].w * v[i].w); }
            ss += dpp_f<0xB1>(ss); ss += dpp_f<0x4E>(ss);
            const float rn = rsqrtf(ss * (1.f / 128.f) + RMS_EPS) * (1.f - lam_init);
            half_t* op = O + (rowbase + qb * 128 + qq) * D + hd * 128 + 32 * q4;
#pragma unroll
            for (int i = 0; i < 4; ++i) {
                const f32x4 g0 = *(const f32x4*)(subg + 32 * q4 + 8 * i), g1 = *(const f32x4*)(subg + 32 * q4 + 8 * i + 4);
                const f32x4 a = v[2 * i] * rn * g0, bq = v[2 * i + 1] * rn * g1;
                u32x4 wv; wv.x = pkh(a.x, a.y); wv.y = pkh(a.z, a.w); wv.z = pkh(bq.x, bq.y); wv.w = pkh(bq.z, bq.w);
                *(u32x4*)(op + 8 * i) = wv;
            }
        }
    }
    LDS_BARRIER();
}

__device__ __forceinline__ void dsa_kiwi_phase(const Ctx& c, const half_t* __restrict__ H, const float* __restrict__ RS, const half_t* __restrict__ W3, half_t* __restrict__ KW) {
    const int tid = c.tid, lane = c.lane, w = c.wave, fr = lane & 15, fq = lane >> 4;
    LAS float* red = (LAS float*)c.lds;
    for (int it = c.vcu; it < M / 32; it += c.G) {
        const int row0 = 32 * it;
        f32x4 acc[2][5];
#pragma unroll
        for (int mt = 0; mt < 2; ++mt)
#pragma unroll
            for (int nt = 0; nt < 5; ++nt) acc[mt][nt] = (f32x4){0.f, 0.f, 0.f, 0.f};
#pragma unroll 2
        for (int ks = 8 * w; ks < 8 * w + 8; ++ks) {
            h16x8 a[2];
#pragma unroll
            for (int mt = 0; mt < 2; ++mt) a[mt] = *(const h16x8*)(H + (size_t)(row0 + 16 * mt + fr) * D + 32 * ks + 8 * fq);
#pragma unroll
            for (int nt = 0; nt < 5; ++nt) { const h16x8 bw = *(const h16x8*)(W3 + (size_t)(DSA_MAIN + 16 * nt + fr) * D + 32 * ks + 8 * fq);
#pragma unroll
                for (int mt = 0; mt < 2; ++mt) acc[mt][nt] = MFMA16(a[mt], bw, acc[mt][nt]); }
        }
        LDS_BARRIER();
#pragma unroll
        for (int mt = 0; mt < 2; ++mt)
#pragma unroll
            for (int nt = 0; nt < 5; ++nt) *(LAS f32x4*)(red + ((w * 10 + mt * 5 + nt) * 64 + lane) * 4) = acc[mt][nt];
        LDS_BARRIER();
#pragma unroll
        for (int j = 0; j < 5; ++j) {
            const int idx = tid + NTH * j, t = idx >> 8, e = idx & 255;
            float s = 0.f;
#pragma unroll
            for (int w2 = 0; w2 < 8; ++w2) s += red[(w2 * 10 + t) * 256 + e];
            const int mt = t / 5, nt = t % 5, l2 = e >> 2, r = e & 3;
            const int row = row0 + 16 * mt + 4 * (l2 >> 4) + r;
            KW[(size_t)row * KW_LD + 16 * nt + (l2 & 15)] = (half_t)(s * RS[row]);
        }
    }
    LDS_BARRIER();
}

__device__ __forceinline__ void dsa_score_phase(const Ctx& c, const half_t* __restrict__ Z, const half_t* __restrict__ KW, float* __restrict__ SC) {
    const int lane = c.lane, w = c.wave, fr = lane & 15, fq = lane >> 4;
    constexpr int ldz = DSA_MAIN;
    for (int U = c.vcu; U < 512; U += c.G) {
        const int grp = U & 255, ui = U >> 8, b = grp >> 6, sx = grp & 63;
        const int qblk = (ui == 0) ? sx : 127 - sx;
        const int q0 = 16 * qblk, ng = (qblk >> 3) + 1;
        const size_t rowbase = (size_t)b * S;
        const half_t* kp = KW + (rowbase + 16 * w + fr) * KW_LD + 8 * fq;
        h16x8 k0 = *(const h16x8*)kp, k1 = *(const h16x8*)(kp + 32);
        h16x8 qf[16][2];
        { const half_t* qp = Z + (rowbase + q0 + fr) * ldz + 3072 + 8 * fq;
#pragma unroll
          for (int h = 0; h < 16; ++h)
#pragma unroll
              for (int ks = 0; ks < 2; ++ks) qf[h][ks] = *(const h16x8*)(qp + 64 * h + 32 * ks); }
        float wq[16];
        { const h16x8 w0 = *(const h16x8*)(KW + (rowbase + q0 + fr) * KW_LD + 64), w1 = *(const h16x8*)(KW + (rowbase + q0 + fr) * KW_LD + 72);
#pragma unroll
          for (int e = 0; e < 8; ++e) { wq[e] = (float)w0[e] * (1.f / 32.f); wq[8 + e] = (float)w1[e] * (1.f / 32.f); } }
        float* sp = SC + (rowbase + q0 + fr) * S + 16 * w + 4 * fq;
        __builtin_amdgcn_s_waitcnt(0x0F70);
#pragma unroll 1
        for (int g = 0; g < ng; ++g) {
            h16x8 n0 = k0, n1 = k1;
            if (g + 1 < ng) { n0 = *(const h16x8*)(kp + (size_t)(g + 1) * 128 * KW_LD); n1 = *(const h16x8*)(kp + (size_t)(g + 1) * 128 * KW_LD + 32); }
            f32x4 acc = (f32x4){0.f, 0.f, 0.f, 0.f};
#pragma unroll
            for (int h = 0; h < 16; ++h) {
                const f32x4 t = MFMA16(k1, qf[h][1], MFMA16(k0, qf[h][0], ((f32x4){0.f, 0.f, 0.f, 0.f})));
#pragma unroll
                for (int r = 0; r < 4; ++r) acc[r] += wq[h] * fmaxf(t[r], 0.f);
            }
            *(f32x4*)(sp + 128 * g) = acc;
            k0 = n0; k1 = n1;
        }
    }
}
__device__ __forceinline__ void dsa_select_phase(const Ctx& c, const float* __restrict__ SC, unsigned* __restrict__ mbits) {
    const int gw = c.vcu * NW + c.wave, NGW = c.G * NW, lane = c.lane;
    for (int R = gw; R < M; R += NGW) {
        const int q = R % S; const float* sp = SC + (size_t)R * S;
        unsigned key[32];
#pragma unroll
        for (int j = 0; j < 32; ++j) { const int s = lane + 64 * j; unsigned k = 0u;
            if (s <= q) { const unsigned u = __float_as_uint(sp[s]); k = (u & 0x80000000u) ? ~u : (u | 0x80000000u); }
            key[j] = k; }
        unsigned T = 0u;
        if (q + 1 > TOPK) {
            for (int bit = 31; bit >= 0; --bit) {
                const unsigned cand = T | (1u << bit); int cnt = 0;
#pragma unroll
                for (int j = 0; j < 32; ++j) cnt += (key[j] >= cand) ? 1 : 0;
                const int tot = wsum64i(cnt);
                if (tot >= TOPK) T = cand;
                if (tot == TOPK) break;
            }
        }
        unsigned* mp = mbits + (size_t)R * 64;
#pragma unroll
        for (int j = 0; j < 32; ++j) { const int s = lane + 64 * j; const unsigned long long bm = __ballot(key[j] >= T && s <= q);
            if (lane == 0) { mp[2 * j] = (unsigned)bm; mp[2 * j + 1] = (unsigned)(bm >> 32); } }
    }
}

__device__ __forceinline__ void hgrn_scan_phase(const Ctx& c, const half_t* __restrict__ Z, const float* __restrict__ lb_logits, float* __restrict__ OR) {
    const int tid = c.tid, lane = c.lane, w = c.wave, fr = lane & 15, fq = lane >> 4;
    constexpr int ldz = HGRN_IN;
    LAS float* QD = (LAS float*)c.lds;
    LAS half_t* QS = (LAS half_t*)(c.lds + 33792);
    LAS half_t* KS = QS + 64 * 136;
    LAS half_t* Vt = KS + 64 * 136;
    LAS half_t* At = Vt + 32 * 72;
    LAS half_t* St = At + 64 * 72;
    LAS float* Tot = (LAS float*)(St + 32 * 136);
    LAS float* TE = Tot + 4 * 128;
    LAS float* TF = TE + 4 * 128;
    LAS float* TD = TF + 4 * 128;
    LAS float* TDEC = TD + 3 * 128;
    const int k = tid & 127, tq = tid >> 7;
    for (int U = c.vcu; U < 256; U += c.G) {
        const int b = U >> 6, hd = (U >> 2) & 15, vs = U & 3;
        float lb;
        { const int ch = hd * 128 + k; const float a0 = lb_logits[ch], a1 = lb_logits[2048 + ch], a2 = lb_logits[4096 + ch], a3 = lb_logits[6144 + ch];
          const float mm = fmaxf(fmaxf(a0, a1), fmaxf(a2, a3)); const float e0 = expf(a0 - mm), e1 = expf(a1 - mm), e2 = expf(a2 - mm), e3 = expf(a3 - mm);
          lb = (e1 + e2) / (e0 + e1 + e2 + e3); }
        LDS_BARRIER();
        for (int i = tid; i < 64 * 72; i += NTH) At[i] = (half_t)0.f;
        for (int i = tid; i < 32 * 136; i += NTH) St[i] = (half_t)0.f;
        f32x4 sacc[2]; sacc[0] = (f32x4){0.f, 0.f, 0.f, 0.f}; sacc[1] = (f32x4){0.f, 0.f, 0.f, 0.f};
        u32x4 qv_[2], zv_[2]; h16x4 vraw;
        const half_t* zp0 = Z + ((size_t)b * S + (tid >> 4)) * ldz + hd * 128 + (tid & 15) * 8;
        const half_t* vp0 = Z + ((size_t)b * S + (tid >> 3)) * ldz + 4096 + hd * 128 + vs * 32 + (tid & 7) * 4;
#define HG_LOAD(ck_) do { const half_t* zp = zp0 + (size_t)(64 * (ck_)) * ldz; \
            qv_[0] = *(const u32x4*)(zp); zv_[0] = *(const u32x4*)(zp + 2048); qv_[1] = *(const u32x4*)(zp + (size_t)32 * ldz); zv_[1] = *(const u32x4*)(zp + (size_t)32 * ldz + 2048); \
            vraw = *(const h16x4*)(vp0 + (size_t)(64 * (ck_)) * ldz); } while (0)
#define HG_SB() do { asm volatile("" ::: "memory"); __builtin_amdgcn_sched_barrier(0); } while (0)
        HG_LOAD(0);
        for (int ck = 0; ck < S / 64; ++ck) {
            const size_t row0 = (size_t)b * S + 64 * ck;
            LDS_BARRIER();
            {
                const int t = tid >> 4, k8 = (tid & 15) * 8;
                *(LAS u32x4*)(QS + t * 136 + k8) = qv_[0]; *(LAS u32x4*)(KS + t * 136 + k8) = zv_[0];
                *(LAS u32x4*)(QS + (t + 32) * 136 + k8) = qv_[1]; *(LAS u32x4*)(KS + (t + 32) * 136 + k8) = zv_[1];
                const int tv = tid >> 3, v4 = (tid & 7) * 4;
#pragma unroll
                for (int j = 0; j < 4; ++j) Vt[(v4 + j) * 72 + tv] = vraw[j];
                if (ck + 1 < S / 64) HG_LOAD(ck + 1);
            }
            LDS_BARRIER();
            {
                float fv[16]; float prod = 1.f;
#pragma unroll
                for (int tt = 0; tt < 16; ++tt) { const float sg = fsigm((float)KS[(16 * tq + tt) * 136 + k]); fv[tt] = lb + (1.f - lb) * sg; prod *= fv[tt]; }
                prod = fmaxf(prod, 1e-30f);
                Tot[tq * 128 + k] = __logf(prod);
                LDS_BARRIER();
                const float t0 = Tot[k], t1 = Tot[128 + k], t2 = Tot[256 + k], t3 = Tot[384 + k];
                const float be1 = t0, be2 = t0 + t1, be3 = be2 + t2, be4 = be3 + t3;
                if (tq == 0) { TE[k] = 1.f; TE[128 + k] = fexp(be1); TE[256 + k] = fexp(be2); TE[384 + k] = fexp(be3); }
                else if (tq == 1) { TF[k] = fexp(be4 - be1); TF[128 + k] = fexp(be4 - be2); TF[256 + k] = fexp(be4 - be3); TF[384 + k] = 1.f; }
                else if (tq == 2) { TD[k] = fexp(be2 - be1); TD[128 + k] = fexp(be3 - be1); TD[256 + k] = fexp(be3 - be2); }
                else TDEC[k] = fexp(be4);
                const float ip16 = __builtin_amdgcn_rcpf(prod);
                float P = 1.f;
#pragma unroll
                for (int tt = 0; tt < 16; ++tt) {
                    const float qv = (float)QS[(16 * tq + tt) * 136 + k];
                    P = fmaxf(P * fv[tt], 1e-30f);
                    const float qp = qv * fsigm(qv), ky = 1.f - fv[tt];
                    const int t = 16 * tq + tt;
                    const float qsv = qp * P;
                    QS[t * 136 + k] = (half_t)qsv;
                    QD[t * 132 + k] = qsv * ip16;
                    KS[t * 136 + k] = (half_t)(ky * prod * __builtin_amdgcn_rcpf(P));
                    if ((tt & 3) == 3) HG_SB();
                }
            }
            LDS_BARRIER();
            if (w < 4) {
                const int I = w;
                f32x4 acc = (f32x4){0.f, 0.f, 0.f, 0.f}, acc2 = acc;
#pragma unroll 2
                for (int m = 0; m < 8; m += 2) {
                    const int k0 = 16 * m + 4 * fq;
                    const f32x4 qd = *(const LAS f32x4*)(QD + (16 * I + fr) * 132 + k0), qd2 = *(const LAS f32x4*)(QD + (16 * I + fr) * 132 + k0 + 16);
                    const h16x4 kv = *(const LAS h16x4*)(KS + (16 * I + fr) * 136 + k0), kv2 = *(const LAS h16x4*)(KS + (16 * I + fr) * 136 + k0 + 16);
#pragma unroll
                    for (int e = 0; e < 4; ++e) { acc = __builtin_amdgcn_mfma_f32_16x16x4f32(qd[e], (float)kv[e], acc, 0, 0, 0);
                                                  acc2 = __builtin_amdgcn_mfma_f32_16x16x4f32(qd2[e], (float)kv2[e], acc2, 0, 0, 0); }
                }
#pragma unroll
                for (int r = 0; r < 4; ++r) { const int tl = 4 * fq + r; At[(16 * I + tl) * 72 + 16 * I + fr] = (half_t)((fr <= tl) ? (acc[r] + acc2[r]) : 0.f); }
            } else {
                const int nb = (w < 6) ? 2 : 1;
                for (int bi = 0; bi < nb; ++bi) {
                    const int I = (w == 4) ? (bi == 0 ? 1 : 3) : (w == 5) ? (bi == 0 ? 2 : 3) : (w == 6) ? 3 : 2;
                    const int J = (w == 4) ? (bi == 0 ? 0 : 1) : (w == 5) ? (bi == 0 ? 1 : 0) : (w == 6) ? 2 : 0;
                    const int dsel = (I == 2) ? 0 : (J == 0 ? 1 : 2);
                    f32x4 acc = (f32x4){0.f, 0.f, 0.f, 0.f};
#pragma unroll
                    for (int ks = 0; ks < 4; ++ks) {
                        const int k0 = 32 * ks + 8 * fq;
                        h16x8 a = *(const LAS h16x8*)(QS + (16 * I + fr) * 136 + k0);
                        const h16x8 bb = *(const LAS h16x8*)(KS + (16 * J + fr) * 136 + k0);
                        if (I - J >= 2) {
                            const f32x4 d0 = *(const LAS f32x4*)(TD + dsel * 128 + k0), d1 = *(const LAS f32x4*)(TD + dsel * 128 + k0 + 4);
#pragma unroll
                            for (int j = 0; j < 4; ++j) { a[j] = (half_t)((float)a[j] * d0[j]); a[4 + j] = (half_t)((float)a[4 + j] * d1[j]); }
                        }
                        acc = MFMA16(a, bb, acc);
                    }
#pragma unroll
                    for (int r = 0; r < 4; ++r) At[(16 * I + 4 * fq + r) * 72 + 16 * J + fr] = (half_t)acc[r];
                }
            }
            const int mt = w - 4;
            f32x4 oacc[2]; oacc[0] = (f32x4){0.f, 0.f, 0.f, 0.f}; oacc[1] = oacc[0];
            if (w >= 4) {
#pragma unroll
                for (int ks = 0; ks < 4; ++ks) {
                    h16x8 a = *(const LAS h16x8*)(QS + (16 * mt + fr) * 136 + 32 * ks + 8 * fq);
                    if (mt > 0) {
                        const f32x4 e0 = *(const LAS f32x4*)(TE + mt * 128 + 32 * ks + 8 * fq), e1 = *(const LAS f32x4*)(TE + mt * 128 + 32 * ks + 8 * fq + 4);
#pragma unroll
                        for (int j = 0; j < 4; ++j) { a[j] = (half_t)((float)a[j] * e0[j]); a[4 + j] = (half_t)((float)a[4 + j] * e1[j]); }
                    }
#pragma unroll
                    for (int nt = 0; nt < 2; ++nt) { const h16x8 sb = *(const LAS h16x8*)(St + (16 * nt + fr) * 136 + 32 * ks + 8 * fq); oacc[nt] = MFMA16(a, sb, oacc[nt]); }
                }
            }
            LDS_BARRIER();
            if (w >= 4) {
#pragma unroll
                for (int ks = 0; ks < 2; ++ks) {
                    const h16x8 a = *(const LAS h16x8*)(At + (16 * mt + fr) * 72 + 32 * ks + 8 * fq);
#pragma unroll
                    for (int nt = 0; nt < 2; ++nt) { const h16x8 vb = *(const LAS h16x8*)(Vt + (16 * nt + fr) * 72 + 32 * ks + 8 * fq); oacc[nt] = MFMA16(a, vb, oacc[nt]); }
                }
#pragma unroll
                for (int nt = 0; nt < 2; ++nt)
#pragma unroll
                    for (int r = 0; r < 4; ++r) OR[(row0 + 16 * mt + 4 * fq + r) * D + hd * 128 + vs * 32 + 16 * nt + fr] = oacc[nt][r];
            }
            {
#pragma unroll
                for (int r = 0; r < 4; ++r) { const float dec = TDEC[16 * w + 4 * fq + r]; sacc[0][r] *= dec; sacc[1][r] *= dec; }
                const int kr = 16 * w + fr;
#pragma unroll
                for (int ks = 0; ks < 2; ++ks) {
                    const float fj = TF[(2 * ks + (fq >> 1)) * 128 + kr];
                    h16x8 a;
#pragma unroll
                    for (int j = 0; j < 8; ++j) { const int s2 = 32 * ks + 8 * fq + j; a[j] = (half_t)((float)KS[s2 * 136 + kr] * fj); }
#pragma unroll
                    for (int n2 = 0; n2 < 2; ++n2) { const h16x8 vb = *(const LAS h16x8*)(Vt + (16 * n2 + fr) * 72 + 32 * ks + 8 * fq); sacc[n2] = MFMA16(a, vb, sacc[n2]); }
                }
#pragma unroll
                for (int n2 = 0; n2 < 2; ++n2) { u32x2 pk; pk.x = pkh(sacc[n2][0], sacc[n2][1]); pk.y = pkh(sacc[n2][2], sacc[n2][3]);
                    *(LAS u32x2*)(St + (16 * n2 + fr) * 136 + 16 * w + 4 * fq) = pk; }
            }
        }
#undef HG_LOAD
#undef HG_SB
    }
    LDS_BARRIER();
}
__device__ __forceinline__ float hgrn_lb(const float* __restrict__ lb_logits, int ch) {
    const float a0 = lb_logits[ch], a1 = lb_logits[2048 + ch], a2 = lb_logits[4096 + ch], a3 = lb_logits[6144 + ch];
    const float mm = fmaxf(fmaxf(a0, a1), fmaxf(a2, a3)); const float e0 = expf(a0 - mm), e1 = expf(a1 - mm), e2 = expf(a2 - mm), e3 = expf(a3 - mm);
    return (e1 + e2) / (e0 + e1 + e2 + e3);
}
constexpr int HG_VS = 144;
__device__ __forceinline__ h16x8 hgrn_vfrag(const LAS half_t* Vr, int fr, int fq, int ks, int nt) {
    const LAS half_t* p = Vr + (32 * ks + 8 * fq + (fr >> 2)) * HG_VS + 16 * nt + 4 * (fr & 3);
    const v4i16_t lo = __builtin_amdgcn_ds_read_tr16_b64_v4i16((LAS v4i16_t*)p);
    const v4i16_t hi2 = __builtin_amdgcn_ds_read_tr16_b64_v4i16((LAS v4i16_t*)(p + 4 * HG_VS));
    typedef short s16x8 __attribute__((ext_vector_type(8)));
    const s16x8 vv = (s16x8){lo[0], lo[1], lo[2], lo[3], hi2[0], hi2[1], hi2[2], hi2[3]};
    return __builtin_bit_cast(h16x8, vv);
}

__device__ __forceinline__ void hgrn_local_phase(const Ctx& c, const half_t* __restrict__ Z, const float* __restrict__ lb_logits, half_t* __restrict__ UT, float* __restrict__ DEC) {
    const int tid = c.tid, lane = c.lane, w = c.wave, fr = lane & 15, fq = lane >> 4;
    constexpr int ldz = HGRN_IN;
    LAS half_t* KS = (LAS half_t*)c.lds;
    LAS half_t* Vr = KS + 64 * 136;
    LAS float* Tot = (LAS float*)(Vr + 64 * HG_VS);
    LAS float* TF = Tot + 4 * 128;
    const int k = tid & 127, tq = tid >> 7;
    const int st = tid >> 4, sk8 = (tid & 15) * 8;
    u32x4 zv_[2], vv_[2];
#define HA_LOAD(u_) do { const int b_ = (u_) >> 9, hd_ = ((u_) >> 5) & 15, ck_ = (u_) & 31; const half_t* zp = Z + ((size_t)b_ * S + 64 * ck_ + st) * ldz + hd_ * 128 + sk8; \
        zv_[0] = *(const u32x4*)(zp + 2048); zv_[1] = *(const u32x4*)(zp + (size_t)32 * ldz + 2048); vv_[0] = *(const u32x4*)(zp + 4096); vv_[1] = *(const u32x4*)(zp + (size_t)32 * ldz + 4096); } while (0)
    int U = c.vcu;
    if (U < 2048) HA_LOAD(U);
    for (; U < 2048; U += c.G) {
        const int hd = (U >> 5) & 15;
        const float lb = hgrn_lb(lb_logits, hd * 128 + k);
        LDS_BARRIER();
        *(LAS u32x4*)(KS + st * 136 + sk8) = zv_[0]; *(LAS u32x4*)(KS + (st + 32) * 136 + sk8) = zv_[1];
        *(LAS u32x4*)(Vr + st * HG_VS + sk8) = vv_[0]; *(LAS u32x4*)(Vr + (st + 32) * HG_VS + sk8) = vv_[1];
        if (U + c.G < 2048) HA_LOAD(U + c.G);
        LDS_BARRIER();
        float fv[16]; float prod = 1.f;
#pragma unroll
        for (int tt = 0; tt < 16; ++tt) { const float sg = fsigm((float)KS[(16 * tq + tt) * 136 + k]); fv[tt] = lb + (1.f - lb) * sg; prod *= fv[tt]; }
        prod = fmaxf(prod, 1e-30f);
        Tot[tq * 128 + k] = __logf(prod);
        LDS_BARRIER();
        {
            const float t0 = Tot[k], t1 = Tot[128 + k], t2 = Tot[256 + k], t3 = Tot[384 + k];
            const float be1 = t0, be2 = t0 + t1, be3 = be2 + t2, be4 = be3 + t3;
            if (tq == 1) { TF[k] = fexp(be4 - be1); TF[128 + k] = fexp(be4 - be2); TF[256 + k] = fexp(be4 - be3); TF[384 + k] = 1.f; }
            if (tq == 3) DEC[(size_t)U * 128 + k] = fexp(be4);
            float P = 1.f;
#pragma unroll
            for (int tt = 0; tt < 16; ++tt) { P = fmaxf(P * fv[tt], 1e-30f); KS[(16 * tq + tt) * 136 + k] = (half_t)((1.f - fv[tt]) * prod * __builtin_amdgcn_rcpf(P)); }
        }
        LDS_BARRIER();
        f32x4 acc[8];
#pragma unroll
        for (int nt = 0; nt < 8; ++nt) acc[nt] = (f32x4){0.f, 0.f, 0.f, 0.f};
        const int kr = 16 * w + fr;
#pragma unroll
        for (int ks = 0; ks < 2; ++ks) {
            const float fj = TF[(2 * ks + (fq >> 1)) * 128 + kr];
            h16x8 a;
#pragma unroll
            for (int j = 0; j < 8; ++j) { const int s2 = 32 * ks + 8 * fq + j; a[j] = (half_t)((float)KS[s2 * 136 + kr] * fj); }
#pragma unroll
            for (int nt = 0; nt < 8; ++nt) acc[nt] = MFMA16(a, hgrn_vfrag(Vr, fr, fq, ks, nt), acc[nt]);
        }
        half_t* ut = UT + (size_t)U * 16384;
#pragma unroll
        for (int nt = 0; nt < 8; ++nt) { u32x2 pk; pk.x = pkh(acc[nt][0], acc[nt][1]); pk.y = pkh(acc[nt][2], acc[nt][3]);
            *(u32x2*)(ut + (16 * nt + fr) * 128 + 16 * w + 4 * fq) = pk; }
    }
#undef HA_LOAD
    LDS_BARRIER();
}

__device__ __forceinline__ void hgrn_carry_phase(const Ctx& c, const half_t* __restrict__ UT, const float* __restrict__ DEC, half_t* __restrict__ SS) {
    for (int g = c.vcu * NTH + c.tid; g < 64 * 2048; g += c.G * NTH) {
        const int bh = g >> 11, p8 = (g & 2047) * 8, k0 = p8 & 127;
        float s[8];
#pragma unroll
        for (int e = 0; e < 8; ++e) s[e] = 0.f;
#pragma unroll 4
        for (int ck = 0; ck < 32; ++ck) {
            const size_t u = (size_t)bh * 32 + ck;
            const h16x8 uv = *(const h16x8*)(UT + u * 16384 + p8);
            const f32x4 d0 = *(const f32x4*)(DEC + u * 128 + k0), d1 = *(const f32x4*)(DEC + u * 128 + k0 + 4);
            u32x4 o; o.x = pkh(s[0], s[1]); o.y = pkh(s[2], s[3]); o.z = pkh(s[4], s[5]); o.w = pkh(s[6], s[7]);
            *(u32x4*)(SS + u * 16384 + p8) = o;
#pragma unroll
            for (int e = 0; e < 4; ++e) { s[e] = fmaf(d0[e], s[e], (float)uv[e]); s[4 + e] = fmaf(d1[e], s[4 + e], (float)uv[4 + e]); }
        }
    }
}

__device__ __forceinline__ void hgrn_out_phase(const Ctx& c, const half_t* __restrict__ Z, const float* __restrict__ lb_logits, const half_t* __restrict__ SS, const float* __restrict__ ng,
                                               half_t* __restrict__ O) {
    const int tid = c.tid, lane = c.lane, w = c.wave, fr = lane & 15, fq = lane >> 4;
    constexpr int ldz = HGRN_IN;
    LAS float* QD = (LAS float*)c.lds;
    LAS half_t* KS = (LAS half_t*)(c.lds + 33792);
    LAS half_t* Vr = KS + 64 * 136;
    LAS half_t* At = Vr + 64 * HG_VS;
    LAS half_t* St = At + 64 * 72;
    LAS float* Tot = (LAS float*)(St + 128 * 136);
    LAS float* TX = Tot + 4 * 128;
    LAS float* TE = TX + 7 * 128;
    LAS float* RS = TE + 4 * 128;
    static_assert(33792 + (64 * 136 + 64 * HG_VS + 64 * 72 + 128 * 136) * 2 + (4 + 7 + 4) * 128 * 4 + 64 * 2 * 4 <= RING_BYTES, "hgrn_out LDS");
    const int k = tid & 127, tq = tid >> 7;
    const int st = tid >> 4, sk8 = (tid & 15) * 8;
    for (int i = tid; i < 64 * 72; i += NTH) At[i] = (half_t)0.f;
    u32x4 qv_[2], zv_[2], vv_[2], sv_[4];
#define HC_LOAD(u_) do { const int b_ = (u_) >> 9, hd_ = ((u_) >> 5) & 15, ck_ = (u_) & 31; const half_t* zp = Z + ((size_t)b_ * S + 64 * ck_ + st) * ldz + hd_ * 128 + sk8; \
        qv_[0] = *(const u32x4*)(zp); qv_[1] = *(const u32x4*)(zp + (size_t)32 * ldz); zv_[0] = *(const u32x4*)(zp + 2048); zv_[1] = *(const u32x4*)(zp + (size_t)32 * ldz + 2048); \
        vv_[0] = *(const u32x4*)(zp + 4096); vv_[1] = *(const u32x4*)(zp + (size_t)32 * ldz + 4096); \
        const half_t* sp = SS + (size_t)(u_) * 16384 + st * 128 + sk8; \
        _Pragma("unroll") for (int i_ = 0; i_ < 4; ++i_) sv_[i_] = *(const u32x4*)(sp + i_ * 32 * 128); } while (0)
    int U = c.vcu;
    if (U < 2048) HC_LOAD(U);
    for (; U < 2048; U += c.G) {
        const int b = U >> 9, hd = (U >> 5) & 15, ck = U & 31;
        const size_t row0 = (size_t)b * S + 64 * ck;
        const float lb = hgrn_lb(lb_logits, hd * 128 + k);
        LDS_BARRIER();
#pragma unroll
        for (int i = 0; i < 2; ++i) { const h16x8 qh = __builtin_bit_cast(h16x8, qv_[i]); f32x4 a0, a1;
#pragma unroll
            for (int e = 0; e < 4; ++e) { const float x0 = (float)qh[e], x1 = (float)qh[4 + e]; a0[e] = x0 * fsigm(x0); a1[e] = x1 * fsigm(x1); }
            *(LAS f32x4*)(QD + (st + 32 * i) * 132 + sk8) = a0; *(LAS f32x4*)(QD + (st + 32 * i) * 132 + sk8 + 4) = a1; }
        *(LAS u32x4*)(KS + st * 136 + sk8) = zv_[0]; *(LAS u32x4*)(KS + (st + 32) * 136 + sk8) = zv_[1];
        *(LAS u32x4*)(Vr + st * HG_VS + sk8) = vv_[0]; *(LAS u32x4*)(Vr + (st + 32) * HG_VS + sk8) = vv_[1];
#pragma unroll
        for (int i = 0; i < 4; ++i) *(LAS u32x4*)(St + (st + 32 * i) * 136 + sk8) = sv_[i];
        if (U + c.G < 2048) HC_LOAD(U + c.G);
        LDS_BARRIER();
        float fv[16]; float prod = 1.f;
#pragma unroll
        for (int tt = 0; tt < 16; ++tt) { const float sg = fsigm((float)KS[(16 * tq + tt) * 136 + k]); fv[tt] = lb + (1.f - lb) * sg; prod *= fv[tt]; }
        prod = fmaxf(prod, 1e-30f);
        Tot[tq * 128 + k] = __logf(prod);
        LDS_BARRIER();
        {
            const float t0 = Tot[k], t1 = Tot[128 + k], t2 = Tot[256 + k], t3 = Tot[384 + k];
            const float be1 = t0, be2 = t0 + t1, be3 = be2 + t2, be4 = be3 + t3;
            if (tq == 0) { TE[k] = fexp(be1); TE[128 + k] = fexp(be2); TE[256 + k] = fexp(be3); TE[384 + k] = fexp(be4); }
            else if (tq == 1) { TX[k] = fexp(be2 - be1); TX[128 + k] = fexp(be3 - be1); TX[256 + k] = fexp(be3 - be2); }
            else if (tq == 2) { TX[384 + k] = fexp(be4 - be1); TX[512 + k] = fexp(be4 - be2); TX[640 + k] = fexp(be4 - be3); }
            const float ip16 = __builtin_amdgcn_rcpf(prod);
            float P = 1.f;
#pragma unroll
            for (int tt = 0; tt < 16; ++tt) {
                const int t = 16 * tq + tt;
                P = fmaxf(P * fv[tt], 1e-30f);
                QD[t * 132 + k] *= P * ip16;
                KS[t * 136 + k] = (half_t)((1.f - fv[tt]) * prod * __builtin_amdgcn_rcpf(P));
                if ((tt & 3) == 3) { asm volatile("" ::: "memory"); __builtin_amdgcn_sched_barrier(0); }
            }
        }
        LDS_BARRIER();
        if (w < 4) {
            const int I = w;
            f32x4 acc = (f32x4){0.f, 0.f, 0.f, 0.f}, acc2 = acc;
#pragma unroll 2
            for (int m = 0; m < 8; m += 2) {
                const int k0 = 16 * m + 4 * fq;
                const f32x4 qd = *(const LAS f32x4*)(QD + (16 * I + fr) * 132 + k0), qd2 = *(const LAS f32x4*)(QD + (16 * I + fr) * 132 + k0 + 16);
                const h16x4 kv = *(const LAS h16x4*)(KS + (16 * I + fr) * 136 + k0), kv2 = *(const LAS h16x4*)(KS + (16 * I + fr) * 136 + k0 + 16);
#pragma unroll
                for (int e = 0; e < 4; ++e) { acc = __builtin_amdgcn_mfma_f32_16x16x4f32(qd[e], (float)kv[e], acc, 0, 0, 0);
                                              acc2 = __builtin_amdgcn_mfma_f32_16x16x4f32(qd2[e], (float)kv2[e], acc2, 0, 0, 0); }
            }
#pragma unroll
            for (int r = 0; r < 4; ++r) { const int tl = 4 * fq + r; At[(16 * I + tl) * 72 + 16 * I + fr] = (half_t)((fr <= tl) ? (acc[r] + acc2[r]) : 0.f); }
        } else {
            const int nb = (w < 6) ? 2 : 1;
            for (int bi = 0; bi < nb; ++bi) {
                const int I = (w == 4) ? (bi == 0 ? 1 : 3) : (w == 5) ? (bi == 0 ? 2 : 3) : (w == 6) ? 3 : 2;
                const int J = (w == 4) ? (bi == 0 ? 0 : 1) : (w == 5) ? (bi == 0 ? 1 : 0) : (w == 6) ? 2 : 0;
                const LAS float* tx = TX + (I * (I - 1) / 2 + J) * 128;
                f32x4 acc = (f32x4){0.f, 0.f, 0.f, 0.f};
#pragma unroll
                for (int ks = 0; ks < 4; ++ks) {
                    const int k0 = 32 * ks + 8 * fq;
                    const f32x4 q0 = *(const LAS f32x4*)(QD + (16 * I + fr) * 132 + k0), q1 = *(const LAS f32x4*)(QD + (16 * I + fr) * 132 + k0 + 4);
                    const f32x4 x0 = *(const LAS f32x4*)(tx + k0), x1 = *(const LAS f32x4*)(tx + k0 + 4);
                    const h16x8 bb = *(const LAS h16x8*)(KS + (16 * J + fr) * 136 + k0);
                    h16x8 a;
#pragma unroll
                    for (int j = 0; j < 4; ++j) { a[j] = (half_t)(q0[j] * x0[j]); a[4 + j] = (half_t)(q1[j] * x1[j]); }
                    acc = MFMA16(a, bb, acc);
                }
#pragma unroll
                for (int r = 0; r < 4; ++r) At[(16 * I + 4 * fq + r) * 72 + 16 * J + fr] = (half_t)acc[r];
            }
        }
        const int mt = w >> 1, nh = w & 1;
        f32x4 oacc[4];
#pragma unroll
        for (int n = 0; n < 4; ++n) oacc[n] = (f32x4){0.f, 0.f, 0.f, 0.f};
        half_t gt[4][4];
#pragma unroll
        for (int n = 0; n < 4; ++n)
#pragma unroll
            for (int r = 0; r < 4; ++r) gt[n][r] = Z[(row0 + 16 * mt + 4 * fq + r) * ldz + 6144 + hd * 128 + 64 * nh + 16 * n + fr];
#pragma unroll
        for (int ks = 0; ks < 4; ++ks) {
            const int k0 = 32 * ks + 8 * fq;
            const f32x4 q0 = *(const LAS f32x4*)(QD + (16 * mt + fr) * 132 + k0), q1 = *(const LAS f32x4*)(QD + (16 * mt + fr) * 132 + k0 + 4);
            const f32x4 x0 = *(const LAS f32x4*)(TE + mt * 128 + k0), x1 = *(const LAS f32x4*)(TE + mt * 128 + k0 + 4);
            h16x8 a;
#pragma unroll
            for (int j = 0; j < 4; ++j) { a[j] = (half_t)(q0[j] * x0[j]); a[4 + j] = (half_t)(q1[j] * x1[j]); }
#pragma unroll
            for (int n = 0; n < 4; ++n) { const h16x8 sb = *(const LAS h16x8*)(St + (64 * nh + 16 * n + fr) * 136 + k0); oacc[n] = MFMA16(a, sb, oacc[n]); }
        }
        LDS_BARRIER();
#pragma unroll
        for (int ks = 0; ks < 2; ++ks) {
            const h16x8 a = *(const LAS h16x8*)(At + (16 * mt + fr) * 72 + 32 * ks + 8 * fq);
#pragma unroll
            for (int n = 0; n < 4; ++n) oacc[n] = MFMA16(a, hgrn_vfrag(Vr, fr, fq, ks, 4 * nh + n), oacc[n]);
        }
        {
            float ssq[4];
#pragma unroll
            for (int r = 0; r < 4; ++r) { float s_ = 0.f;
#pragma unroll
                for (int n = 0; n < 4; ++n) s_ += oacc[n][r] * oacc[n][r];
                ssq[r] = rsum16(s_); }
            if (fr == 0) {
#pragma unroll
                for (int r = 0; r < 4; ++r) RS[(16 * mt + 4 * fq + r) * 2 + nh] = ssq[r];
            }
            LDS_BARRIER();
#pragma unroll
            for (int r = 0; r < 4; ++r) {
                const int t = 16 * mt + 4 * fq + r;
                const float rn = rsqrtf((RS[t * 2] + RS[t * 2 + 1]) * (1.f / 128.f) + RMS_EPS);
                half_t* op = O + (row0 + t) * D + hd * 128 + 64 * nh + fr;
#pragma unroll
                for (int n = 0; n < 4; ++n) { const float gv = (float)gt[n][r]; op[16 * n] = (half_t)(oacc[n][r] * rn * ng[64 * nh + 16 * n + fr] * (gv * fsigm(gv))); }
            }
        }
    }
#undef HC_LOAD
    LDS_BARRIER();
}

}

namespace fp {
constexpr int N_PHASES = 41;
#ifndef PROBE_MASK
#define PROBE_MASK 0
#endif
#define FP_PHASE_G(id, grp, ...) do { if (lo <= (id) && (id) < hi) { \
        if constexpr (((PROBE_MASK) >> (grp)) & 1) { _Pragma("unroll 1") for (int rep_ = 0; rep_ < 2; ++rep_) { asm volatile("" : "+s"(rep_)); __VA_ARGS__; if (rep_ == 0) xcd_barrier(bar); } } \
        else { __VA_ARGS__; } \
        if ((id) + 1 < hi) { xcd_barrier(bar); if constexpr (((PROBE_MASK) >> 10) & 1) xcd_barrier(bar); } } } while (0)
#define FP_PHASE(id, ...) FP_PHASE_G(id, 31, __VA_ARGS__)

template <int L>
__device__ __forceinline__ void layer_phases(const Ctx& c, const Params& p, const XcdBarrier& bar, int lo, int hi) {
    constexpr int KIND = L % 4, PB = 1 + 10 * L;
    constexpr int NIN = KIND == 0 ? SWA_IN : KIND == 1 ? DIFF_IN : KIND == 2 ? HGRN_IN : DSA_MAIN;
    constexpr size_t WIN_OFF = KIND == 0 ? WS_WIN0 : KIND == 1 ? WS_WIN1 : KIND == 2 ? WS_WIN2 : WS_WIN3;
    unsigned char* ws = p.ws;
    half_t* H = (half_t*)(ws + WS_X16); float* RS = (float*)(ws + WS_RS); half_t* ZU = (half_t*)(ws + WS_ZU); half_t* O = (half_t*)(ws + WS_O); float* MF = (float*)(ws + WS_MF); half_t* ACT = (half_t*)(ws + WS_ACT);
    const float* ng = p.in[3] + (size_t)L * 4 * D;
    const float* bias = p.in[1];
    FP_PHASE_G(PB + 0, 0, { if constexpr (KIND == 3) dsa_kiwi_phase(c, H, RS, (const half_t*)(ws + WS_WIN3), (half_t*)(ws + WS_KW));
                       pg8::Gemm g{H, (const half_t*)(ws + WIN_OFF), M, NIN, D}; pg8::StaticOrder so; so.init(M, NIN, c.G, (int)blockIdx.x); pg8::EpiH16T<true> E{ZU, NIN, RS};
                       pg8::gemm_phase<pg8::EpiH16T<true>, pg8::StaticOrder, true, true>(c.lds, g, so, E);
                       if constexpr (L == 0) { if (c.G == 256 && (int)blockIdx.x >= so.nwg - c.G) spare_slot_convert(c, p, 1, 0, DEFER_G1, (int)blockIdx.x - (so.nwg - c.G)); } });
    if constexpr (KIND == 0) {
        FP_PHASE_G(PB + 1, 1, gqa_phase<0>(c, ZU, SWA_IN, 2048, 2560, bias, p.in[9], nullptr, O));
    } else if constexpr (KIND == 1) {
        FP_PHASE_G(PB + 1, 2, diff_phase(c, ZU, bias, p.in[12], p.in[13], 0.8f - 0.6f * 0.74081822068f  , O));
    } else if constexpr (KIND == 2) {
        FP_PHASE_G(PB + 1, 3, hgrn_local_phase(c, ZU, p.in[2], (half_t*)(ws + WS_HUT), (float*)(ws + WS_HDEC)));
        FP_PHASE_G(PB + 2, 7, hgrn_carry_phase(c, (const half_t*)(ws + WS_HUT), (const float*)(ws + WS_HDEC), (half_t*)MF));
        FP_PHASE_G(PB + 3, 3, hgrn_out_phase(c, ZU, p.in[2], (const half_t*)MF, p.in[16], O));
    } else {
        FP_PHASE_G(PB + 1, 8, dsa_score_phase(c, ZU, (const half_t*)(ws + WS_KW), (float*)(ws + WS_ACT)));
        FP_PHASE_G(PB + 2, 9, dsa_select_phase(c, (const float*)(ws + WS_ACT), (unsigned*)(ws + WS_MBITS)));
        FP_PHASE_G(PB + 3, 4, gqa_phase<1>(c, ZU, DSA_MAIN, 2048, 2560, bias, nullptr, (const unsigned*)(ws + WS_MBITS), O));
    }
    FP_PHASE_G(PB + 4, 0, { pg8::Gemm g{O, (const half_t*)(ws + WS_WOUT + L * WOUT_STRIDE), M, D, D}; pg8::StaticOrder so; so.init(M, D, c.G, (int)blockIdx.x); pg8::EpiH16 E{(half_t*)MF, D};
                       pg8::gemm_phase<pg8::EpiH16, pg8::StaticOrder, true, true>(c.lds, g, so, E); });
    FP_PHASE(PB + 5, resnorm_phase(c, (half_t*)(ws + WS_X16), (const half_t*)MF, ng + D, RS, nullptr));
    FP_PHASE_G(PB + 6, 0, { constexpr int MT = (M + 253) / 254; pg8::Gemm g{H, (const half_t*)(ws + WS_WUP + L * WUP_STRIDE), MT * 256, NUP, D, 254, -2}; pg8::StaticOrder so; so.init(MT * 256, NUP, c.G, (int)blockIdx.x);
                       pg8::EpiConv E{ACT, p.in[5] + (size_t)L * 3 * NUP, (LAS float*)(c.lds + MISC_OFF + 256), M, S, DFF, NUP, RS};
                       pg8::gemm_phase<pg8::EpiConv, pg8::StaticOrder, true, true>(c.lds, g, so, E);
                       if constexpr (L < 3) { const int nfull = so.nwg % c.G;
                           if (c.G == 256 && nfull == 256 - 84 && (int)blockIdx.x >= nfull) spare_slot_convert(c, p, L + 1, L == 0 ? DEFER_G1 : 0, L == 0 ? FFN_TILES : DEFER_G3, (int)blockIdx.x - nfull); } });
    FP_PHASE_G(PB + 8, 0, { pg8::Gemm g{ACT, (const half_t*)(ws + WS_WDN + L * WDN_STRIDE), M, D, DFF}; pg8::StaticOrder so; so.init(M, D, c.G, (int)blockIdx.x); pg8::EpiH16 E{(half_t*)MF, D};
                       pg8::gemm_phase<pg8::EpiH16, pg8::StaticOrder, true, true>(c.lds, g, so, E); });
    FP_PHASE(PB + 9, resnorm_phase(c, (half_t*)(ws + WS_X16), (const half_t*)MF, ng + 3 * D, (L < 3) ? RS : (float*)nullptr, (L < 3) ? (float*)nullptr : p.out));
}

__global__ void __launch_bounds__(NTH, 2) fwd_kernel(Params p) {
    extern __shared__ __attribute__((aligned(16))) unsigned char lds_raw[];
    Ctx c;
    c.lds = (LAS unsigned char*)lds_raw;
    c.tid = threadIdx.x; c.lane = c.tid & 63; c.wave = __builtin_amdgcn_readfirstlane(c.tid >> 6);
    c.G = gridDim.x; { const int bx = blockIdx.x; c.vcu = (c.G % 8 == 0) ? (bx % 8) * (c.G / 8) + bx / 8 : bx; }
    volatile LAS unsigned* misc = (volatile LAS unsigned*)(c.lds + MISC_OFF);
    if (c.tid < 4) misc[c.tid] = 0u;
    __syncthreads();
    XcdBarrier bar = xcd_barrier_post((unsigned*)(p.ws + WS_CTL) + CW_BAR, misc);
    const int lo = p.ph_lo, hi = p.ph_hi;
    FP_PHASE_G(0, 6, prologue_phase(c, p));
#ifndef ONLY_LAYER
#define ONLY_LAYER -1
#endif
    if constexpr (ONLY_LAYER < 0 || ONLY_LAYER == 0) layer_phases<0>(c, p, bar, lo, hi);
    if constexpr (ONLY_LAYER < 0 || ONLY_LAYER == 1) layer_phases<1>(c, p, bar, lo, hi);
    if constexpr (ONLY_LAYER < 0 || ONLY_LAYER == 2) layer_phases<2>(c, p, bar, lo, hi);
    if constexpr (ONLY_LAYER < 0 || ONLY_LAYER == 3) layer_phases<3>(c, p, bar, lo, hi);
}

static int g_grid = 0;
static int fast_setup() {
    if (g_grid == 0) {
        int dev = 0, cus = 0, per_cu = 0;
        if (hipGetDevice(&dev) != hipSuccess || hipDeviceGetAttribute(&cus, hipDeviceAttributeMultiprocessorCount, dev) != hipSuccess) { fprintf(stderr, "kernel_launch: device query failed\n"); g_grid = -1; return g_grid; }
        if (hipFuncSetAttribute((const void*)fwd_kernel, hipFuncAttributeMaxDynamicSharedMemorySize, LDS_BYTES) != hipSuccess) { fprintf(stderr, "kernel_launch: hipFuncSetAttribute failed\n"); g_grid = -1; return g_grid; }
        if (hipOccupancyMaxActiveBlocksPerMultiprocessor(&per_cu, (const void*)fwd_kernel, NTH, LDS_BYTES) != hipSuccess || per_cu < 1) fprintf(stderr, "kernel_launch: occupancy query says %d\n", per_cu);
        (void)hipGetLastError();
        g_grid = cus;
    }
    return g_grid;
}
static void fast_launch(void* const* d_in, void* d_out, void* d_ws, int lo, int hi, hipStream_t stream) {
    Params p{};
    for (int i = 0; i < 19; ++i) p.in[i] = (const float*)d_in[i];
    p.out = (float*)d_out; p.ws = (unsigned char*)d_ws; p.ph_lo = lo; p.ph_hi = hi;
#if MODE == 2
    (void)hipMemsetAsync((char*)d_ws + WS_CTL + CW_BAR * 4, 0, XCD_BAR_WORDS * 4, stream);
#endif
    hipLaunchKernelGGL(fwd_kernel, dim3(g_grid), dim3(NTH), LDS_BYTES, stream, p);
}
}

#if MODE == 0
extern "C" void kernel_launch(void* const* d_in, const int* in_sizes, int n_in, void* d_out, int out_size, void* d_ws, size_t ws_size, hipStream_t stream) {
    if (fp::fast_setup() <= 0) return;
    (void)hipMemsetAsync((char*)d_ws + fp::WS_CTL, 0, fp::CTL_BYTES, stream);
    fp::fast_launch(d_in, d_out, d_ws, 0, fp::N_PHASES, stream);
}
#endif

#if MODE == 2
namespace dbg {
using namespace cfg;
template <bool HALF>
__global__ void __launch_bounds__(256) cmp_kernel(const void* f, int ldf, const float* o, int ldo, int rows, int cols, float* sums) {
    float sd = 0.f, so = 0.f;
    const size_t n = (size_t)rows * cols;
    for (size_t i = (size_t)blockIdx.x * 256 + threadIdx.x; i < n; i += (size_t)gridDim.x * 256) {
        const int r = (int)(i / cols), cc = (int)(i % cols);
        const float fv = HALF ? (float)((const half_t*)f)[(size_t)r * ldf + cc] : ((const float*)f)[(size_t)r * ldf + cc];
        const float ov = o[(size_t)r * ldo + cc];
        const float d = fv - ov; sd += d * d; so += ov * ov;
    }
    for (int off = 32; off >= 1; off >>= 1) { sd += __shfl_xor(sd, off); so += __shfl_xor(so, off); }
    if ((threadIdx.x & 63) == 0) { atomicAdd(sums, sd); atomicAdd(sums + 1, so); }
}
__global__ void __launch_bounds__(256) report_kernel(const float* sums, int nck, float* out, size_t n) {
    int bad = 0; float V = 0.f;
    for (int k = 0; k < nck; ++k) {
        const float sd = sums[2 * k], so = sums[2 * k + 1];
        if (so == 0.f && sd == 0.f) continue;
        const float rvr = sd / so;
        const float tol = (k == 23) ? 2e-2f : (k > 23) ? 5e-3f : 3e-4f;
        if (!(rvr < tol)) {
            int e = 15;
            if (rvr == rvr) { e = (int)floorf(1.f - log10f(rvr)); e = e < 0 ? 0 : (e > 12 ? 12 : e); }
            V = (float)(10 + k + 1) * powf(10.f, (float)(4 + e)); bad = 1; break;
        }
    }
    if (!bad) return;
    for (size_t i = (size_t)blockIdx.x * 256 + threadIdx.x; i < n; i += (size_t)gridDim.x * 256) out[i] = (i == 0) ? V : 0.f;
}
}

extern "C" void kernel_launch(void* const* d_in, const int* in_sizes, int n_in, void* d_out, int out_size, void* d_ws, size_t ws_size, hipStream_t stream) {
    using namespace cfg;
    if (fp::fast_setup() <= 0) return;
    unsigned char* ws = (unsigned char*)d_ws;
    (void)hipMemsetAsync(ws + fp::WS_CTL, 0, fp::CTL_BYTES, stream);
    float* sums = (float*)(ws + fp::WS_CTL) + fp::CW_CK;
    constexpr size_t MiB = 1u << 20;
    size_t off = fp::WS_FAST_END + 2 * MiB;
    orc::Bufs bf;
    bf.X = (float*)(ws + off); off += 64 * MiB;
    bf.O = (float*)(ws + off); off += 64 * MiB;
    bf.MF = (float*)(ws + off); off += 64 * MiB;
    bf.H = (float*)(ws + off); off += 16 * MiB;
    bf.Z = (float*)(ws + off); off += 64 * MiB;
    bf.U = (float*)(ws + off); off += 88 * MiB;
    bf.A = (float*)(ws + off); off += 44 * MiB;
    if (off > ws_size) { fprintf(stderr, "kernel_launch: workspace too small (%zu > %zu)\n", off, ws_size); return; }
    (void)hipMemcpyAsync(bf.X, d_in[0], (size_t)M * D * 4, hipMemcpyDeviceToDevice, stream);
    half_t* fZU = (half_t*)(ws + fp::WS_ZU); half_t* fO = (half_t*)(ws + fp::WS_O); half_t* fACT = (half_t*)(ws + fp::WS_ACT);
    float* fX = (float*)d_out;
    fp::fast_launch(d_in, d_out, d_ws, 0, 1, stream);
    for (int L = 0; L < 4; ++L) {
        const int kind = L % 4, PB = 1 + 10 * L;
        const int nin = kind == 0 ? SWA_IN : kind == 1 ? DIFF_IN : kind == 2 ? HGRN_IN : DSA_IN;
        const int ninp = kind == 3 ? fp::DSA_MAIN : nin;
        float* ck = sums + 2 * 7 * L;
        fp::fast_launch(d_in, d_out, d_ws, PB, PB + 1, stream);
        for (int b = 0; b < B; ++b)
            orc::run_mixer(bf, d_in, L, b, 1, stream, [&](int stage) {
                if (b != 0) return;
                if (stage == 1) dbg::cmp_kernel<true><<<1024, 256, 0, stream>>>(fZU, ninp, bf.Z, nin, S, nin < ninp ? nin : ninp, ck + 2);
            });
        fp::fast_launch(d_in, d_out, d_ws, PB + 1, PB + 4, stream);
        dbg::cmp_kernel<true><<<1024, 256, 0, stream>>>(fO, D, bf.O, D, M, D, ck + 4);
        fp::fast_launch(d_in, d_out, d_ws, PB + 4, PB + 5, stream);
        fp::fast_launch(d_in, d_out, d_ws, PB + 5, PB + 6, stream);
        dbg::cmp_kernel<true><<<1024, 256, 0, stream>>>(ws + fp::WS_X16, D, bf.X, D, M, D, ck + 6);
        fp::fast_launch(d_in, d_out, d_ws, PB + 6, PB + 7, stream);
        for (int b = 0; b < B; ++b)
            orc::run_ffn(bf, d_in, L, b, 1, stream, [&](int stage) {
                if (b != 0) return;
                if (stage == 2) { (void)fZU; }
                if (stage == 3) dbg::cmp_kernel<true><<<1024, 256, 0, stream>>>(fACT, DFF, bf.A, DFF, S, DFF, ck + 10);
            });
        fp::fast_launch(d_in, d_out, d_ws, PB + 8, PB + 9, stream);
        fp::fast_launch(d_in, d_out, d_ws, PB + 9, PB + 10, stream);
        if (L < 3) dbg::cmp_kernel<true><<<1024, 256, 0, stream>>>(ws + fp::WS_X16, D, bf.X, D, M, D, ck + 12);
        else dbg::cmp_kernel<false><<<1024, 256, 0, stream>>>(fX, D, bf.X, D, M, D, ck + 12);
    }
    dbg::report_kernel<<<1024, 256, 0, stream>>>(sums, 28, fX, (size_t)M * D);
}
#endif
#endif
#if MODE == 1
extern "C" void kernel_launch(void* const* d_in, const int* in_sizes, int n_in, void* d_out, int out_size, void* d_ws, size_t ws_size, hipStream_t stream) {
    using namespace cfg;
    float* ws = (float*)d_ws;
    orc::Bufs bf;
    bf.X = (float*)d_out;
    size_t off = 0;
    bf.H = ws + off; off += (size_t)M * D;
    bf.O = ws + off; off += (size_t)M * D;
    bf.MF = ws + off; off += (size_t)M * D;
    bf.Z = ws + off; off += (size_t)M * 8192;
    bf.U = ws + off; off += (size_t)M * NUP;
    bf.A = ws + off; off += (size_t)M * DFF;
    hipMemcpyAsync(bf.X, d_in[0], (size_t)M * D * 4, hipMemcpyDeviceToDevice, stream);
    for (int layer = 0; layer < 4; ++layer) {
        orc::run_mixer(bf, d_in, layer, 0, B, stream, orc::NoHook());
        orc::run_ffn(bf, d_in, layer, 0, B, stream, orc::NoHook());
    }
}
#endif
```

```cpp
#define MODE 0
#include <hip/hip_runtime.h>
#include <stdint.h>
#include <stdio.h>
#include <math.h>

#ifndef MODE
#define MODE 1
#endif

namespace cfg {
constexpr int B = 4, S = 2048, D = 2048, M = B * S, DFF = 5632, NUP = 2 * DFF, TOPK = 256;
constexpr int SWA_IN = 3072, DIFF_IN = 6144, HGRN_IN = 8192, DSA_IN = 4176, DSA_PAD = 4352;
constexpr float RMS_EPS = 1e-6f;
}
__constant__ unsigned char BUCKET_LUT[128] = {0,1,2,3,4,5,6,7,8,9,10,11,12,13,14,15,16,16,16,17,17,18,18,18,19,19,19,20,20,20,20,21,21,21,21,22,22,22,22,22,23,23,23,23,23,23,24,24,24,24,24,24,25,25,25,25,25,25,25,26,26,26,26,26,26,26,26,27,27,27,27,27,27,27,27,27,27,28,28,28,28,28,28,28,28,28,28,29,29,29,29,29,29,29,29,29,29,29,29,30,30,30,30,30,30,30,30,30,30,30,30,30,30,31,31,31,31,31,31,31,31,31,31,31,31,31,31,31};
#if MODE != 0
namespace orc {
using namespace cfg;

__device__ __forceinline__ float sigm(float x) { return 1.f / (1.f + expf(-x)); }
__device__ __forceinline__ int bucket(int n) { return n < 128 ? (int)BUCKET_LUT[n] : 31; }

__device__ __forceinline__ float wave_sum(float v) {
#pragma unroll
    for (int o = 32; o >= 1; o >>= 1) v += __shfl_xor(v, o);
    return v;
}
__device__ __forceinline__ float wave_max(float v) {
#pragma unroll
    for (int o = 32; o >= 1; o >>= 1) v = fmaxf(v, __shfl_xor(v, o));
    return v;
}
__device__ __forceinline__ float block_sum(float v, float* red) {
    v = wave_sum(v);
    const int w = threadIdx.x >> 6, nw = blockDim.x >> 6;
    __syncthreads();
    if ((threadIdx.x & 63) == 0) red[w] = v;
    __syncthreads();
    float r = 0.f;
    for (int i = 0; i < nw; ++i) r += red[i];
    return r;
}
__device__ __forceinline__ float block_max(float v, float* red) {
    v = wave_max(v);
    const int w = threadIdx.x >> 6, nw = blockDim.x >> 6;
    __syncthreads();
    if ((threadIdx.x & 63) == 0) red[w] = v;
    __syncthreads();
    float r = red[0];
    for (int i = 1; i < nw; ++i) r = fmaxf(r, red[i]);
    return r;
}

__global__ void __launch_bounds__(256) o_gemm(const float* __restrict__ A, int lda, const float* __restrict__ W, int ldw,
                                              float* __restrict__ C, int ldc, int N, int K) {
    __shared__ float As[16][132];
    __shared__ float Ws[16][132];
    const int tid = threadIdx.x, tx = tid & 15, ty = tid >> 4;
    const int m0 = blockIdx.y * 128, n0 = blockIdx.x * 128;
    float acc[8][8];
#pragma unroll
    for (int i = 0; i < 8; ++i)
#pragma unroll
        for (int j = 0; j < 8; ++j) acc[i][j] = 0.f;
    for (int k0 = 0; k0 < K; k0 += 16) {
#pragma unroll
        for (int i = 0; i < 8; ++i) { const int idx = tid + i * 256, r = idx >> 4, c = idx & 15; As[c][r] = A[(size_t)(m0 + r) * lda + k0 + c]; }
#pragma unroll
        for (int i = 0; i < 8; ++i) { const int idx = tid + i * 256, r = idx >> 7, c = idx & 127; Ws[r][c] = (n0 + c < N) ? W[(size_t)(k0 + r) * ldw + n0 + c] : 0.f; }
        __syncthreads();
#pragma unroll
        for (int kk = 0; kk < 16; ++kk) {
            float a[8], b[8];
#pragma unroll
            for (int i = 0; i < 8; ++i) { a[i] = As[kk][ty * 8 + i]; b[i] = Ws[kk][tx * 8 + i]; }
#pragma unroll
            for (int i = 0; i < 8; ++i)
#pragma unroll
                for (int j = 0; j < 8; ++j) acc[i][j] = fmaf(a[i], b[j], acc[i][j]);
        }
        __syncthreads();
    }
#pragma unroll
    for (int i = 0; i < 8; ++i)
#pragma unroll
        for (int j = 0; j < 8; ++j) { const int n = n0 + tx * 8 + j; if (n < N) C[(size_t)(m0 + ty * 8 + i) * ldc + n] = acc[i][j]; }
}

template <bool ADD>
__global__ void __launch_bounds__(256) o_rmsnorm(const float* __restrict__ in, const float* __restrict__ g, float* __restrict__ out) {
    __shared__ float red[16];
    const size_t row = blockIdx.x;
    const float* x = in + row * D;
    float ss = 0.f;
    for (int c = threadIdx.x; c < D; c += 256) ss += x[c] * x[c];
    ss = block_sum(ss, red);
    const float r = rsqrtf(ss / (float)D + RMS_EPS);
    for (int c = threadIdx.x; c < D; c += 256) { const float y = x[c] * r * g[c]; if (ADD) out[row * D + c] += y; else out[row * D + c] = y; }
}

__global__ void __launch_bounds__(128) o_swa(const float* __restrict__ Z, const float* __restrict__ bias, const float* __restrict__ sinks, float* __restrict__ O, int b0) {
    __shared__ float qs[64], ps[128], red[16];
    const int t = blockIdx.x, h = blockIdx.y, bl = blockIdx.z, kvh = h >> 2, tid = threadIdx.x;
    const size_t zr = (size_t)bl * S + t;
    const float* zq = Z + zr * 3072;
    if (tid < 64) qs[tid] = zq[h * 64 + tid];
    __syncthreads();
    const int j = tid, s = t - j;
    float sc = -INFINITY;
    if (s >= 0) {
        const float* kp = Z + (zr - j) * 3072 + 2048 + kvh * 64;
        float d = 0.f;
        for (int e = 0; e < 64; ++e) d = fmaf(qs[e], kp[e], d);
        sc = d * 0.125f + bias[bucket(j) * 32 + h];
    }
    const float sink = sinks[h];
    const float mx = fmaxf(block_max(sc, red), sink);
    const float p = (s >= 0) ? expf(sc - mx) : 0.f;
    const float den = block_sum(p, red) + expf(sink - mx);
    ps[j] = p / den;
    __syncthreads();
    if (tid < 64) {
        float o = 0.f;
        const int nj = t < 127 ? t + 1 : 128;
        for (int jj = 0; jj < nj; ++jj) o = fmaf(ps[jj], Z[(zr - jj) * 3072 + 2560 + kvh * 64 + tid], o);
        O[((size_t)(b0 + bl) * S + t) * D + h * 64 + tid] = o;
    }
}

__global__ void __launch_bounds__(256) o_diff(const float* __restrict__ Z, const float* __restrict__ bias, const float* __restrict__ lambdas, const float* __restrict__ subg,
                                              float* __restrict__ O, int b0, float lam_init) {
    __shared__ float qs[128], sc[2][2048], part[256], red[16];
    const int t = blockIdx.x, h = blockIdx.y, bl = blockIdx.z, tid = threadIdx.x;
    const size_t zr0 = (size_t)bl * S;
    const float* zq = Z + (zr0 + t) * 6144;
    if (tid < 128) qs[tid] = zq[h * 128 + tid];
    float l1 = 0.f, l2 = 0.f;
    if (tid < 64) { l1 = lambdas[tid] * lambdas[64 + tid]; l2 = lambdas[128 + tid] * lambdas[192 + tid]; }
    l1 = block_sum(l1, red); l2 = block_sum(l2, red);
    const float lam = expf(l1) - expf(l2) + lam_init;
    float mx[2], sm[2];
    for (int m = 0; m < 2; ++m) {
        float lmx = -INFINITY;
        for (int s = tid; s <= t; s += 256) {
            const float* kp = Z + (zr0 + s) * 6144 + 2048 + h * 128 + m * 64;
            float d = 0.f;
            for (int e = 0; e < 64; ++e) d = fmaf(qs[m * 64 + e], kp[e], d);
            const float v = d * 0.125f + bias[bucket(t - s) * 32 + h * 2 + m];
            sc[m][s] = v; lmx = fmaxf(lmx, v);
        }
        mx[m] = block_max(lmx, red);
        float ls = 0.f;
        for (int s = tid; s <= t; s += 256) ls += expf(sc[m][s] - mx[m]);
        sm[m] = block_sum(ls, red);
    }
    for (int s = tid; s <= t; s += 256) sc[0][s] = expf(sc[0][s] - mx[0]) / sm[0] - lam * (expf(sc[1][s] - mx[1]) / sm[1]);
    __syncthreads();
    const int e = tid & 127, half = tid >> 7;
    float o = 0.f;
    for (int s = half; s <= t; s += 2) o = fmaf(sc[0][s], Z[(zr0 + s) * 6144 + 4096 + h * 128 + e], o);
    part[tid] = o;
    __syncthreads();
    float ov = 0.f, ss = 0.f;
    if (tid < 128) { ov = part[tid] + part[tid + 128]; ss = ov * ov; }
    ss = block_sum(ss, red);
    if (tid < 128) {
        const float r = rsqrtf(ss / 128.f + RMS_EPS);
        O[((size_t)(b0 + bl) * S + t) * D + h * 128 + e] = ov * r * subg[e] * (1.f - lam_init);
    }
}

__global__ void __launch_bounds__(256) o_hgrn(const float* __restrict__ Z, const float* __restrict__ lb_logits, const float* __restrict__ ng, float* __restrict__ O, int b0) {
    __shared__ float qs[128], fs[128], ks[128], part[256], red[16];
    const int h = blockIdx.x, bl = blockIdx.z, tid = threadIdx.x, v = tid & 127, kh = tid >> 7;
    float lb = 0.f;
    if (tid < 128) {
        const int c = h * 128 + tid;
        const float a0 = lb_logits[c], a1 = lb_logits[2048 + c], a2 = lb_logits[4096 + c], a3 = lb_logits[6144 + c];
        const float mm = fmaxf(fmaxf(a0, a1), fmaxf(a2, a3));
        const float e0 = expf(a0 - mm), e1 = expf(a1 - mm), e2 = expf(a2 - mm), e3 = expf(a3 - mm);
        lb = (e1 + e2) / (e0 + e1 + e2 + e3);
    }
    float St[64];
#pragma unroll
    for (int i = 0; i < 64; ++i) St[i] = 0.f;
    const float gn = ng[v];
    for (int t = 0; t < S; ++t) {
        const float* zr = Z + ((size_t)bl * S + t) * 8192;
        if (tid < 128) {
            const float qv = zr[h * 128 + tid]; qs[tid] = qv * sigm(qv);
            const float z = zr[2048 + h * 128 + tid];
            fs[tid] = lb + (1.f - lb) * sigm(z);
            ks[tid] = (1.f - lb) * sigm(-z);
        }
        const float iv = zr[4096 + h * 128 + v];
        __syncthreads();
        float p = 0.f;
#pragma unroll
        for (int kk = 0; kk < 64; ++kk) { const int k = kh * 64 + kk; St[kk] = fmaf(fs[k], St[kk], ks[k] * iv); p = fmaf(qs[k], St[kk], p); }
        part[tid] = p;
        __syncthreads();
        float ov = 0.f, ss = 0.f;
        if (tid < 128) { ov = part[tid] + part[tid + 128]; ss = ov * ov; }
        ss = block_sum(ss, red);
        if (tid < 128) {
            const float r = rsqrtf(ss / 128.f + RMS_EPS);
            const float gt = zr[6144 + h * 128 + v];
            O[((size_t)(b0 + bl) * S + t) * D + h * 128 + v] = ov * r * gn * (gt * sigm(gt));
        }
        __syncthreads();
    }
}

__global__ void __launch_bounds__(256) o_dsa(const float* __restrict__ Z, const float* __restrict__ bias, float* __restrict__ O, int b0) {
    __shared__ float qi[1024], wi[16], sc[2048], q[2048], pj[256], red[16];
    __shared__ int idx[256];
    __shared__ unsigned char sel[2048];
    __shared__ int nsel_s;
    const int t = blockIdx.x, bl = blockIdx.z, tid = threadIdx.x;
    const size_t zr0 = (size_t)bl * S;
    const int LD = 4176;
    const float* zq = Z + (zr0 + t) * LD;
    for (int i = tid; i < 1024; i += 256) qi[i] = zq[3072 + i];
    for (int i = tid; i < 2048; i += 256) q[i] = zq[i];
    if (tid < 16) wi[tid] = zq[4160 + tid] * 0.25f;
    __syncthreads();
    for (int s = tid; s < S; s += 256) {
        float a = -INFINITY;
        if (s <= t) {
            const float* kp = Z + (zr0 + s) * LD + 4096;
            a = 0.f;
            for (int hh = 0; hh < 16; ++hh) {
                float d = 0.f;
                for (int e = 0; e < 64; ++e) d = fmaf(qi[hh * 64 + e], kp[e], d);
                d *= 0.125f;
                a += wi[hh] * fmaxf(d, 0.f);
            }
        }
        sc[s] = a;
    }
    __syncthreads();
    for (int s = tid; s < S; s += 256) {
        const float v = sc[s];
        int r = 0;
        for (int s2 = 0; s2 < S; ++s2) { const float v2 = sc[s2]; r += (v2 > v || (v2 == v && s2 < s)) ? 1 : 0; }
        sel[s] = (r < TOPK && s <= t) ? 1 : 0;
    }
    __syncthreads();
    if (tid == 0) { int n = 0; for (int s = 0; s < S; ++s) if (sel[s]) { if (n < 256) idx[n] = s; ++n; } nsel_s = n < 256 ? n : 256; }
    __syncthreads();
    const int nsel = nsel_s;
    for (int h = 0; h < 32; ++h) {
        const int kvh = h >> 2;
        float scv = -INFINITY; int s = 0;
        if (tid < nsel) {
            s = idx[tid];
            const float* kp = Z + (zr0 + s) * LD + 2048 + kvh * 64;
            float d = 0.f;
            for (int e = 0; e < 64; ++e) d = fmaf(q[h * 64 + e], kp[e], d);
            scv = d * 0.125f + bias[bucket(t - s) * 32 + h];
        }
        const float mx = block_max(scv, red);
        const float ev = (tid < nsel) ? expf(scv - mx) : 0.f;
        const float sm = block_sum(ev, red);
        pj[tid] = ev / sm;
        __syncthreads();
        if (tid < 64) {
            float o = 0.f;
            for (int j = 0; j < nsel; ++j) o = fmaf(pj[j], Z[(zr0 + idx[j]) * LD + 2560 + kvh * 64 + tid], o);
            O[((size_t)(b0 + bl) * S + t) * D + h * 64 + tid] = o;
        }
        __syncthreads();
    }
}

__global__ void __launch_bounds__(256) o_convact(const float* __restrict__ U, const float* __restrict__ cw, float* __restrict__ A) {
    const int c = blockIdx.x * 256 + threadIdx.x; const size_t r = blockIdx.y; const int t = (int)(r % S);
    float g = 0.f, v = 0.f;
#pragma unroll
    for (int j = 0; j < 3; ++j) {
        const int tt = t - 2 + j;
        if (tt >= 0) { const float* u = U + (r - 2 + j) * NUP; g = fmaf(cw[j * NUP + c], u[c], g); v = fmaf(cw[j * NUP + DFF + c], u[DFF + c], v); }
    }
    A[r * DFF + c] = g * sigm(g) * v;
}

struct Bufs { float *X, *H, *Z, *O, *MF, *U, *A; };

template <class Hook> static void run_mixer(const Bufs& bf, void* const* d_in, int layer, int b0, int nb, hipStream_t st, Hook hook) {
    const float* ng = (const float*)d_in[3] + (size_t)layer * 4 * D;
    const int rows = nb * S; const size_t r0 = (size_t)b0 * S;
    const float* bias = (const float*)d_in[1];
    o_rmsnorm<false><<<rows, 256, 0, st>>>(bf.X + r0 * D, ng, bf.H);
    hook(0);
    const int kind = layer % 4;
    const float* win = (const float*)d_in[kind == 0 ? 7 : kind == 1 ? 10 : kind == 2 ? 14 : 17];
    const float* wout = (const float*)d_in[kind == 0 ? 8 : kind == 1 ? 11 : kind == 2 ? 15 : 18];
    const int nin = kind == 0 ? SWA_IN : kind == 1 ? DIFF_IN : kind == 2 ? HGRN_IN : DSA_IN;
    o_gemm<<<dim3((nin + 127) / 128, rows / 128), 256, 0, st>>>(bf.H, D, win, nin, bf.Z, nin, nin, D);
    hook(1);
    if (kind == 0) o_swa<<<dim3(S, 32, nb), 128, 0, st>>>(bf.Z, bias, (const float*)d_in[9], bf.O, b0);
    else if (kind == 1) o_diff<<<dim3(S, 16, nb), 256, 0, st>>>(bf.Z, bias, (const float*)d_in[12], (const float*)d_in[13], bf.O, b0, 0.8f - 0.6f * expf(-0.3f * (float)layer));
    else if (kind == 2) o_hgrn<<<dim3(16, 1, nb), 256, 0, st>>>(bf.Z, (const float*)d_in[2], (const float*)d_in[16], bf.O, b0);
    else o_dsa<<<dim3(S, 1, nb), 256, 0, st>>>(bf.Z, bias, bf.O, b0);
    o_gemm<<<dim3(D / 128, rows / 128), 256, 0, st>>>(bf.O + r0 * D, D, wout, D, bf.MF + r0 * D, D, D, D);
    o_rmsnorm<true><<<rows, 256, 0, st>>>(bf.MF + r0 * D, ng + D, bf.X + r0 * D);
}
template <class Hook> static void run_ffn(const Bufs& bf, void* const* d_in, int layer, int b0, int nb, hipStream_t st, Hook hook) {
    const float* ng = (const float*)d_in[3] + (size_t)layer * 4 * D;
    const int rows = nb * S; const size_t r0 = (size_t)b0 * S;
    o_rmsnorm<false><<<rows, 256, 0, st>>>(bf.X + r0 * D, ng + 2 * D, bf.H);
    o_gemm<<<dim3(NUP / 128, rows / 128), 256, 0, st>>>(bf.H, D, (const float*)d_in[4] + (size_t)layer * D * NUP, NUP, bf.U, NUP, NUP, D);
    hook(2);
    o_convact<<<dim3(DFF / 256, rows), 256, 0, st>>>(bf.U, (const float*)d_in[5] + (size_t)layer * 3 * NUP, bf.A);
    hook(3);
    o_gemm<<<dim3(D / 128, rows / 128), 256, 0, st>>>(bf.A, DFF, (const float*)d_in[6] + (size_t)layer * DFF * D, D, bf.MF + r0 * D, D, D, DFF);
    o_rmsnorm<true><<<rows, 256, 0, st>>>(bf.MF + r0 * D, ng + 3 * D, bf.X + r0 * D);
}
struct NoHook { void operator()(int) const {} };
}

#endif

#if MODE != 1
#define GAS __attribute__((address_space(1)))
#define LAS __attribute__((address_space(3)))
typedef _Float16 half_t;
typedef _Float16 h16x8 __attribute__((ext_vector_type(8)));
typedef _Float16 h16x4 __attribute__((ext_vector_type(4)));
typedef _Float16 h16x2 __attribute__((ext_vector_type(2)));
typedef float f32x4 __attribute__((ext_vector_type(4)));
typedef float f32x2 __attribute__((ext_vector_type(2)));
typedef unsigned u32x4 __attribute__((ext_vector_type(4)));
typedef unsigned u32x2 __attribute__((ext_vector_type(2)));
#define MFMA16(a, b, c) __builtin_amdgcn_mfma_f32_16x16x32_f16((a), (b), (c), 0, 0, 0)
__device__ __forceinline__ unsigned pkh(float lo, float hi) { h16x2 v; v.x = (_Float16)lo; v.y = (_Float16)hi; return __builtin_bit_cast(unsigned, v); }
__device__ __forceinline__ float fexp2(float x) { return __builtin_amdgcn_exp2f(x); }
__device__ __forceinline__ float fexp(float x) { return __builtin_amdgcn_exp2f(x * 1.4426950408889634f); }
__device__ __forceinline__ float fsigm(float x) { return __builtin_amdgcn_rcpf(1.f + fexp(-x)); }

#define XB_TMO      128
#define XB_XCNT(j)  (256  + 64 * (j))
#define XB_XSUB(j)  (1280 + 64 * (j))
#define XB_XGEN(j)  (2304 + 64 * (j))
#define XB_TOP      3328
#define XB_TOPGEN   3392
#define XCD_BAR_WORDS 3456
#define XB_SPIN_CAP (1u << 18)

__device__ __forceinline__ unsigned xb_ld(unsigned* p)              { return __hip_atomic_load(p, __ATOMIC_RELAXED, __HIP_MEMORY_SCOPE_AGENT); }
__device__ __forceinline__ unsigned xb_add(unsigned* p, unsigned v) { return __hip_atomic_fetch_add(p, v, __ATOMIC_RELAXED, __HIP_MEMORY_SCOPE_AGENT); }
__device__ __forceinline__ unsigned xb_xcc_id() { return (unsigned)__builtin_amdgcn_s_getreg((3 << 11) | 20) & 0xFu; }
#define XB_SPIN(cond, bar) do { unsigned _sp = 0; while (cond) { __builtin_amdgcn_s_sleep(1); \
    if ((++_sp & 255u) == 0u) { if (xb_ld(&(bar)[XB_TMO])) break; if (_sp > XB_SPIN_CAP) { atomicAdd(&(bar)[XB_TMO], 1u); break; } } } } while (0)

struct XcdBarrier {
    unsigned* bar; unsigned x;
    volatile LAS unsigned* st;
};

__device__ __forceinline__ XcdBarrier xcd_barrier_post(unsigned* bar, volatile LAS unsigned* st) {
    XcdBarrier b; b.bar = bar; b.x = xb_xcc_id(); b.st = st;
    if (threadIdx.x == 0) (void)xb_add(&bar[XB_XCNT(b.x)], 1u);
    return b;
}
__device__ __forceinline__ void xcd_barrier_complete(unsigned* bar, unsigned x, unsigned& nloc, unsigned& nx) {
    const unsigned G = gridDim.x * gridDim.y * gridDim.z;
    unsigned sum, cnt, mine, sp = 0u;
    for (;;) {
        sum = 0u; cnt = 0u; mine = 0u;
#pragma unroll
        for (unsigned j = 0; j < 16; ++j) { const unsigned c = xb_ld(&bar[XB_XCNT(j)]); sum += c; cnt += (c > 0u) ? 1u : 0u; mine = (j == x) ? c : mine; }
        if (sum == G) break;
        __builtin_amdgcn_s_sleep(1);
        if ((++sp & 255u) == 0u) { if (xb_ld(&bar[XB_TMO])) break; if (sp > XB_SPIN_CAP) { atomicAdd(&bar[XB_TMO], 1u); break; } }
    }
    nloc = mine > 0u ? mine : 1u; nx = cnt > 0u ? cnt : 1u;
}

__device__ __forceinline__ void xcd_barrier(const XcdBarrier& b) {
    asm volatile("s_waitcnt vmcnt(0)" ::: "memory");
    __syncthreads();
    if (threadIdx.x == 0) {
        unsigned* bar = b.bar;
        __builtin_amdgcn_s_waitcnt(0);
        unsigned nloc = b.st[0], nx = b.st[1];
        if (nloc == 0u) { xcd_barrier_complete(bar, b.x, nloc, nx); b.st[0] = nloc; b.st[1] = nx; }
        const unsigned old = xb_add(&bar[XB_XSUB(b.x)], 1u);
        const unsigned gen = old / nloc;
        if (old + 1u == (gen + 1u) * nloc) {
            __builtin_amdgcn_fence(__ATOMIC_RELEASE, "agent");
            asm volatile("s_waitcnt vmcnt(0)" ::: "memory");
            const unsigned og = xb_add(&bar[XB_TOP], 1u);
            const unsigned tg = og / nx;
            if (og + 1u == (tg + 1u) * nx) xb_add(&bar[XB_TOPGEN], 1u);
            else XB_SPIN(xb_ld(&bar[XB_TOPGEN]) == tg, bar);
            __builtin_amdgcn_fence(__ATOMIC_ACQUIRE, "agent");
            xb_add(&bar[XB_XGEN(b.x)], 1u);
            asm volatile("s_waitcnt vmcnt(0)" ::: "memory");
        } else {
            XB_SPIN(xb_ld(&bar[XB_XGEN(b.x)]) == gen, bar);
            __builtin_amdgcn_fence(__ATOMIC_ACQUIRE, "agent");
            asm volatile("s_waitcnt vmcnt(0)" ::: "memory");
        }
    }
    __syncthreads();
}

template <int CTRL> __device__ __forceinline__ float dppx_f(float v) { return __builtin_bit_cast(float, __builtin_amdgcn_update_dpp(0, __builtin_bit_cast(int, v), CTRL, 0xf, 0xf, true)); }
template <int CTRL> __device__ __forceinline__ float dppo_f(float old, float v) { return __builtin_bit_cast(float, __builtin_amdgcn_update_dpp(__builtin_bit_cast(int, old), __builtin_bit_cast(int, v), CTRL, 0xf, 0xf, false)); }
namespace pg8 {
#define PG8_LAS __attribute__((address_space(3)))
constexpr int BM = 256, BK = 64, HALF = 128, HTB = HALF * BK * 2  , STAGE_BYTES = 8 * HTB, NXCD = 8, WGM = 8;
__host__ __device__ __forceinline__ int lds_byte(int r, int c) { const int st = (r >> 4) * 2 + (c >> 5), rr = r & 15, cc = c & 31, ob = rr * 64 + cc * 2; return st * 1024 + (ob ^ (((ob >> 9) & 1) << 5)); }
__host__ __device__ __forceinline__ void stage_rc(int b, int& R, int& C) { const int st = b / 1024, sb = b % 1024, swz = sb ^ (((sb >> 9) & 1) << 5); R = (st >> 1) * 16 + swz / 64; C = (st & 1) * 32 + (swz % 64) / 2; }
__host__ __device__ __forceinline__ int perm32(int rho) { const int n = rho >> 4, i = rho & 15; return 8 * (i >> 2) + 4 * n + (i & 3); }
struct Unit { int pm, pn; };
struct Gemm { const half_t* A; const half_t* Bt; int M, N, K; int a_step = 256, a_off = 0; };
struct StaticOrder {
    int nM, nN, nwg, G, c;
    __host__ __device__ void init(int M, int N, int G_, int c_) { nM = M / BM; nN = N / BM; nwg = nM * nN; G = G_; c = c_; }
    __host__ __device__ bool next(int i, Unit& u) const {
        const long L = (long)i * G + c; if (L >= nwg) return false;
        int wgid = (int)L; { const int q = nwg / NXCD, r = nwg % NXCD, xcd = wgid % NXCD, off = wgid / NXCD; wgid = (xcd < r ? xcd * (q + 1) : r * (q + 1) + (xcd - r) * q) + off; }
        const int nig = WGM * nN, gid = wgid / nig, fm = gid * WGM, gsz = (nM - fm) < WGM ? (nM - fm) : WGM;
        u.pm = fm + ((wgid % nig) % gsz); u.pn = (wgid % nig) / gsz; return true;
    }
    __device__ __forceinline__ void a_ready(const Unit&) const {}
    __device__ __forceinline__ void done(const Unit&) const {}
};
struct EpiF32 {
    static constexpr bool PERM = false, AFTER_DRAIN = false;
    float* C; int ldc;
    __device__ __forceinline__ void operator()(const f32x4 (&acc)[2][2][4][2], const Unit& u, int wr, int wc, int fr, int fq) const {
        const int row0 = u.pm * BM + wr * 64 + fr, col0 = u.pn * BM + wc * 32 + 4 * fq;
#pragma unroll
        for (int ai = 0; ai < 2; ++ai)
#pragma unroll
            for (int m = 0; m < 4; ++m) { float* rowp = C + (size_t)(row0 + ai * HALF + m * 16) * ldc + col0;
#pragma unroll
                for (int bj = 0; bj < 2; ++bj)
#pragma unroll
                    for (int n = 0; n < 2; ++n) *(f32x4*)(rowp + bj * HALF + n * 16) = acc[ai][bj][m][n]; }
    }
};
template <bool SCALE>
struct EpiH16T {
    static constexpr bool PERM = true, AFTER_DRAIN = false;
    half_t* O; int ldc; const float* rs = nullptr;
    __device__ __forceinline__ void operator()(const f32x4 (&acc)[2][2][4][2], const Unit& u, int wr, int wc, int fr, int fq) const {
        const int row0 = u.pm * BM + wr * 64 + fr, col0 = u.pn * BM + wc * 32 + 8 * fq;
        float sc[2][4];
#pragma unroll
        for (int ai = 0; ai < 2; ++ai)
#pragma unroll
            for (int m = 0; m < 4; ++m) sc[ai][m] = SCALE ? rs[row0 + ai * HALF + m * 16] : 1.f;
#pragma unroll
        for (int ai = 0; ai < 2; ++ai)
#pragma unroll
            for (int m = 0; m < 4; ++m) { half_t* rowp = O + (size_t)(row0 + ai * HALF + m * 16) * ldc + col0;
#pragma unroll
                for (int bj = 0; bj < 2; ++bj) { f32x4 v0 = acc[ai][bj][m][0], v1 = acc[ai][bj][m][1];
                    if (SCALE) { v0 *= sc[ai][m]; v1 *= sc[ai][m]; }
                    u32x4 w; w.x = pkh(v0[0], v0[1]); w.y = pkh(v0[2], v0[3]); w.z = pkh(v1[0], v1[1]); w.w = pkh(v1[2], v1[3]);
                    *(u32x4*)(rowp + bj * HALF) = w; } }
    }
};
using EpiH16 = EpiH16T<false>;
struct EpiConv {
    static constexpr bool PERM = true, AFTER_DRAIN = false;
    half_t* ACT; const float* cw; PG8_LAS float* xb; int Mrows, seq, dff, nup; const float* rs;
    __device__ __forceinline__ void operator()(f32x4 (&acc)[2][2][4][2], const Unit& u, int wr, int wc, int fr, int fq) const {
        int cc0 = wc * 32 + 8 * fq;
        asm volatile("" : "+v"(cc0));
        PG8_LAS float* wl = xb + 2048; PG8_LAS float* rsl = xb + 2048 + 768;
        if (fr >= 14) {
#pragma unroll
            for (int ai = 0; ai < 2; ++ai)
#pragma unroll
                for (int bj = 0; bj < 2; ++bj)
#pragma unroll
                    for (int n = 0; n < 2; ++n) *(PG8_LAS f32x4*)(xb + ((((2 * ai + wr) * 2 + (fr - 14)) * 2 + bj) * 128) + cc0 + 4 * n) = acc[ai][bj][3][n];
        }
        { const int t = (wr * 4 + wc) * 64 + fq * 16 + fr;
          for (int idx = t; idx < 768; idx += 512) { const int j = idx >> 8, col = idx & 255; wl[idx] = cw[(size_t)j * nup + (col >> 7) * dff + 128 * u.pn + (col & 127)]; }
          if (t < 256) { int gr = 254 * u.pm - 2 + t; gr = gr < 0 ? 0 : (gr >= Mrows ? Mrows - 1 : gr); rsl[t] = rs[gr]; } }
        asm volatile("s_waitcnt vmcnt(0) lgkmcnt(0)" ::: "memory"); __builtin_amdgcn_s_barrier(); asm volatile("" ::: "memory");
        const int gr0 = 254 * u.pm - 2;
        const bool hs = ((gr0 + 255) >> 11) != ((gr0 - 2) >> 11);
#pragma unroll
        for (int ai = 0; ai < 2; ++ai) {
            const int pred = 2 * ai + wr - 1;
#pragma unroll
            for (int mm = 0; mm < 4; ++mm) {
                const int m = 3 - mm;
                const int R = 128 * ai + 64 * wr + 16 * m + fr, gr = gr0 + R, ts = gr & (seq - 1);
                if (mm == 0) { const float rc = rsl[R];
#pragma unroll
                    for (int bj = 0; bj < 2; ++bj)
#pragma unroll
                        for (int n = 0; n < 2; ++n) acc[ai][bj][3][n] *= rc; }
                if (m > 0) { const float rp = rsl[R - 16];
#pragma unroll
                    for (int bj = 0; bj < 2; ++bj)
#pragma unroll
                        for (int n = 0; n < 2; ++n) acc[ai][bj][m > 0 ? m - 1 : 0][n] *= rp; }
                float rx0 = 0.f, rx1 = 0.f;
                if (m == 0 && pred >= 0) { rx0 = rsl[64 * pred + 62]; rx1 = rsl[64 * pred + 63]; }
#pragma unroll
                for (int n = 0; n < 2; ++n) {
                    f32x4 cv[2];
#pragma unroll
                    for (int bj = 0; bj < 2; ++bj) {
                        const f32x4 cur = acc[ai][bj][m][n];
                        f32x4 p1, p2;
                        if (m > 0) {
                            const f32x4 pv = acc[ai][bj][m > 0 ? m - 1 : 0][n];
#pragma unroll
                            for (int e = 0; e < 4; ++e) { const float q1 = dppx_f<0x121>(pv[e]), q2 = dppx_f<0x122>(pv[e]);
                                p1[e] = dppo_f<0x111>(q1, cur[e]); p2[e] = dppo_f<0x112>(q2, cur[e]); }
                        } else {
                            f32x4 x0 = (f32x4){0.f, 0.f, 0.f, 0.f}, x1 = x0;
                            if (pred >= 0) { x0 = *(const PG8_LAS f32x4*)(xb + (((pred * 2 + 0) * 2 + bj) * 128) + cc0 + 4 * n); x1 = *(const PG8_LAS f32x4*)(xb + (((pred * 2 + 1) * 2 + bj) * 128) + cc0 + 4 * n); x0 *= rx0; x1 *= rx1; }
#pragma unroll
                            for (int e = 0; e < 4; ++e) { const float o2 = (fr == 0) ? x0[e] : x1[e];
                                p1[e] = dppo_f<0x111>(x1[e], cur[e]); p2[e] = dppo_f<0x112>(o2, cur[e]); }
                        }
                        if (hs) {
#pragma unroll
                            for (int e = 0; e < 4; ++e) { p1[e] = (ts >= 1) ? p1[e] : 0.f; p2[e] = (ts >= 2) ? p2[e] : 0.f; }
                        }
                        const f32x4 w0 = *(const PG8_LAS f32x4*)(wl + 0 * 256 + bj * 128 + cc0 + 4 * n), w1 = *(const PG8_LAS f32x4*)(wl + 1 * 256 + bj * 128 + cc0 + 4 * n), w2 = *(const PG8_LAS f32x4*)(wl + 2 * 256 + bj * 128 + cc0 + 4 * n);
                        cv[bj] = w0 * p2 + w1 * p1 + w2 * cur;
                    }
                    float r_[4];
#pragma unroll
                    for (int e = 0; e < 4; ++e) { const float g_ = cv[0][e]; r_[e] = g_ * __builtin_amdgcn_rcpf(1.f + __builtin_amdgcn_exp2f(-1.4426950408889634f * g_)) * cv[1][e]; }
                    u32x2 o; o.x = pkh(r_[0], r_[1]); o.y = pkh(r_[2], r_[3]);
                    if (R >= 2 && gr < Mrows) *(u32x2*)(ACT + (size_t)gr * dff + 128 * u.pn + cc0 + 4 * n) = o;
                    asm volatile("" ::: "memory"); __builtin_amdgcn_sched_barrier(0);
                }
                asm volatile("" ::: "memory"); __builtin_amdgcn_sched_barrier(0);
            }
        }
    }
};
template <class Epi, class Sched, bool ALIGN_EPI = false, bool SP2 = false>
__device__ __forceinline__ void gemm_phase(PG8_LAS unsigned char* lds, const Gemm g, const Sched& S, const Epi& E) {
    const int tid = threadIdx.x, wid = __builtin_amdgcn_readfirstlane(tid >> 6), lane = tid & 63, wr = wid >> 2, wc = wid & 3, fr = lane & 15, fq = lane >> 4;
    const int K = g.K, nt = K / BK;
    unsigned voffA[2], voffB[2];
#pragma unroll
    for (int i = 0; i < 2; ++i) { int R, C; stage_rc(tid * 16 + i * 8192, R, C); const int Rb = Epi::PERM ? ((R & ~31) + perm32(R & 31)) : R;
        voffA[i] = (unsigned)(R * K + C) * 2u; voffB[i] = (unsigned)(Rb * K + C) * 2u; }
    const size_t kstep = (size_t)(BK * 2);
    const size_t hstep = (size_t)HALF * K * 2;
    const size_t tstep = 2 * hstep;
    const unsigned ldsw = (unsigned)wid * 1024u;
    const int aoff = lds_byte(wr * 64 + fr, fq * 8), boff = lds_byte(wc * 32 + fr, fq * 8);
#define PG8_SA(b, h) (((b) * 2 + (h)) * HTB)
#define PG8_SB(b, h) ((4 + (b) * 2 + (h)) * HTB)
#define PG8_STAGE(bufoff, gbase, voff) do { _Pragma("unroll") for (int _i = 0; _i < 2; ++_i) \
        __builtin_amdgcn_global_load_lds((const unsigned*)((const char*)(gbase) + (voff)[_i]), (PG8_LAS unsigned*)(lds + (bufoff) + ldsw + _i * 8192), 16, 0, 0); } while (0)
#define PG8_LDA(dst, b, h) do { _Pragma("unroll") for (int m = 0; m < 4; ++m) _Pragma("unroll") for (int k = 0; k < 2; ++k) dst[m][k] = *(const PG8_LAS h16x8*)(lds + PG8_SA(b, h) + aoff + m * 2048 + k * 1024); } while (0)
#define PG8_LDB(dst, b, h) do { _Pragma("unroll") for (int n = 0; n < 2; ++n) _Pragma("unroll") for (int k = 0; k < 2; ++k) dst[n][k] = *(const PG8_LAS h16x8*)(lds + PG8_SB(b, h) + boff + n * 2048 + k * 1024); } while (0)
#define PG8_MMA(ai, bj, At, Bt) do { __builtin_amdgcn_s_setprio(1); _Pragma("unroll") for (int m = 0; m < 4; ++m) _Pragma("unroll") for (int n = 0; n < 2; ++n) _Pragma("unroll") for (int k = 0; k < 2; ++k) \
        acc[ai][bj][m][n] = __builtin_amdgcn_mfma_f32_16x16x32_f16(Bt[n][k], At[m][k], acc[ai][bj][m][n], 0, 0, 0); __builtin_amdgcn_s_setprio(0); } while (0)
#define PG8_WAIT_V(n) asm volatile("s_waitcnt vmcnt(" #n ")" ::: "memory")
#define PG8_WAIT_L(n) asm volatile("s_waitcnt lgkmcnt(" #n ")" ::: "memory")
#define PG8_BAR __builtin_amdgcn_s_barrier()
#define PG8_SCHED __builtin_amdgcn_sched_barrier(0)
    Unit cur, nxt; int ui = 0;
    if (!S.next(0, cur)) return;
    f32x4 acc[2][2][4][2];
#pragma unroll
    for (int a = 0; a < 2; ++a)
#pragma unroll
        for (int b = 0; b < 2; ++b)
#pragma unroll
            for (int m = 0; m < 4; ++m)
#pragma unroll
                for (int n = 0; n < 2; ++n) acc[a][b][m][n] = (f32x4){0.f, 0.f, 0.f, 0.f};
    h16x8 At[4][2], B0[2][2], B1[2][2];
    const long arow_bytes = (long)K * 2; const char* cA = (const char*)g.A + ((long)cur.pm * g.a_step + g.a_off) * arow_bytes; const char* cB = (const char*)g.Bt + (size_t)cur.pn * tstep;
    S.a_ready(cur);
    if constexpr (SP2) {
        PG8_STAGE(PG8_SB(0, 0), cB, voffB); PG8_STAGE(PG8_SB(0, 1), cB + hstep, voffB); PG8_STAGE(PG8_SA(0, 0), cA, voffA); PG8_STAGE(PG8_SA(0, 1), cA + hstep, voffA);
        if (wr == 1) PG8_BAR;
        PG8_WAIT_V(2); PG8_BAR;
        PG8_STAGE(PG8_SB(1, 0), cB + kstep, voffB); PG8_STAGE(PG8_SA(1, 0), cA + kstep, voffA); PG8_STAGE(PG8_SB(1, 1), cB + hstep + kstep, voffB);
        PG8_WAIT_V(6); PG8_BAR;
    } else {
        PG8_STAGE(PG8_SB(0, 0), cB, voffB); PG8_STAGE(PG8_SA(0, 0), cA, voffA); PG8_STAGE(PG8_SB(0, 1), cB + hstep, voffB); PG8_STAGE(PG8_SA(0, 1), cA + hstep, voffA);
        if (wr == 1) PG8_BAR;
        PG8_WAIT_V(4); PG8_BAR;
        PG8_STAGE(PG8_SB(1, 0), cB + kstep, voffB); PG8_STAGE(PG8_SA(1, 0), cA + kstep, voffA); PG8_STAGE(PG8_SB(1, 1), cB + hstep + kstep, voffB);
        PG8_WAIT_V(6); PG8_BAR;
    }
    for (;;) {
        const bool has_next = S.next(ui + 1, nxt);
        const char* nA = has_next ? (const char*)g.A + ((long)nxt.pm * g.a_step + g.a_off) * arow_bytes : cA; const char* nB = has_next ? (const char*)g.Bt + (size_t)nxt.pn * tstep : cB;
        for (int t = 0; t < nt; t += 2) {
            const bool last = (t == nt - 2);
            const char* a1 = cA + (size_t)(t + 1) * kstep;
            const char* a2 = last ? nA : cA + (size_t)(t + 2) * kstep; const char* b2 = last ? nB : cB + (size_t)(t + 2) * kstep;
            const char* a3 = a2 + kstep; const char* b3 = b2 + kstep;
            if (last && has_next) S.a_ready(nxt);
            if constexpr (SP2) {
            PG8_LDB(B0, 0, 0); PG8_LDB(B1, 0, 1); PG8_SCHED; PG8_LDA(At, 0, 0); PG8_STAGE(PG8_SA(1, 1), a1 + hstep, voffA);
            PG8_WAIT_V(8); PG8_WAIT_L(0); PG8_BAR; PG8_MMA(0, 0, At, B0); PG8_MMA(0, 1, At, B1); PG8_BAR; PG8_SCHED;
            PG8_LDA(At, 0, 1); PG8_STAGE(PG8_SB(0, 0), b2, voffB); PG8_STAGE(PG8_SB(0, 1), b2 + hstep, voffB); PG8_STAGE(PG8_SA(0, 0), a2, voffA);
            PG8_WAIT_V(8); PG8_WAIT_L(0); PG8_BAR; PG8_MMA(1, 0, At, B0); PG8_MMA(1, 1, At, B1); PG8_BAR; PG8_SCHED;
            PG8_LDB(B0, 1, 0); PG8_LDB(B1, 1, 1); PG8_SCHED; PG8_LDA(At, 1, 0); PG8_STAGE(PG8_SA(0, 1), a2 + hstep, voffA);
            PG8_WAIT_V(8); PG8_WAIT_L(0); PG8_BAR; PG8_MMA(0, 0, At, B0); PG8_MMA(0, 1, At, B1); PG8_BAR; PG8_SCHED;
            PG8_LDA(At, 1, 1); PG8_STAGE(PG8_SB(1, 0), b3, voffB); PG8_STAGE(PG8_SB(1, 1), b3 + hstep, voffB); PG8_STAGE(PG8_SA(1, 0), a3, voffA);
            PG8_WAIT_V(8); PG8_WAIT_L(0); PG8_BAR; PG8_MMA(1, 0, At, B0); PG8_MMA(1, 1, At, B1); PG8_BAR; PG8_SCHED;
            } else {
            PG8_LDB(B0, 0, 0); PG8_SCHED; PG8_LDA(At, 0, 0); PG8_STAGE(PG8_SA(1, 1), a1 + hstep, voffA);
            PG8_WAIT_L(8); PG8_BAR; PG8_WAIT_L(0); PG8_MMA(0, 0, At, B0); PG8_BAR; PG8_SCHED;
            PG8_LDB(B1, 0, 1); PG8_STAGE(PG8_SB(0, 0), b2, voffB);
            PG8_BAR; PG8_WAIT_L(0); PG8_MMA(0, 1, At, B1); PG8_BAR;
            PG8_LDA(At, 0, 1); PG8_STAGE(PG8_SA(0, 0), a2, voffA);
            PG8_BAR; PG8_WAIT_L(0); PG8_MMA(1, 0, At, B0); PG8_BAR; PG8_SCHED;
            PG8_STAGE(PG8_SB(0, 1), b2 + hstep, voffB);
            PG8_WAIT_V(6); PG8_BAR; PG8_MMA(1, 1, At, B1); PG8_BAR;
            PG8_LDB(B0, 1, 0); PG8_SCHED; PG8_LDA(At, 1, 0); PG8_STAGE(PG8_SA(0, 1), a2 + hstep, voffA);
            PG8_WAIT_L(8); PG8_BAR; PG8_WAIT_L(0); PG8_MMA(0, 0, At, B0); PG8_BAR; PG8_SCHED;
            PG8_LDB(B1, 1, 1); PG8_STAGE(PG8_SB(1, 0), b3, voffB);
            PG8_BAR; PG8_WAIT_L(0); PG8_MMA(0, 1, At, B1); PG8_BAR;
            PG8_LDA(At, 1, 1); PG8_STAGE(PG8_SA(1, 0), a3, voffA);
            PG8_BAR; PG8_WAIT_L(0); PG8_MMA(1, 0, At, B0); PG8_BAR; PG8_SCHED;
            PG8_STAGE(PG8_SB(1, 1), b3 + hstep, voffB);
            PG8_WAIT_V(6); PG8_BAR; PG8_MMA(1, 1, At, B1); PG8_BAR;
            }
        }
        if constexpr (ALIGN_EPI) { if (wr == 0) PG8_BAR; }
        if constexpr (!Epi::AFTER_DRAIN) { E(acc, cur, wr, wc, fr, fq); S.done(cur); }
#if defined(PROBE_MASK) && ((PROBE_MASK >> 11) & 1)
        if constexpr (!Epi::AFTER_DRAIN) { asm volatile("" ::: "memory"); E(acc, cur, wr, wc, fr, fq); }
#endif
        if (!has_next) break;
#pragma unroll
        for (int a = 0; a < 2; ++a)
#pragma unroll
            for (int b = 0; b < 2; ++b)
#pragma unroll
                for (int m = 0; m < 4; ++m)
#pragma unroll
                    for (int n = 0; n < 2; ++n) acc[a][b][m][n] = (f32x4){0.f, 0.f, 0.f, 0.f};
        cur = nxt; cA = nA; cB = nB; ++ui;
        if constexpr (ALIGN_EPI) { if (wr == 1) PG8_BAR; }
    }
    PG8_WAIT_V(0);
    if constexpr (!ALIGN_EPI) { if (wr == 0) PG8_BAR; }
    PG8_BAR;
    if constexpr (Epi::AFTER_DRAIN) { E.fused(acc, cur, wr, wc, fr, fq, lds, wid, lane); S.done(cur); }
#undef PG8_SA
#undef PG8_SB
#undef PG8_STAGE
#undef PG8_LDA
#undef PG8_LDB
#undef PG8_MMA
#undef PG8_WAIT_V
#undef PG8_WAIT_L
#undef PG8_BAR
#undef PG8_SCHED
}
}

namespace fp {
using namespace cfg;
constexpr int NW = 8, NTH = 512;
constexpr int RING_BYTES = 131072, MISC_OFF = RING_BYTES, LDS_BYTES = 147456;
constexpr size_t MiB = 1u << 20;
constexpr size_t WS_CTL = 0, CTL_BYTES = 1 * MiB;
constexpr size_t WS_WIN0 = 1 * MiB, WS_WIN1 = WS_WIN0 + 12 * MiB, WS_WIN2 = WS_WIN1 + 24 * MiB, WS_WIN3 = WS_WIN2 + 32 * MiB;
constexpr size_t WS_WOUT = WS_WIN3 + 17 * MiB, WOUT_STRIDE = 8 * MiB;
constexpr size_t WS_WUP = WS_WOUT + 32 * MiB, WUP_STRIDE = 44 * MiB;
constexpr size_t WS_WDN = WS_WUP + 176 * MiB, WDN_STRIDE = 22 * MiB;
constexpr size_t WS_H = WS_WDN + 88 * MiB;
constexpr size_t WS_ZU = WS_H + 32 * MiB;
constexpr size_t WS_O = WS_ZU + 176 * MiB;
constexpr size_t WS_MF = WS_O + 32 * MiB;
constexpr size_t WS_ACT = WS_MF + 64 * MiB;
constexpr size_t WS_MBITS = WS_ACT + 64 * MiB;
constexpr size_t WS_HUT = WS_ACT;
constexpr size_t WS_HDEC = WS_ACT + 64 * MiB;
constexpr size_t WS_KW = WS_MBITS + 2 * MiB;
constexpr int DSA_MAIN = 4096, KW_LD = 96;
constexpr size_t WS_X16 = WS_ACT + 88 * MiB;
constexpr size_t WS_FAST_END = WS_X16 + 32 * MiB;
static_assert(WS_WIN0 + (size_t)SWA_IN * D * 2 == WS_WIN1 && WS_WIN1 + (size_t)DIFF_IN * D * 2 == WS_WIN2 && WS_WIN2 + (size_t)HGRN_IN * D * 2 == WS_WIN3 && WS_WIN3 + (size_t)DSA_PAD * D * 2 == WS_WOUT, "weights map");
static_assert((size_t)NUP * D * 2 == WUP_STRIDE && (size_t)DFF * D * 2 == WDN_STRIDE && (size_t)M * NUP * 2 == 176 * MiB && (size_t)M * DFF * 2 == 88 * MiB, "map sizes");
constexpr size_t WS_RS = WS_CTL + 512 * 1024;
constexpr int CW_TMO = 0, CW_BAR = 4096, CW_CK = 16384;

#define LDS_BARRIER() do { asm volatile("s_waitcnt lgkmcnt(0)" ::: "memory"); __builtin_amdgcn_s_barrier(); asm volatile("" ::: "memory"); } while (0)
struct Params {
    const float* in[19];
    float* out;
    unsigned char* ws;
    int ph_lo, ph_hi;
};
struct Ctx {
    LAS unsigned char* lds;
    int tid, lane, wave, vcu, G;
};

template <int CTRL> __device__ __forceinline__ float dpp_f(float v) { return __builtin_bit_cast(float, __builtin_amdgcn_update_dpp(0, __builtin_bit_cast(int, v), CTRL, 0xf, 0xf, true)); }
template <int CTRL> __device__ __forceinline__ int dpp_i(int v) { return __builtin_amdgcn_update_dpp(0, v, CTRL, 0xf, 0xf, true); }
__device__ __forceinline__ float rsum16(float v) { v += dpp_f<0xB1>(v); v += dpp_f<0x4E>(v); v += dpp_f<0x141>(v); v += dpp_f<0x140>(v); return v; }
__device__ __forceinline__ int rsum16i(int v) { v += dpp_i<0xB1>(v); v += dpp_i<0x4E>(v); v += dpp_i<0x141>(v); v += dpp_i<0x140>(v); return v; }
__device__ __forceinline__ float wsum64(float v) {
    const int iv = __builtin_bit_cast(int, rsum16(v));
    return (__builtin_bit_cast(float, __builtin_amdgcn_readlane(iv, 0)) + __builtin_bit_cast(float, __builtin_amdgcn_readlane(iv, 16))) +
           (__builtin_bit_cast(float, __builtin_amdgcn_readlane(iv, 32)) + __builtin_bit_cast(float, __builtin_amdgcn_readlane(iv, 48)));
}
__device__ __forceinline__ int wsum64i(int v) { v = rsum16i(v); return (__builtin_amdgcn_readlane(v, 0) + __builtin_amdgcn_readlane(v, 16)) + (__builtin_amdgcn_readlane(v, 32) + __builtin_amdgcn_readlane(v, 48)); }
__device__ __forceinline__ float sum16(float v) { v += __shfl_xor(v, 1); v += __shfl_xor(v, 2); v += __shfl_xor(v, 4); v += __shfl_xor(v, 8); return v; }
__device__ __forceinline__ float max16(float v) { v = fmaxf(v, __shfl_xor(v, 1)); v = fmaxf(v, __shfl_xor(v, 2)); v = fmaxf(v, __shfl_xor(v, 4)); v = fmaxf(v, __shfl_xor(v, 8)); return v; }

struct TTile { const float* W; half_t* WT; const float* gk; int K, N, item, ntn, mapup; };
__device__ __forceinline__ void tt_load(const Ctx& c, const TTile& a, f32x4 (&v)[8]) {
    const int kb = a.item / a.ntn, nb = a.item % a.ntn, k0 = 64 * kb, n = 256 * nb + 4 * c.lane;
#pragma unroll
    for (int i = 0; i < 8; ++i) v[i] = (n < a.N) ? *(const f32x4*)(a.W + (size_t)(k0 + 8 * c.wave + i) * a.N + n) : (f32x4){0.f, 0.f, 0.f, 0.f};
}
__device__ __forceinline__ void tt_finish(const Ctx& c, const TTile& a, f32x4 (&v)[8]) {
    const int kb = a.item / a.ntn, nb = a.item % a.ntn, k0 = 64 * kb, n0 = 256 * nb, lane = c.lane, w = c.wave;
    LAS half_t* T = (LAS half_t*)c.lds;
    if (a.gk) {
#pragma unroll
        for (int i = 0; i < 8; ++i) v[i] *= a.gk[k0 + 8 * w + i];
    }
#pragma unroll
    for (int e = 0; e < 4; ++e) { u32x4 o; o.x = pkh(v[0][e], v[1][e]); o.y = pkh(v[2][e], v[3][e]); o.z = pkh(v[4][e], v[5][e]); o.w = pkh(v[6][e], v[7][e]);
        *(LAS u32x4*)(T + (4 * lane + e) * 72 + 8 * w) = o; }
    LDS_BARRIER();
#pragma unroll
    for (int i = 0; i < 4; ++i) { const int id = c.tid + NTH * i, row = id >> 3, ch = id & 7;
        const u32x4 o = *(const LAS u32x4*)(T + row * 72 + 8 * ch);
        int drow = n0 + row;
        if (a.mapup) { const int nn = drow < DFF ? drow : drow - DFF; drow = 256 * (nn >> 7) + (nn & 127) + (drow < DFF ? 0 : 128); }
        *(u32x4*)(a.WT + (size_t)drow * a.K + k0 + 8 * ch) = o; }
    LDS_BARRIER();
}
__device__ __forceinline__ void transpose_tile(const Ctx& c, const TTile& a) { f32x4 v[8]; tt_load(c, a, v); tt_finish(c, a, v); }
__device__ __forceinline__ void norm_row_first(const float* __restrict__ xrow, half_t* __restrict__ xout, float* __restrict__ rs, int lane) {
    f32x4 v[8]; float ss = 0.f;
#pragma unroll
    for (int j = 0; j < 8; ++j) { v[j] = *(const f32x4*)(xrow + 4 * lane + 256 * j); ss += (v[j].x * v[j].x + v[j].y * v[j].y) + (v[j].z * v[j].z + v[j].w * v[j].w); }
    const float r = rsqrtf(wsum64(ss) * (1.f / D) + RMS_EPS);
    if (lane == 0) *rs = r;
#pragma unroll
    for (int j = 0; j < 8; ++j) { u32x2 xo; xo.x = pkh(v[j].x, v[j].y); xo.y = pkh(v[j].z, v[j].w); *(u32x2*)(xout + 4 * lane + 256 * j) = xo; }
}
constexpr int I_UP = 32 * (NUP / 256), I_DN = (DFF / 64) * (D / 256), FFN_TILES = I_UP + I_DN;
__device__ __forceinline__ TTile ffn_tile_desc(const Params& p, int l, int t) {
    unsigned char* ws = p.ws;
    if (t < I_UP) return TTile{p.in[4] + (size_t)l * D * NUP, (half_t*)(ws + WS_WUP + l * WUP_STRIDE), p.in[3] + (size_t)(4 * l + 2) * D, D, NUP, t, NUP / 256, 1};
    return TTile{p.in[6] + (size_t)l * DFF * D, (half_t*)(ws + WS_WDN + l * WDN_STRIDE), nullptr, DFF, D, t - I_UP, D / 256, 0};
}
__device__ __forceinline__ void ffn_weight_tile(const Ctx& c, const Params& p, int l, int t) { transpose_tile(c, ffn_tile_desc(p, l, t)); }
constexpr int DEFER_PER_WG = 10, DEFER_G1 = 128 * DEFER_PER_WG, DEFER_G3 = 84 * DEFER_PER_WG;
static_assert(DEFER_G1 + DEFER_G3 >= FFN_TILES, "layer 1's FFN weights fit the two spare slots");
__device__ __forceinline__ void spare_slot_convert(const Ctx& c, const Params& p, int l, int first, int last, int rank) {
    for (int i = 0; i < DEFER_PER_WG; ++i) { const int t = first + rank * DEFER_PER_WG + i; if (t < last) ffn_weight_tile(c, p, l, t); }
}
__device__ __forceinline__ TTile prologue_item(const Params& p, int it) {
    constexpr int I_W0 = 32 * (SWA_IN / 256), I_W1 = 32 * (DIFF_IN / 256), I_W2 = 32 * (HGRN_IN / 256), I_W3 = 32 * (DSA_PAD / 256), I_WO = 32 * (D / 256);
    constexpr int I_F23 = FFN_TILES - DEFER_G3;
    unsigned char* ws = p.ws; const float* ng = p.in[3];
    int r = it;
    if (r < I_W0) return TTile{p.in[7], (half_t*)(ws + WS_WIN0), ng, D, SWA_IN, r, SWA_IN / 256, 0}; r -= I_W0;
    if (r < I_W1) return TTile{p.in[10], (half_t*)(ws + WS_WIN1), ng + 4 * D, D, DIFF_IN, r, DIFF_IN / 256, 0}; r -= I_W1;
    if (r < I_W2) return TTile{p.in[14], (half_t*)(ws + WS_WIN2), ng + 8 * D, D, HGRN_IN, r, HGRN_IN / 256, 0}; r -= I_W2;
    if (r < I_W3) return TTile{p.in[17], (half_t*)(ws + WS_WIN3), ng + 12 * D, D, DSA_IN, r, DSA_PAD / 256, 0}; r -= I_W3;
    if (r < 4 * I_WO) { const int l = r / I_WO; r -= l * I_WO; const float* src = l == 0 ? p.in[8] : l == 1 ? p.in[11] : l == 2 ? p.in[15] : p.in[18];
        return TTile{src, (half_t*)(ws + WS_WOUT + l * WOUT_STRIDE), nullptr, D, D, r, D / 256, 0}; } r -= 4 * I_WO;
    if (r < FFN_TILES) return ffn_tile_desc(p, 0, r); r -= FFN_TILES;
    if (r < I_F23) return ffn_tile_desc(p, 2, DEFER_G3 + r); r -= I_F23;
    if (r < I_F23) return ffn_tile_desc(p, 3, DEFER_G3 + r); r -= I_F23;
    if (r < FFN_TILES) return ffn_tile_desc(p, 1, r); r -= FFN_TILES;
    if (r < DEFER_G3) return ffn_tile_desc(p, 2, r); r -= DEFER_G3;
    return ffn_tile_desc(p, 3, r);
}
__device__ __forceinline__ void prologue_phase(const Ctx& c, const Params& p) {
    const int gw = c.vcu * NW + c.wave, NGW = c.G * NW;
    unsigned char* ws = p.ws;
    constexpr int I_W0 = 32 * (SWA_IN / 256), I_W1 = 32 * (DIFF_IN / 256), I_W2 = 32 * (HGRN_IN / 256), I_W3 = 32 * (DSA_PAD / 256), I_WO = 32 * (D / 256);
    constexpr int I_F23 = FFN_TILES - DEFER_G3;
    constexpr int NITEMS = I_W0 + I_W1 + I_W2 + I_W3 + 4 * I_WO + FFN_TILES + 2 * I_F23;
    const bool defer = (c.G == 256);
    const int nitems = defer ? NITEMS : NITEMS + FFN_TILES + 2 * DEFER_G3;
    {
        f32x4 va[8], vb[8]; TTile ta, tb;
        int it = c.vcu;
        if (it < nitems) { ta = prologue_item(p, it); tt_load(c, ta, va); }
        while (it < nitems) {
            const int i1 = it + c.G;
            if (i1 < nitems) { tb = prologue_item(p, i1); tt_load(c, tb, vb); }
            tt_finish(c, ta, va);
            if (i1 >= nitems) break;
            const int i2 = i1 + c.G;
            if (i2 < nitems) { ta = prologue_item(p, i2); tt_load(c, ta, va); }
            tt_finish(c, tb, vb);
            it = i2;
        }
    }
    const float* x = p.in[0];
    for (int m = gw; m < M; m += NGW) norm_row_first(x + (size_t)m * D, (half_t*)(ws + WS_X16) + (size_t)m * D, (float*)(ws + WS_RS) + m, c.lane);
}

__device__ __forceinline__ void resnorm_phase(const Ctx& c, half_t* __restrict__ X, const half_t* __restrict__ MF, const float* __restrict__ g1, float* __restrict__ RS, float* __restrict__ out32) {
    const int gw = c.vcu * NW + c.wave, NGW = c.G * NW, lane = c.lane;
    for (int m = gw; m < M; m += NGW) {
        const half_t* mf = MF + (size_t)m * D; half_t* xr = X + (size_t)m * D;
        f32x4 v[8]; h16x4 xh[8]; float ss = 0.f;
#pragma unroll
        for (int j = 0; j < 8; ++j) { const h16x4 hv = *(const h16x4*)(mf + 4 * lane + 256 * j); xh[j] = *(const h16x4*)(xr + 4 * lane + 256 * j); v[j] = (f32x4){(float)hv[0], (float)hv[1], (float)hv[2], (float)hv[3]};
            ss += (v[j].x * v[j].x + v[j].y * v[j].y) + (v[j].z * v[j].z + v[j].w * v[j].w); }
        const float r1 = rsqrtf(wsum64(ss) * (1.f / D) + RMS_EPS);
        float s2 = 0.f;
#pragma unroll
        for (int j = 0; j < 8; ++j) { const f32x4 gg = *(const f32x4*)(g1 + 4 * lane + 256 * j); const f32x4 xx = (f32x4){(float)xh[j][0], (float)xh[j][1], (float)xh[j][2], (float)xh[j][3]};
            v[j] = xx + v[j] * r1 * gg; s2 += (v[j].x * v[j].x + v[j].y * v[j].y) + (v[j].z * v[j].z + v[j].w * v[j].w);
            if (out32) *(f32x4*)(out32 + (size_t)m * D + 4 * lane + 256 * j) = v[j];
            else { u32x2 xo; xo.x = pkh(v[j].x, v[j].y); xo.y = pkh(v[j].z, v[j].w); *(u32x2*)(xr + 4 * lane + 256 * j) = xo; } }
        if (RS) { const float r2 = rsqrtf(wsum64(s2) * (1.f / D) + RMS_EPS); if (lane == 0) RS[m] = r2; }
    }
}
__device__ __forceinline__ void convact_phase(const Ctx& c, const half_t* __restrict__ U, const float* __restrict__ cw, half_t* __restrict__ ACT) {
    const int gw = c.vcu * NW + c.wave, NGW = c.G * NW, lane = c.lane;
    constexpr int NCC = DFF / 512, NRB = M / 16;
    for (int it = gw; it < NCC * NRB; it += NGW) {
        const int cc = it % NCC, rb = it / NCC, c0 = cc * 512 + lane * 8, r0 = rb * 16, t0 = r0 % S;
        float wg[3][8], wv[3][8];
#pragma unroll
        for (int j = 0; j < 3; ++j) {
            const f32x4 a0 = *(const f32x4*)(cw + j * NUP + c0), a1 = *(const f32x4*)(cw + j * NUP + c0 + 4);
            const f32x4 b0 = *(const f32x4*)(cw + j * NUP + DFF + c0), b1 = *(const f32x4*)(cw + j * NUP + DFF + c0 + 4);
#pragma unroll
            for (int e = 0; e < 4; ++e) { wg[j][e] = a0[e]; wg[j][4 + e] = a1[e]; wv[j][e] = b0[e]; wv[j][4 + e] = b1[e]; }
        }
        float g2[8], g1[8], v2[8], v1[8];
        if (t0 == 0) {
#pragma unroll
            for (int e = 0; e < 8; ++e) { g2[e] = 0.f; g1[e] = 0.f; v2[e] = 0.f; v1[e] = 0.f; }
        } else {
            const h16x8 a = *(const h16x8*)(U + (size_t)(r0 - 2) * NUP + c0), b = *(const h16x8*)(U + (size_t)(r0 - 1) * NUP + c0);
            const h16x8 cgv = *(const h16x8*)(U + (size_t)(r0 - 2) * NUP + DFF + c0), d = *(const h16x8*)(U + (size_t)(r0 - 1) * NUP + DFF + c0);
#pragma unroll
            for (int e = 0; e < 8; ++e) { g2[e] = (float)a[e]; g1[e] = (float)b[e]; v2[e] = (float)cgv[e]; v1[e] = (float)d[e]; }
        }
        for (int r = r0; r < r0 + 16; ++r) {
            const h16x8 gc = *(const h16x8*)(U + (size_t)r * NUP + c0), vc = *(const h16x8*)(U + (size_t)r * NUP + DFF + c0);
            float o[8];
#pragma unroll
            for (int e = 0; e < 8; ++e) {
                const float gcur = (float)gc[e], vcur = (float)vc[e];
                const float gg = wg[0][e] * g2[e] + wg[1][e] * g1[e] + wg[2][e] * gcur;
                const float vv = wv[0][e] * v2[e] + wv[1][e] * v1[e] + wv[2][e] * vcur;
                o[e] = gg * fsigm(gg) * vv;
                g2[e] = g1[e]; g1[e] = gcur; v2[e] = v1[e]; v1[e] = vcur;
            }
            u32x4 w; w.x = pkh(o[0], o[1]); w.y = pkh(o[2], o[3]); w.z = pkh(o[4], o[5]); w.w = pkh(o[6], o[7]);
            *(u32x4*)(ACT + (size_t)r * DFF + c0) = w;
        }
    }
}
__device__ __forceinline__ void hgrn_normgate_phase(const Ctx& c, const float* __restrict__ OR, const half_t* __restrict__ Z, const float* __restrict__ ng, half_t* __restrict__ O) {
    const int gw = c.vcu * NW + c.wave, NGW = c.G * NW, lane = c.lane;
    const f32x4 gn = *(const f32x4*)(ng + ((4 * lane) & 127));
    for (int m = gw; m < M; m += NGW) {
        const float* orow = OR + (size_t)m * D; const half_t* grow = Z + (size_t)m * HGRN_IN + 6144; half_t* out = O + (size_t)m * D;
        f32x4 v[8]; h16x4 gt[8];
#pragma unroll
        for (int j = 0; j < 8; ++j) { v[j] = *(const f32x4*)(orow + 4 * lane + 256 * j); gt[j] = *(const h16x4*)(grow + 4 * lane + 256 * j); }
#pragma unroll
        for (int j = 0; j < 8; ++j) {
            const int col = 4 * lane + 256 * j;
            float ss = (v[j].x * v[j].x + v[j].y * v[j].y) + (v[j].z * v[j].z + v[j].w * v[j].w);
            ss = rsum16(ss); ss += __shfl_xor(ss, 16);
            const float r = rsqrtf(ss * (1.f / 128.f) + RMS_EPS);
            float o[4];
#pragma unroll
            for (int e = 0; e < 4; ++e) { const float gv = (float)gt[j][e]; o[e] = v[j][e] * r * gn[e] * (gv * fsigm(gv)); }
            u32x2 w; w.x = pkh(o[0], o[1]); w.y = pkh(o[2], o[3]);
            *(u32x2*)(out + col) = w;
        }
    }
}

typedef float f32x16 __attribute__((ext_vector_type(16)));
#define MFMA32(a, b, c) __builtin_amdgcn_mfma_f32_32x32x16_f16((a), (b), (c), 0, 0, 0)
constexpr float LOG2E = 1.4426950408889634f, C2 = 0.125f * LOG2E, ATT_THR = 8.0f, NEGBIG = -1e30f;
__device__ __forceinline__ int crow(int r, int hi) { return (r & 3) + 8 * (r >> 2) + 4 * hi; }
__device__ __forceinline__ float xhalf_max(float m) { auto rr = __builtin_amdgcn_permlane32_swap(__float_as_uint(m), __float_as_uint(m), false, false); return fmaxf(__uint_as_float(rr[0]), __uint_as_float(rr[1])); }
__device__ __forceinline__ float xhalf_sum(float m) { auto rr = __builtin_amdgcn_permlane32_swap(__float_as_uint(m), __float_as_uint(m), false, false); return __uint_as_float(rr[0]) + __uint_as_float(rr[1]); }

typedef short v4i16_t __attribute__((ext_vector_type(4)));
template <int NDB, bool NEAR, int AM, bool SWZ = false>
__device__ __forceinline__ void attn_tile(const LAS half_t* Kt, const LAS half_t* Vr, const h16x8 (&qf)[4], float& mhat, float& lsum, f32x16 (&o)[NDB],
                                          LAS float* wsf, const LAS float* bd2, int qrel, unsigned mw0, unsigned mw1, int r32, int hi, bool start) {
    f32x16 pp[2];
    constexpr bool UPFRONT = (NDB == 2);
    if (UPFRONT) {
        const int KRS = SWZ ? 64 : 72, sw = SWZ ? ((r32 >> 1) & 7) : 0;
        const LAS half_t* kp = Kt + r32 * KRS;
        const f32x16 z = {0.f, 0.f, 0.f, 0.f, 0.f, 0.f, 0.f, 0.f, 0.f, 0.f, 0.f, 0.f, 0.f, 0.f, 0.f, 0.f};
        pp[0] = MFMA32(*(const LAS h16x8*)(kp + ((hi ^ sw) * 8)), qf[0], z); pp[1] = MFMA32(*(const LAS h16x8*)(kp + 32 * KRS + ((hi ^ sw) * 8)), qf[0], z);
#pragma unroll
        for (int ks = 1; ks < 4; ++ks) { pp[0] = MFMA32(*(const LAS h16x8*)(kp + (((2 * ks + hi) ^ sw) * 8)), qf[ks], pp[0]); pp[1] = MFMA32(*(const LAS h16x8*)(kp + 32 * KRS + (((2 * ks + hi) ^ sw) * 8)), qf[ks], pp[1]); }
#if defined(PROBE_MASK) && ((PROBE_MASK >> 13) & 1)
        { f32x16 t0 = z, t1 = z;
#pragma unroll
          for (int ks = 0; ks < 4; ++ks) { t0 = MFMA32(*(const LAS h16x8*)(kp + 16 * ks), qf[ks], t0); t1 = MFMA32(*(const LAS h16x8*)(kp + 32 * 72 + 16 * ks), qf[ks], t1); }
#pragma unroll
          for (int r = 0; r < 16; ++r) { pp[0][r] = 0.5f * (pp[0][r] + t0[r]); pp[1][r] = 0.5f * (pp[1][r] + t1[r]); } }
#endif
    }
#pragma unroll
    for (int blk = 0; blk < 2; ++blk) {
        f32x16 p;
        if (UPFRONT) p = pp[blk];
        else if (!SWZ) {
            const LAS half_t* kp = Kt + (32 * blk + r32) * 72 + 8 * hi;
            const f32x16 z = {0.f, 0.f, 0.f, 0.f, 0.f, 0.f, 0.f, 0.f, 0.f, 0.f, 0.f, 0.f, 0.f, 0.f, 0.f, 0.f};
            p = MFMA32(*(const LAS h16x8*)(kp), qf[0], z);
#pragma unroll
            for (int ks = 1; ks < 4; ++ks) p = MFMA32(*(const LAS h16x8*)(kp + 16 * ks), qf[ks], p);
        } else {
            const LAS half_t* kp = Kt + (32 * blk + r32) * 64; const int sw = (r32 >> 1) & 7;
            const f32x16 z = {0.f, 0.f, 0.f, 0.f, 0.f, 0.f, 0.f, 0.f, 0.f, 0.f, 0.f, 0.f, 0.f, 0.f, 0.f, 0.f};
            p = MFMA32(*(const LAS h16x8*)(kp + ((hi ^ sw) * 8)), qf[0], z);
#pragma unroll
            for (int ks = 1; ks < 4; ++ks) p = MFMA32(*(const LAS h16x8*)(kp + (((2 * ks + hi) ^ sw) * 8)), qf[ks], p);
        }
#pragma unroll
        for (int r = 0; r < 16; ++r) p[r] = fmaf(p[r], C2, -mhat);
        if (NEAR) {
#pragma unroll
            for (int r = 0; r < 16; ++r) {
                const int d0 = qrel - 32 * blk - ((r & 3) + 8 * (r >> 2));
                const int i0 = d0 < 0 ? 0 : (d0 > 128 ? 128 : d0);
                const bool ok0 = (AM == 0) ? (d0 >= 0 && d0 < 128) : (d0 >= 0);
                p[r] = ok0 ? p[r] + bd2[i0] : NEGBIG;
                if (NDB > 2 && (r & 7) == 7) asm volatile("" ::: "memory");
            }
        }
        if (AM == 1) {
            const unsigned ws = (blk == 0 ? mw0 : mw1) >> (4 * hi);
#pragma unroll
            for (int r = 0; r < 16; ++r) { const unsigned bit = 1u << ((r & 3) + 8 * (r >> 2)); p[r] = (ws & bit) ? p[r] : NEGBIG; }
        }
        float rm;
        { const float a0 = fmaxf(fmaxf(p[0], p[1]), fmaxf(p[2], p[3])), a1 = fmaxf(fmaxf(p[4], p[5]), fmaxf(p[6], p[7])), a2 = fmaxf(fmaxf(p[8], p[9]), fmaxf(p[10], p[11])), a3 = fmaxf(fmaxf(p[12], p[13]), fmaxf(p[14], p[15]));
          rm = fmaxf(fmaxf(a0, a1), fmaxf(a2, a3)); }
        rm = xhalf_max(rm);
        if (start && blk == 0) {
            const float dl = (rm > -1e29f) ? rm : 0.f; mhat += dl;
#pragma unroll
            for (int r = 0; r < 16; ++r) p[r] -= dl;
        } else if (__any(rm > ATT_THR)) {
            const float dl = (rm > ATT_THR) ? rm : 0.f; mhat += dl;
#pragma unroll
            for (int r = 0; r < 16; ++r) p[r] -= dl;
            const float f = fexp2(-dl); lsum *= f;
            if (hi == 0) wsf[r32] = f;
#pragma unroll
            for (int r = 0; r < 16; ++r) { const float fr_ = wsf[crow(r, hi)];
#pragma unroll
                for (int d = 0; d < NDB; ++d) o[d][r] *= fr_;
                if (NDB > 2 && (r & 3) == 3) asm volatile("" ::: "memory"); }
        }
#if defined(PROBE_MASK) && ((PROBE_MASK >> 14) & 1)
#pragma unroll
        for (int r = 0; r < 16; ++r) { float t_ = fexp2(p[r] - 40.f); asm volatile("" : "+v"(t_)); p[r] += t_ * 1e-30f; }
#endif
#pragma unroll
        for (int r = 0; r < 16; ++r) p[r] = fexp2(p[r]);
        lsum += ((p[0] + p[1]) + (p[2] + p[3])) + ((p[4] + p[5]) + (p[6] + p[7])) + (((p[8] + p[9]) + (p[10] + p[11])) + ((p[12] + p[13]) + (p[14] + p[15])));
        u32x4 pw[2];
        pw[0] = (u32x4){pkh(p[0], p[1]), pkh(p[2], p[3]), pkh(p[4], p[5]), pkh(p[6], p[7])};
        pw[1] = (u32x4){pkh(p[8], p[9]), pkh(p[10], p[11]), pkh(p[12], p[13]), pkh(p[14], p[15])};
        constexpr int VSTR = SWZ ? 32 * NDB : 32 * NDB + 32;
        const int j4 = (r32 & 15) >> 2, vsw = (NDB == 4) ? j4 : (j4 >> 1);
        const LAS half_t* vb = SWZ ? Vr + (32 * blk + 4 * hi + j4) * VSTR + 4 * (r32 & 1)
                                   : Vr + (32 * blk + 4 * hi + j4) * VSTR + 16 * (r32 >> 4) + 4 * (r32 & 3);
#pragma unroll
        for (int d = 0; d < NDB; ++d) {
            const int vco = SWZ ? ((((d ^ vsw) << 2) | (2 * (r32 >> 4)) | ((r32 & 3) >> 1)) * 8) : 32 * d;
#pragma unroll
            for (int s2 = 0; s2 < 2; ++s2) {
                const v4i16_t lo = __builtin_amdgcn_ds_read_tr16_b64_v4i16((LAS v4i16_t*)(vb + (16 * s2) * VSTR + vco));
                const v4i16_t hi2 = __builtin_amdgcn_ds_read_tr16_b64_v4i16((LAS v4i16_t*)(vb + (16 * s2 + 8) * VSTR + vco));
                typedef short s16x8 __attribute__((ext_vector_type(8)));
                const s16x8 vv = (s16x8){lo[0], lo[1], lo[2], lo[3], hi2[0], hi2[1], hi2[2], hi2[3]};
                o[d] = MFMA32(__builtin_bit_cast(h16x8, pw[s2]), __builtin_bit_cast(h16x8, vv), o[d]);
            }
            if (NDB > 2 && (d & 1)) asm volatile("" ::: "memory");
        }
    }
}

template <int AM>
__device__ __forceinline__ void gqa_phase(const Ctx& c, const half_t* __restrict__ Z, int ldz, int koff, int voff, const float* __restrict__ bias, const float* __restrict__ sinks,
                                          const unsigned* __restrict__ mbits, half_t* __restrict__ O) {
    const int tid = c.tid, lane = c.lane, w = c.wave, r32 = lane & 31, hi = lane >> 5;
    constexpr int VS = 96;
    LAS half_t* Kb = (LAS half_t*)c.lds;
    LAS half_t* Vb = Kb + 2 * 64 * 72;
    constexpr int GQA_TILE_BYTES = (2 * 64 * 72 + 2 * 64 * VS) * 2;
    LAS float* wsf = (LAS float*)(c.lds + GQA_TILE_BYTES) + w * 64;
    LAS float* btab = (LAS float*)(c.lds + GQA_TILE_BYTES + 8 * 64 * 4);
    for (int i = tid; i < 32 * 129; i += NTH) { const int h = i / 129, d = i % 129; const int bk = d < 128 ? (int)BUCKET_LUT[d] : 31; btab[h * 132 + d] = (bias[bk * 32 + h] - bias[31 * 32 + h]) * LOG2E; }
    const int skey = tid >> 3, sch = tid & 7;
    for (int U = c.vcu; U < 1024; U += c.G) {
        const int grp = U & 255, ui = U >> 8, bkv = grp >> 3, sx = grp & 7;
        const int qb = (ui == 0) ? sx : (ui == 1) ? 15 - sx : (ui == 2) ? 16 + sx : 31 - sx;
        const int b = bkv >> 3, kvh = bkv & 7, h = kvh * 4 + (w >> 1);
        const int qw0 = qb * 64 + 32 * (w & 1), q = qw0 + r32;
        const size_t rowbase = (size_t)b * S;
        h16x8 qf[4];
#pragma unroll
        for (int ks = 0; ks < 4; ++ks) qf[ks] = *(const h16x8*)(Z + (rowbase + q) * ldz + h * 64 + 16 * ks + 8 * hi);
        float mhat = 0.f, lsum = 0.f;
        if (AM == 0) { mhat = (sinks[h] - bias[31 * 32 + h]) * LOG2E; lsum = (hi == 0) ? 1.f : 0.f; }
        f32x16 o[2];
#pragma unroll
        for (int d = 0; d < 2; ++d)
#pragma unroll
            for (int r = 0; r < 16; ++r) o[d][r] = 0.f;
        const int kt_lo = (AM == 0) ? (qb >= 2 ? qb - 2 : 0) : 0;
        const LAS float* bt = btab + h * 132;
        const half_t* sbase = Z + (rowbase + skey) * ldz + kvh * 64 + sch * 8;
        const unsigned* mrow = mbits + (rowbase + q) * 64;
        u32x4 kreg = *(const u32x4*)(sbase + (size_t)(64 * kt_lo) * ldz + koff);
        h16x8 vreg = *(const h16x8*)(sbase + (size_t)(64 * kt_lo) * ldz + voff);
        u32x2 mnext = (u32x2){0xffffffffu, 0xffffffffu};
        if (AM == 1) mnext = *(const u32x2*)(mrow + 2 * kt_lo);
        LDS_BARRIER();
        {
            *(LAS u32x4*)(Kb + skey * 72 + sch * 8) = kreg;
            *(LAS h16x8*)(Vb + skey * VS + sch * 8) = vreg;
        }
        if (kt_lo < qb) { kreg = *(const u32x4*)(sbase + (size_t)(64 * (kt_lo + 1)) * ldz + koff); vreg = *(const h16x8*)(sbase + (size_t)(64 * (kt_lo + 1)) * ldz + voff); }
        LDS_BARRIER();
        for (int kt = kt_lo; kt <= qb; ++kt) {
            const int cur = (kt - kt_lo) & 1;
            const u32x2 mcur = mnext;
            if (kt < qb) {
                LAS half_t* Kn = Kb + (cur ^ 1) * (64 * 72); LAS half_t* Vn = Vb + (cur ^ 1) * (64 * VS);
                *(LAS u32x4*)(Kn + skey * 72 + sch * 8) = kreg;
                *(LAS h16x8*)(Vn + skey * VS + sch * 8) = vreg;
                if (AM == 1) mnext = *(const u32x2*)(mrow + 2 * (kt + 1));
                if (kt + 1 < qb) { kreg = *(const u32x4*)(sbase + (size_t)(64 * (kt + 2)) * ldz + koff); vreg = *(const h16x8*)(sbase + (size_t)(64 * (kt + 2)) * ldz + voff); }
            }
            const LAS half_t* Kt = Kb + cur * (64 * 72); const LAS half_t* Vt = Vb + cur * (64 * VS);
            const int qrel = q - 64 * kt - 4 * hi;
            const bool start = (AM == 1) && (kt == kt_lo);
            const bool near = (AM == 0) || (64 * kt + 191 > qw0);
            if (near) attn_tile<2, true, AM>(Kt, Vt, qf, mhat, lsum, o, wsf, bt, qrel, mcur.x, mcur.y, r32, hi, start);
            else attn_tile<2, false, AM>(Kt, Vt, qf, mhat, lsum, o, wsf, bt, qrel, mcur.x, mcur.y, r32, hi, start);
            LDS_BARRIER();
#if defined(PROBE_MASK) && ((PROBE_MASK >> 12) & 1)
            LDS_BARRIER(); LDS_BARRIER();
#endif
        }
        {
            const float lt = xhalf_sum(lsum);
            if (hi == 0) wsf[r32] = 1.f / lt;
            float inv[16];
#pragma unroll
            for (int r = 0; r < 16; ++r) inv[r] = wsf[crow(r, hi)];
#pragma unroll
            for (int r = 0; r < 16; ++r) {
                half_t* op = O + (rowbase + qw0 + crow(r, hi)) * D + h * 64 + r32;
                op[0] = (half_t)(o[0][r] * inv[r]); op[32] = (half_t)(o[1][r] * inv[r]);
            }
        }
    }
    LDS_BARRIER();
}

__device__ __forceinline__ void diff_phase(const Ctx& c, const half_t* __restrict__ Z, const float* __restrict__ bias, const float* __restrict__ lambdas, const float* __restrict__ subg,
                                           float lam_init, half_t* __restrict__ O) {
    const int tid = c.tid, lane = c.lane, w = c.wave, r32 = lane & 31, hi = lane >> 5;
    constexpr int ldz = DIFF_IN;
    constexpr int KIMG = 64 * 64, VIMG = 64 * 128, BUF_H = 2 * KIMG + VIMG;
    LAS half_t* ring = (LAS half_t*)c.lds;
    constexpr int TILE_BYTES = 3 * BUF_H * 2;
    LAS float* cb = (LAS float*)c.lds;
    static_assert(128 * 132 * 4 <= TILE_BYTES, "combine buffer");
    LAS float* wsf = (LAS float*)(c.lds + TILE_BYTES) + w * 64;
    LAS float* btab = (LAS float*)(c.lds + TILE_BYTES + 8 * 64 * 4);
    static_assert(TILE_BYTES + 8 * 64 * 4 + 32 * 132 * 4 <= RING_BYTES, "diff LDS");
    for (int i = tid; i < 32 * 129; i += NTH) { const int h = i / 129, d = i % 129; const int bk = d < 128 ? (int)BUCKET_LUT[d] : 31; btab[h * 132 + d] = (bias[bk * 32 + h] - bias[31 * 32 + h]) * LOG2E; }
    float lam;
    { float l1 = lambdas[lane] * lambdas[64 + lane], l2 = lambdas[128 + lane] * lambdas[192 + lane]; l1 = wsum64(l1); l2 = wsum64(l2); lam = expf(l1) - expf(l2) + lam_init; }
    const int mp = w & 1, rg = w >> 1;
    const int kkey = 8 * w + (lane >> 3), kch = (lane & 7) ^ ((kkey >> 1) & 7);
    const int vkey0 = 8 * w + (lane >> 4), vkey1 = vkey0 + 4, vch0 = (lane & 15) ^ (4 * (vkey0 & 3)), vch1 = (lane & 15) ^ (4 * (vkey1 & 3));
    for (int U = c.vcu; U < 1024; U += c.G) {
        const int grp = U & 255, ui = U >> 8, bh = grp >> 2, sx = grp & 3;
        const int qb = (ui == 0) ? sx : (ui == 1) ? 7 - sx : (ui == 2) ? 8 + sx : 15 - sx;
        const int b = bh >> 4, hd = bh & 15;
        const int qw0 = qb * 128 + 32 * rg, q = qw0 + r32;
        const size_t rowbase = (size_t)b * S;
        h16x8 qf[4];
#pragma unroll
        for (int ks = 0; ks < 4; ++ks) qf[ks] = *(const h16x8*)(Z + (rowbase + q) * ldz + hd * 128 + mp * 64 + 16 * ks + 8 * hi);
        float mhat = 0.f, lsum = 0.f;
        f32x16 o[4];
#pragma unroll
        for (int d = 0; d < 4; ++d)
#pragma unroll
            for (int r = 0; r < 16; ++r) o[d][r] = 0.f;
        const LAS float* bt = btab + (hd * 2 + mp) * 132;
        const int kt_hi = 2 * qb + 1;
        const half_t* gk = Z + (rowbase + kkey) * ldz + 2048 + hd * 128 + kch * 8;
        const half_t* gv0 = Z + (rowbase + vkey0) * ldz + 4096 + hd * 128 + vch0 * 8;
        const half_t* gv1 = Z + (rowbase + vkey1) * ldz + 4096 + hd * 128 + vch1 * 8;
#define DIFF_DMA(t, si) do { const size_t adv = (size_t)(64 * (t)) * ldz; LAS half_t* slot = ring + (si) * BUF_H; \
            __builtin_amdgcn_global_load_lds((const unsigned*)(gk + adv), (LAS unsigned*)(slot + w * 512), 16, 0, 0); \
            __builtin_amdgcn_global_load_lds((const unsigned*)(gk + adv + 64), (LAS unsigned*)(slot + KIMG + w * 512), 16, 0, 0); \
            __builtin_amdgcn_global_load_lds((const unsigned*)(gv0 + adv), (LAS unsigned*)(slot + 2 * KIMG + w * 1024), 16, 0, 0); \
            __builtin_amdgcn_global_load_lds((const unsigned*)(gv1 + adv), (LAS unsigned*)(slot + 2 * KIMG + w * 1024 + 512), 16, 0, 0); } while (0)
        LDS_BARRIER();
        DIFF_DMA(0, 0);
        DIFF_DMA(1, 1);
        asm volatile("s_waitcnt vmcnt(4)" ::: "memory");
        LDS_BARRIER();
        int s_cur = 0, s_nn = 2;
#pragma unroll 1
        for (int kt = 0; kt <= kt_hi; ++kt) {
            if (kt + 2 <= kt_hi) DIFF_DMA(kt + 2, s_nn);
            if (64 * kt <= qw0 + 31) {
                const LAS half_t* slot = ring + s_cur * BUF_H;
                const LAS half_t* Kt = slot + mp * KIMG; const LAS half_t* Vt = slot + 2 * KIMG;
                const int qrel = q - 64 * kt - 4 * hi;
                if (64 * kt + 191 > qw0) attn_tile<4, true, 2, true>(Kt, Vt, qf, mhat, lsum, o, wsf, bt, qrel, 0u, 0u, r32, hi, kt == 0);
                else attn_tile<4, false, 2, true>(Kt, Vt, qf, mhat, lsum, o, wsf, bt, qrel, 0u, 0u, r32, hi, kt == 0);
            }
            if (kt + 2 <= kt_hi) asm volatile("s_waitcnt vmcnt(4)" ::: "memory"); else asm volatile("s_waitcnt vmcnt(0)" ::: "memory");
            LDS_BARRIER();
            s_cur = (s_cur == 2) ? 0 : s_cur + 1; s_nn = (s_nn == 2) ? 0 : s_nn + 1;
        }
#undef DIFF_DMA
        {
            const float lt = xhalf_sum(lsum);
            if (hi == 0) wsf[r32] = 1.f / lt;
            float inv[16];
#pragma unroll
            for (int r = 0; r < 16; ++r) inv[r] = wsf[crow(r, hi)];
            if (mp == 1) {
#pragma unroll
                for (int d = 0; d < 4; ++d)
#pragma unroll
                    for (int r = 0; r < 16; ++r) cb[(32 * rg + crow(r, hi)) * 132 + 32 * d + r32] = o[d][r] * inv[r];
            }
            LDS_BARRIER();
            if (mp == 0) {
#pragma unroll
                for (int d = 0; d < 4; ++d)
#pragma unroll
                    for (int r = 0; r < 16; ++r) { LAS float* pc = cb + (32 * rg + crow(r, hi)) * 132 + 32 * d + r32; *pc = o[d][r] * inv[r] - lam * (*pc); }
            }
            LDS_BARRIER();
            const int qq = tid >> 2, q4 = tid & 3;
            f32x4 v[8]; float ss = 0.f;
#pragma unroll
            for (int i = 0; i < 8; ++i) { v[i] = *(const LAS f32x4*)(cb + qq * 132 + 32 * q4 + 4 * i); ss += (v[i].x * v[i].x + v[i].y * v[i].y) + (v[i].z * v[i].z + v[i].w * v[i].w); }
            ss += dpp_f<0xB1>(ss); ss += dpp_f<0x4E>(ss);
            const float rn = rsqrtf(ss * (1.f / 128.f) + RMS_EPS) * (1.f - lam_init);
            half_t* op = O + (rowbase + qb * 128 + qq) * D + hd * 128 + 32 * q4;
#pragma unroll
            for (int i = 0; i < 4; ++i) {
                const f32x4 g0 = *(const f32x4*)(subg + 32 * q4 + 8 * i), g1 = *(const f32x4*)(subg + 32 * q4 + 8 * i + 4);
                const f32x4 a = v[2 * i] * rn * g0, bq = v[2 * i + 1] * rn * g1;
                u32x4 wv; wv.x = pkh(a.x, a.y); wv.y = pkh(a.z, a.w); wv.z = pkh(bq.x, bq.y); wv.w = pkh(bq.z, bq.w);
                *(u32x4*)(op + 8 * i) = wv;
            }
        }
    }
    LDS_BARRIER();
}

__device__ __forceinline__ void dsa_kiwi_phase(const Ctx& c, const half_t* __restrict__ H, const float* __restrict__ RS, const half_t* __restrict__ W3, half_t* __restrict__ KW) {
    const int tid = c.tid, lane = c.lane, w = c.wave, fr = lane & 15, fq = lane >> 4;
    LAS float* red = (LAS float*)c.lds;
    for (int it = c.vcu; it < M / 32; it += c.G) {
        const int row0 = 32 * it;
        f32x4 acc[2][5];
#pragma unroll
        for (int mt = 0; mt < 2; ++mt)
#pragma unroll
            for (int nt = 0; nt < 5; ++nt) acc[mt][nt] = (f32x4){0.f, 0.f, 0.f, 0.f};
#pragma unroll 2
        for (int ks = 8 * w; ks < 8 * w + 8; ++ks) {
            h16x8 a[2];
#pragma unroll
            for (int mt = 0; mt < 2; ++mt) a[mt] = *(const h16x8*)(H + (size_t)(row0 + 16 * mt + fr) * D + 32 * ks + 8 * fq);
#pragma unroll
            for (int nt = 0; nt < 5; ++nt) { const h16x8 bw = *(const h16x8*)(W3 + (size_t)(DSA_MAIN + 16 * nt + fr) * D + 32 * ks + 8 * fq);
#pragma unroll
                for (int mt = 0; mt < 2; ++mt) acc[mt][nt] = MFMA16(a[mt], bw, acc[mt][nt]); }
        }
        LDS_BARRIER();
#pragma unroll
        for (int mt = 0; mt < 2; ++mt)
#pragma unroll
            for (int nt = 0; nt < 5; ++nt) *(LAS f32x4*)(red + ((w * 10 + mt * 5 + nt) * 64 + lane) * 4) = acc[mt][nt];
        LDS_BARRIER();
#pragma unroll
        for (int j = 0; j < 5; ++j) {
            const int idx = tid + NTH * j, t = idx >> 8, e = idx & 255;
            float s = 0.f;
#pragma unroll
            for (int w2 = 0; w2 < 8; ++w2) s += red[(w2 * 10 + t) * 256 + e];
            const int mt = t / 5, nt = t % 5, l2 = e >> 2, r = e & 3;
            const int row = row0 + 16 * mt + 4 * (l2 >> 4) + r;
            KW[(size_t)row * KW_LD + 16 * nt + (l2 & 15)] = (half_t)(s * RS[row]);
        }
    }
    LDS_BARRIER();
}

__device__ __forceinline__ void dsa_score_phase(const Ctx& c, const half_t* __restrict__ Z, const half_t* __restrict__ KW, float* __restrict__ SC) {
    const int lane = c.lane, w = c.wave, fr = lane & 15, fq = lane >> 4;
    constexpr int ldz = DSA_MAIN;
    for (int U = c.vcu; U < 512; U += c.G) {
        const int grp = U & 255, ui = U >> 8, b = grp >> 6, sx = grp & 63;
        const int qblk = (ui == 0) ? sx : 127 - sx;
        const int q0 = 16 * qblk, ng = (qblk >> 3) + 1;
        const size_t rowbase = (size_t)b * S;
        const half_t* kp = KW + (rowbase + 16 * w + fr) * KW_LD + 8 * fq;
        h16x8 k0 = *(const h16x8*)kp, k1 = *(const h16x8*)(kp + 32);
        h16x8 qf[16][2];
        { const half_t* qp = Z + (rowbase + q0 + fr) * ldz + 3072 + 8 * fq;
#pragma unroll
          for (int h = 0; h < 16; ++h)
#pragma unroll
              for (int ks = 0; ks < 2; ++ks) qf[h][ks] = *(const h16x8*)(qp + 64 * h + 32 * ks); }
        float wq[16];
        { const h16x8 w0 = *(const h16x8*)(KW + (rowbase + q0 + fr) * KW_LD + 64), w1 = *(const h16x8*)(KW + (rowbase + q0 + fr) * KW_LD + 72);
#pragma unroll
          for (int e = 0; e < 8; ++e) { wq[e] = (float)w0[e] * (1.f / 32.f); wq[8 + e] = (float)w1[e] * (1.f / 32.f); } }
        float* sp = SC + (rowbase + q0 + fr) * S + 16 * w + 4 * fq;
        __builtin_amdgcn_s_waitcnt(0x0F70);
#pragma unroll 1
        for (int g = 0; g < ng; ++g) {
            h16x8 n0 = k0, n1 = k1;
            if (g + 1 < ng) { n0 = *(const h16x8*)(kp + (size_t)(g + 1) * 128 * KW_LD); n1 = *(const h16x8*)(kp + (size_t)(g + 1) * 128 * KW_LD + 32); }
            f32x4 acc = (f32x4){0.f, 0.f, 0.f, 0.f};
#pragma unroll
            for (int h = 0; h < 16; ++h) {
                const f32x4 t = MFMA16(k1, qf[h][1], MFMA16(k0, qf[h][0], ((f32x4){0.f, 0.f, 0.f, 0.f})));
#pragma unroll
                for (int r = 0; r < 4; ++r) acc[r] += wq[h] * fmaxf(t[r], 0.f);
            }
            *(f32x4*)(sp + 128 * g) = acc;
            k0 = n0; k1 = n1;
        }
    }
}
__device__ __forceinline__ void dsa_select_phase(const Ctx& c, const float* __restrict__ SC, unsigned* __restrict__ mbits) {
    const int gw = c.vcu * NW + c.wave, NGW = c.G * NW, lane = c.lane;
    for (int R = gw; R < M; R += NGW) {
        const int q = R % S; const float* sp = SC + (size_t)R * S;
        unsigned key[32];
#pragma unroll
        for (int j = 0; j < 32; ++j) { const int s = lane + 64 * j; unsigned k = 0u;
            if (s <= q) { const unsigned u = __float_as_uint(sp[s]); k = (u & 0x80000000u) ? ~u : (u | 0x80000000u); }
            key[j] = k; }
        unsigned T = 0u;
        if (q + 1 > TOPK) {
            for (int bit = 31; bit >= 0; --bit) {
                const unsigned cand = T | (1u << bit); int cnt = 0;
#pragma unroll
                for (int j = 0; j < 32; ++j) cnt += (key[j] >= cand) ? 1 : 0;
                const int tot = wsum64i(cnt);
                if (tot >= TOPK) T = cand;
                if (tot == TOPK) break;
            }
        }
        unsigned* mp = mbits + (size_t)R * 64;
#pragma unroll
        for (int j = 0; j < 32; ++j) { const int s = lane + 64 * j; const unsigned long long bm = __ballot(key[j] >= T && s <= q);
            if (lane == 0) { mp[2 * j] = (unsigned)bm; mp[2 * j + 1] = (unsigned)(bm >> 32); } }
    }
}

__device__ __forceinline__ void hgrn_scan_phase(const Ctx& c, const half_t* __restrict__ Z, const float* __restrict__ lb_logits, float* __restrict__ OR) {
    const int tid = c.tid, lane = c.lane, w = c.wave, fr = lane & 15, fq = lane >> 4;
    constexpr int ldz = HGRN_IN;
    LAS float* QD = (LAS float*)c.lds;
    LAS half_t* QS = (LAS half_t*)(c.lds + 33792);
    LAS half_t* KS = QS + 64 * 136;
    LAS half_t* Vt = KS + 64 * 136;
    LAS half_t* At = Vt + 32 * 72;
    LAS half_t* St = At + 64 * 72;
    LAS float* Tot = (LAS float*)(St + 32 * 136);
    LAS float* TE = Tot + 4 * 128;
    LAS float* TF = TE + 4 * 128;
    LAS float* TD = TF + 4 * 128;
    LAS float* TDEC = TD + 3 * 128;
    const int k = tid & 127, tq = tid >> 7;
    for (int U = c.vcu; U < 256; U += c.G) {
        const int b = U >> 6, hd = (U >> 2) & 15, vs = U & 3;
        float lb;
        { const int ch = hd * 128 + k; const float a0 = lb_logits[ch], a1 = lb_logits[2048 + ch], a2 = lb_logits[4096 + ch], a3 = lb_logits[6144 + ch];
          const float mm = fmaxf(fmaxf(a0, a1), fmaxf(a2, a3)); const float e0 = expf(a0 - mm), e1 = expf(a1 - mm), e2 = expf(a2 - mm), e3 = expf(a3 - mm);
          lb = (e1 + e2) / (e0 + e1 + e2 + e3); }
        LDS_BARRIER();
        for (int i = tid; i < 64 * 72; i += NTH) At[i] = (half_t)0.f;
        for (int i = tid; i < 32 * 136; i += NTH) St[i] = (half_t)0.f;
        f32x4 sacc[2]; sacc[0] = (f32x4){0.f, 0.f, 0.f, 0.f}; sacc[1] = (f32x4){0.f, 0.f, 0.f, 0.f};
        u32x4 qv_[2], zv_[2]; h16x4 vraw;
        const half_t* zp0 = Z + ((size_t)b * S + (tid >> 4)) * ldz + hd * 128 + (tid & 15) * 8;
        const half_t* vp0 = Z + ((size_t)b * S + (tid >> 3)) * ldz + 4096 + hd * 128 + vs * 32 + (tid & 7) * 4;
#define HG_LOAD(ck_) do { const half_t* zp = zp0 + (size_t)(64 * (ck_)) * ldz; \
            qv_[0] = *(const u32x4*)(zp); zv_[0] = *(const u32x4*)(zp + 2048); qv_[1] = *(const u32x4*)(zp + (size_t)32 * ldz); zv_[1] = *(const u32x4*)(zp + (size_t)32 * ldz + 2048); \
            vraw = *(const h16x4*)(vp0 + (size_t)(64 * (ck_)) * ldz); } while (0)
#define HG_SB() do { asm volatile("" ::: "memory"); __builtin_amdgcn_sched_barrier(0); } while (0)
        HG_LOAD(0);
        for (int ck = 0; ck < S / 64; ++ck) {
            const size_t row0 = (size_t)b * S + 64 * ck;
            LDS_BARRIER();
            {
                const int t = tid >> 4, k8 = (tid & 15) * 8;
                *(LAS u32x4*)(QS + t * 136 + k8) = qv_[0]; *(LAS u32x4*)(KS + t * 136 + k8) = zv_[0];
                *(LAS u32x4*)(QS + (t + 32) * 136 + k8) = qv_[1]; *(LAS u32x4*)(KS + (t + 32) * 136 + k8) = zv_[1];
                const int tv = tid >> 3, v4 = (tid & 7) * 4;
#pragma unroll
                for (int j = 0; j < 4; ++j) Vt[(v4 + j) * 72 + tv] = vraw[j];
                if (ck + 1 < S / 64) HG_LOAD(ck + 1);
            }
            LDS_BARRIER();
            {
                float fv[16]; float prod = 1.f;
#pragma unroll
                for (int tt = 0; tt < 16; ++tt) { const float sg = fsigm((float)KS[(16 * tq + tt) * 136 + k]); fv[tt] = lb + (1.f - lb) * sg; prod *= fv[tt]; }
                prod = fmaxf(prod, 1e-30f);
                Tot[tq * 128 + k] = __logf(prod);
                LDS_BARRIER();
                const float t0 = Tot[k], t1 = Tot[128 + k], t2 = Tot[256 + k], t3 = Tot[384 + k];
                const float be1 = t0, be2 = t0 + t1, be3 = be2 + t2, be4 = be3 + t3;
                if (tq == 0) { TE[k] = 1.f; TE[128 + k] = fexp(be1); TE[256 + k] = fexp(be2); TE[384 + k] = fexp(be3); }
                else if (tq == 1) { TF[k] = fexp(be4 - be1); TF[128 + k] = fexp(be4 - be2); TF[256 + k] = fexp(be4 - be3); TF[384 + k] = 1.f; }
                else if (tq == 2) { TD[k] = fexp(be2 - be1); TD[128 + k] = fexp(be3 - be1); TD[256 + k] = fexp(be3 - be2); }
                else TDEC[k] = fexp(be4);
                const float ip16 = __builtin_amdgcn_rcpf(prod);
                float P = 1.f;
#pragma unroll
                for (int tt = 0; tt < 16; ++tt) {
                    const float qv = (float)QS[(16 * tq + tt) * 136 + k];
                    P = fmaxf(P * fv[tt], 1e-30f);
                    const float qp = qv * fsigm(qv), ky = 1.f - fv[tt];
                    const int t = 16 * tq + tt;
                    const float qsv = qp * P;
                    QS[t * 136 + k] = (half_t)qsv;
                    QD[t * 132 + k] = qsv * ip16;
                    KS[t * 136 + k] = (half_t)(ky * prod * __builtin_amdgcn_rcpf(P));
                    if ((tt & 3) == 3) HG_SB();
                }
            }
            LDS_BARRIER();
            if (w < 4) {
                const int I = w;
                f32x4 acc = (f32x4){0.f, 0.f, 0.f, 0.f}, acc2 = acc;
#pragma unroll 2
                for (int m = 0; m < 8; m += 2) {
                    const int k0 = 16 * m + 4 * fq;
                    const f32x4 qd = *(const LAS f32x4*)(QD + (16 * I + fr) * 132 + k0), qd2 = *(const LAS f32x4*)(QD + (16 * I + fr) * 132 + k0 + 16);
                    const h16x4 kv = *(const LAS h16x4*)(KS + (16 * I + fr) * 136 + k0), kv2 = *(const LAS h16x4*)(KS + (16 * I + fr) * 136 + k0 + 16);
#pragma unroll
                    for (int e = 0; e < 4; ++e) { acc = __builtin_amdgcn_mfma_f32_16x16x4f32(qd[e], (float)kv[e], acc, 0, 0, 0);
                                                  acc2 = __builtin_amdgcn_mfma_f32_16x16x4f32(qd2[e], (float)kv2[e], acc2, 0, 0, 0); }
                }
#pragma unroll
                for (int r = 0; r < 4; ++r) { const int tl = 4 * fq + r; At[(16 * I + tl) * 72 + 16 * I + fr] = (half_t)((fr <= tl) ? (acc[r] + acc2[r]) : 0.f); }
            } else {
                const int nb = (w < 6) ? 2 : 1;
                for (int bi = 0; bi < nb; ++bi) {
                    const int I = (w == 4) ? (bi == 0 ? 1 : 3) : (w == 5) ? (bi == 0 ? 2 : 3) : (w == 6) ? 3 : 2;
                    const int J = (w == 4) ? (bi == 0 ? 0 : 1) : (w == 5) ? (bi == 0 ? 1 : 0) : (w == 6) ? 2 : 0;
                    const int dsel = (I == 2) ? 0 : (J == 0 ? 1 : 2);
                    f32x4 acc = (f32x4){0.f, 0.f, 0.f, 0.f};
#pragma unroll
                    for (int ks = 0; ks < 4; ++ks) {
                        const int k0 = 32 * ks + 8 * fq;
                        h16x8 a = *(const LAS h16x8*)(QS + (16 * I + fr) * 136 + k0);
                        const h16x8 bb = *(const LAS h16x8*)(KS + (16 * J + fr) * 136 + k0);
                        if (I - J >= 2) {
                            const f32x4 d0 = *(const LAS f32x4*)(TD + dsel * 128 + k0), d1 = *(const LAS f32x4*)(TD + dsel * 128 + k0 + 4);
#pragma unroll
                            for (int j = 0; j < 4; ++j) { a[j] = (half_t)((float)a[j] * d0[j]); a[4 + j] = (half_t)((float)a[4 + j] * d1[j]); }
                        }
                        acc = MFMA16(a, bb, acc);
                    }
#pragma unroll
                    for (int r = 0; r < 4; ++r) At[(16 * I + 4 * fq + r) * 72 + 16 * J + fr] = (half_t)acc[r];
                }
            }
            const int mt = w - 4;
            f32x4 oacc[2]; oacc[0] = (f32x4){0.f, 0.f, 0.f, 0.f}; oacc[1] = oacc[0];
            if (w >= 4) {
#pragma unroll
                for (int ks = 0; ks < 4; ++ks) {
                    h16x8 a = *(const LAS h16x8*)(QS + (16 * mt + fr) * 136 + 32 * ks + 8 * fq);
                    if (mt > 0) {
                        const f32x4 e0 = *(const LAS f32x4*)(TE + mt * 128 + 32 * ks + 8 * fq), e1 = *(const LAS f32x4*)(TE + mt * 128 + 32 * ks + 8 * fq + 4);
#pragma unroll
                        for (int j = 0; j < 4; ++j) { a[j] = (half_t)((float)a[j] * e0[j]); a[4 + j] = (half_t)((float)a[4 + j] * e1[j]); }
                    }
#pragma unroll
                    for (int nt = 0; nt < 2; ++nt) { const h16x8 sb = *(const LAS h16x8*)(St + (16 * nt + fr) * 136 + 32 * ks + 8 * fq); oacc[nt] = MFMA16(a, sb, oacc[nt]); }
                }
            }
            LDS_BARRIER();
            if (w >= 4) {
#pragma unroll
                for (int ks = 0; ks < 2; ++ks) {
                    const h16x8 a = *(const LAS h16x8*)(At + (16 * mt + fr) * 72 + 32 * ks + 8 * fq);
#pragma unroll
                    for (int nt = 0; nt < 2; ++nt) { const h16x8 vb = *(const LAS h16x8*)(Vt + (16 * nt + fr) * 72 + 32 * ks + 8 * fq); oacc[nt] = MFMA16(a, vb, oacc[nt]); }
                }
#pragma unroll
                for (int nt = 0; nt < 2; ++nt)
#pragma unroll
                    for (int r = 0; r < 4; ++r) OR[(row0 + 16 * mt + 4 * fq + r) * D + hd * 128 + vs * 32 + 16 * nt + fr] = oacc[nt][r];
            }
            {
#pragma unroll
                for (int r = 0; r < 4; ++r) { const float dec = TDEC[16 * w + 4 * fq + r]; sacc[0][r] *= dec; sacc[1][r] *= dec; }
                const int kr = 16 * w + fr;
#pragma unroll
                for (int ks = 0; ks < 2; ++ks) {
                    const float fj = TF[(2 * ks + (fq >> 1)) * 128 + kr];
                    h16x8 a;
#pragma unroll
                    for (int j = 0; j < 8; ++j) { const int s2 = 32 * ks + 8 * fq + j; a[j] = (half_t)((float)KS[s2 * 136 + kr] * fj); }
#pragma unroll
                    for (int n2 = 0; n2 < 2; ++n2) { const h16x8 vb = *(const LAS h16x8*)(Vt + (16 * n2 + fr) * 72 + 32 * ks + 8 * fq); sacc[n2] = MFMA16(a, vb, sacc[n2]); }
                }
#pragma unroll
                for (int n2 = 0; n2 < 2; ++n2) { u32x2 pk; pk.x = pkh(sacc[n2][0], sacc[n2][1]); pk.y = pkh(sacc[n2][2], sacc[n2][3]);
                    *(LAS u32x2*)(St + (16 * n2 + fr) * 136 + 16 * w + 4 * fq) = pk; }
            }
        }
#undef HG_LOAD
#undef HG_SB
    }
    LDS_BARRIER();
}
__device__ __forceinline__ float hgrn_lb(const float* __restrict__ lb_logits, int ch) {
    const float a0 = lb_logits[ch], a1 = lb_logits[2048 + ch], a2 = lb_logits[4096 + ch], a3 = lb_logits[6144 + ch];
    const float mm = fmaxf(fmaxf(a0, a1), fmaxf(a2, a3)); const float e0 = expf(a0 - mm), e1 = expf(a1 - mm), e2 = expf(a2 - mm), e3 = expf(a3 - mm);
    return (e1 + e2) / (e0 + e1 + e2 + e3);
}
constexpr int HG_VS = 144;
__device__ __forceinline__ h16x8 hgrn_vfrag(const LAS half_t* Vr, int fr, int fq, int ks, int nt) {
    const LAS half_t* p = Vr + (32 * ks + 8 * fq + (fr >> 2)) * HG_VS + 16 * nt + 4 * (fr & 3);
    const v4i16_t lo = __builtin_amdgcn_ds_read_tr16_b64_v4i16((LAS v4i16_t*)p);
    const v4i16_t hi2 = __builtin_amdgcn_ds_read_tr16_b64_v4i16((LAS v4i16_t*)(p + 4 * HG_VS));
    typedef short s16x8 __attribute__((ext_vector_type(8)));
    const s16x8 vv = (s16x8){lo[0], lo[1], lo[2], lo[3], hi2[0], hi2[1], hi2[2], hi2[3]};
    return __builtin_bit_cast(h16x8, vv);
}

__device__ __forceinline__ void hgrn_local_phase(const Ctx& c, const half_t* __restrict__ Z, const float* __restrict__ lb_logits, half_t* __restrict__ UT, float* __restrict__ DEC) {
    const int tid = c.tid, lane = c.lane, w = c.wave, fr = lane & 15, fq = lane >> 4;
    constexpr int ldz = HGRN_IN;
    LAS half_t* KS = (LAS half_t*)c.lds;
    LAS half_t* Vr = KS + 64 * 136;
    LAS float* Tot = (LAS float*)(Vr + 64 * HG_VS);
    LAS float* TF = Tot + 4 * 128;
    const int k = tid & 127, tq = tid >> 7;
    const int st = tid >> 4, sk8 = (tid & 15) * 8;
    u32x4 zv_[2], vv_[2];
#define HA_LOAD(u_) do { const int b_ = (u_) >> 9, hd_ = ((u_) >> 5) & 15, ck_ = (u_) & 31; const half_t* zp = Z + ((size_t)b_ * S + 64 * ck_ + st) * ldz + hd_ * 128 + sk8; \
        zv_[0] = *(const u32x4*)(zp + 2048); zv_[1] = *(const u32x4*)(zp + (size_t)32 * ldz + 2048); vv_[0] = *(const u32x4*)(zp + 4096); vv_[1] = *(const u32x4*)(zp + (size_t)32 * ldz + 4096); } while (0)
    int U = c.vcu;
    if (U < 2048) HA_LOAD(U);
    for (; U < 2048; U += c.G) {
        const int hd = (U >> 5) & 15;
        const float lb = hgrn_lb(lb_logits, hd * 128 + k);
        LDS_BARRIER();
        *(LAS u32x4*)(KS + st * 136 + sk8) = zv_[0]; *(LAS u32x4*)(KS + (st + 32) * 136 + sk8) = zv_[1];
        *(LAS u32x4*)(Vr + st * HG_VS + sk8) = vv_[0]; *(LAS u32x4*)(Vr + (st + 32) * HG_VS + sk8) = vv_[1];
        if (U + c.G < 2048) HA_LOAD(U + c.G);
        LDS_BARRIER();
        float fv[16]; float prod = 1.f;
#pragma unroll
        for (int tt = 0; tt < 16; ++tt) { const float sg = fsigm((float)KS[(16 * tq + tt) * 136 + k]); fv[tt] = lb + (1.f - lb) * sg; prod *= fv[tt]; }
        prod = fmaxf(prod, 1e-30f);
        Tot[tq * 128 + k] = __logf(prod);
        LDS_BARRIER();
        {
            const float t0 = Tot[k], t1 = Tot[128 + k], t2 = Tot[256 + k], t3 = Tot[384 + k];
            const float be1 = t0, be2 = t0 + t1, be3 = be2 + t2, be4 = be3 + t3;
            if (tq == 1) { TF[k] = fexp(be4 - be1); TF[128 + k] = fexp(be4 - be2); TF[256 + k] = fexp(be4 - be3); TF[384 + k] = 1.f; }
            if (tq == 3) DEC[(size_t)U * 128 + k] = fexp(be4);
            float P = 1.f;
#pragma unroll
            for (int tt = 0; tt < 16; ++tt) { P = fmaxf(P * fv[tt], 1e-30f); KS[(16 * tq + tt) * 136 + k] = (half_t)((1.f - fv[tt]) * prod * __builtin_amdgcn_rcpf(P)); }
        }
        LDS_BARRIER();
        f32x4 acc[8];
#pragma unroll
        for (int nt = 0; nt < 8; ++nt) acc[nt] = (f32x4){0.f, 0.f, 0.f, 0.f};
        const int kr = 16 * w + fr;
#pragma unroll
        for (int ks = 0; ks < 2; ++ks) {
            const float fj = TF[(2 * ks + (fq >> 1)) * 128 + kr];
            h16x8 a;
#pragma unroll
            for (int j = 0; j < 8; ++j) { const int s2 = 32 * ks + 8 * fq + j; a[j] = (half_t)((float)KS[s2 * 136 + kr] * fj); }
#pragma unroll
            for (int nt = 0; nt < 8; ++nt) acc[nt] = MFMA16(a, hgrn_vfrag(Vr, fr, fq, ks, nt), acc[nt]);
        }
        half_t* ut = UT + (size_t)U * 16384;
#pragma unroll
        for (int nt = 0; nt < 8; ++nt) { u32x2 pk; pk.x = pkh(acc[nt][0], acc[nt][1]); pk.y = pkh(acc[nt][2], acc[nt][3]);
            *(u32x2*)(ut + (16 * nt + fr) * 128 + 16 * w + 4 * fq) = pk; }
    }
#undef HA_LOAD
    LDS_BARRIER();
}

__device__ __forceinline__ void hgrn_carry_phase(const Ctx& c, const half_t* __restrict__ UT, const float* __restrict__ DEC, half_t* __restrict__ SS) {
    for (int g = c.vcu * NTH + c.tid; g < 64 * 2048; g += c.G * NTH) {
        const int bh = g >> 11, p8 = (g & 2047) * 8, k0 = p8 & 127;
        float s[8];
#pragma unroll
        for (int e = 0; e < 8; ++e) s[e] = 0.f;
#pragma unroll 4
        for (int ck = 0; ck < 32; ++ck) {
            const size_t u = (size_t)bh * 32 + ck;
            const h16x8 uv = *(const h16x8*)(UT + u * 16384 + p8);
            const f32x4 d0 = *(const f32x4*)(DEC + u * 128 + k0), d1 = *(const f32x4*)(DEC + u * 128 + k0 + 4);
            u32x4 o; o.x = pkh(s[0], s[1]); o.y = pkh(s[2], s[3]); o.z = pkh(s[4], s[5]); o.w = pkh(s[6], s[7]);
            *(u32x4*)(SS + u * 16384 + p8) = o;
#pragma unroll
            for (int e = 0; e < 4; ++e) { s[e] = fmaf(d0[e], s[e], (float)uv[e]); s[4 + e] = fmaf(d1[e], s[4 + e], (float)uv[4 + e]); }
        }
    }
}

__device__ __forceinline__ void hgrn_out_phase(const Ctx& c, const half_t* __restrict__ Z, const float* __restrict__ lb_logits, const half_t* __restrict__ SS, const float* __restrict__ ng,
                                               half_t* __restrict__ O) {
    const int tid = c.tid, lane = c.lane, w = c.wave, fr = lane & 15, fq = lane >> 4;
    constexpr int ldz = HGRN_IN;
    LAS float* QD = (LAS float*)c.lds;
    LAS half_t* KS = (LAS half_t*)(c.lds + 33792);
    LAS half_t* Vr = KS + 64 * 136;
    LAS half_t* At = Vr + 64 * HG_VS;
    LAS half_t* St = At + 64 * 72;
    LAS float* Tot = (LAS float*)(St + 128 * 136);
    LAS float* TX = Tot + 4 * 128;
    LAS float* TE = TX + 7 * 128;
    LAS float* RS = TE + 4 * 128;
    static_assert(33792 + (64 * 136 + 64 * HG_VS + 64 * 72 + 128 * 136) * 2 + (4 + 7 + 4) * 128 * 4 + 64 * 2 * 4 <= RING_BYTES, "hgrn_out LDS");
    const int k = tid & 127, tq = tid >> 7;
    const int st = tid >> 4, sk8 = (tid & 15) * 8;
    for (int i = tid; i < 64 * 72; i += NTH) At[i] = (half_t)0.f;
    u32x4 qv_[2], zv_[2], vv_[2], sv_[4];
#define HC_LOAD(u_) do { const int b_ = (u_) >> 9, hd_ = ((u_) >> 5) & 15, ck_ = (u_) & 31; const half_t* zp = Z + ((size_t)b_ * S + 64 * ck_ + st) * ldz + hd_ * 128 + sk8; \
        qv_[0] = *(const u32x4*)(zp); qv_[1] = *(const u32x4*)(zp + (size_t)32 * ldz); zv_[0] = *(const u32x4*)(zp + 2048); zv_[1] = *(const u32x4*)(zp + (size_t)32 * ldz + 2048); \
        vv_[0] = *(const u32x4*)(zp + 4096); vv_[1] = *(const u32x4*)(zp + (size_t)32 * ldz + 4096); \
        const half_t* sp = SS + (size_t)(u_) * 16384 + st * 128 + sk8; \
        _Pragma("unroll") for (int i_ = 0; i_ < 4; ++i_) sv_[i_] = *(const u32x4*)(sp + i_ * 32 * 128); } while (0)
    int U = c.vcu;
    if (U < 2048) HC_LOAD(U);
    for (; U < 2048; U += c.G) {
        const int b = U >> 9, hd = (U >> 5) & 15, ck = U & 31;
        const size_t row0 = (size_t)b * S + 64 * ck;
        const float lb = hgrn_lb(lb_logits, hd * 128 + k);
        LDS_BARRIER();
#pragma unroll
        for (int i = 0; i < 2; ++i) { const h16x8 qh = __builtin_bit_cast(h16x8, qv_[i]); f32x4 a0, a1;
#pragma unroll
            for (int e = 0; e < 4; ++e) { const float x0 = (float)qh[e], x1 = (float)qh[4 + e]; a0[e] = x0 * fsigm(x0); a1[e] = x1 * fsigm(x1); }
            *(LAS f32x4*)(QD + (st + 32 * i) * 132 + sk8) = a0; *(LAS f32x4*)(QD + (st + 32 * i) * 132 + sk8 + 4) = a1; }
        *(LAS u32x4*)(KS + st * 136 + sk8) = zv_[0]; *(LAS u32x4*)(KS + (st + 32) * 136 + sk8) = zv_[1];
        *(LAS u32x4*)(Vr + st * HG_VS + sk8) = vv_[0]; *(LAS u32x4*)(Vr + (st + 32) * HG_VS + sk8) = vv_[1];
#pragma unroll
        for (int i = 0; i < 4; ++i) *(LAS u32x4*)(St + (st + 32 * i) * 136 + sk8) = sv_[i];
        if (U + c.G < 2048) HC_LOAD(U + c.G);
        LDS_BARRIER();
        float fv[16]; float prod = 1.f;
#pragma unroll
        for (int tt = 0; tt < 16; ++tt) { const float sg = fsigm((float)KS[(16 * tq + tt) * 136 + k]); fv[tt] = lb + (1.f - lb) * sg; prod *= fv[tt]; }
        prod = fmaxf(prod, 1e-30f);
        Tot[tq * 128 + k] = __logf(prod);
        LDS_BARRIER();
        {
            const float t0 = Tot[k], t1 = Tot[128 + k], t2 = Tot[256 + k], t3 = Tot[384 + k];
            const float be1 = t0, be2 = t0 + t1, be3 = be2 + t2, be4 = be3 + t3;
            if (tq == 0) { TE[k] = fexp(be1); TE[128 + k] = fexp(be2); TE[256 + k] = fexp(be3); TE[384 + k] = fexp(be4); }
            else if (tq == 1) { TX[k] = fexp(be2 - be1); TX[128 + k] = fexp(be3 - be1); TX[256 + k] = fexp(be3 - be2); }
            else if (tq == 2) { TX[384 + k] = fexp(be4 - be1); TX[512 + k] = fexp(be4 - be2); TX[640 + k] = fexp(be4 - be3); }
            const float ip16 = __builtin_amdgcn_rcpf(prod);
            float P = 1.f;
#pragma unroll
            for (int tt = 0; tt < 16; ++tt) {
                const int t = 16 * tq + tt;
                P = fmaxf(P * fv[tt], 1e-30f);
                QD[t * 132 + k] *= P * ip16;
                KS[t * 136 + k] = (half_t)((1.f - fv[tt]) * prod * __builtin_amdgcn_rcpf(P));
                if ((tt & 3) == 3) { asm volatile("" ::: "memory"); __builtin_amdgcn_sched_barrier(0); }
            }
        }
        LDS_BARRIER();
        if (w < 4) {
            const int I = w;
            f32x4 acc = (f32x4){0.f, 0.f, 0.f, 0.f}, acc2 = acc;
#pragma unroll 2
            for (int m = 0; m < 8; m += 2) {
                const int k0 = 16 * m + 4 * fq;
                const f32x4 qd = *(const LAS f32x4*)(QD + (16 * I + fr) * 132 + k0), qd2 = *(const LAS f32x4*)(QD + (16 * I + fr) * 132 + k0 + 16);
                const h16x4 kv = *(const LAS h16x4*)(KS + (16 * I + fr) * 136 + k0), kv2 = *(const LAS h16x4*)(KS + (16 * I + fr) * 136 + k0 + 16);
#pragma unroll
                for (int e = 0; e < 4; ++e) { acc = __builtin_amdgcn_mfma_f32_16x16x4f32(qd[e], (float)kv[e], acc, 0, 0, 0);
                                              acc2 = __builtin_amdgcn_mfma_f32_16x16x4f32(qd2[e], (float)kv2[e], acc2, 0, 0, 0); }
            }
#pragma unroll
            for (int r = 0; r < 4; ++r) { const int tl = 4 * fq + r; At[(16 * I + tl) * 72 + 16 * I + fr] = (half_t)((fr <= tl) ? (acc[r] + acc2[r]) : 0.f); }
        } else {
            const int nb = (w < 6) ? 2 : 1;
            for (int bi = 0; bi < nb; ++bi) {
                const int I = (w == 4) ? (bi == 0 ? 1 : 3) : (w == 5) ? (bi == 0 ? 2 : 3) : (w == 6) ? 3 : 2;
                const int J = (w == 4) ? (bi == 0 ? 0 : 1) : (w == 5) ? (bi == 0 ? 1 : 0) : (w == 6) ? 2 : 0;
                const LAS float* tx = TX + (I * (I - 1) / 2 + J) * 128;
                f32x4 acc = (f32x4){0.f, 0.f, 0.f, 0.f};
#pragma unroll
                for (int ks = 0; ks < 4; ++ks) {
                    const int k0 = 32 * ks + 8 * fq;
                    const f32x4 q0 = *(const LAS f32x4*)(QD + (16 * I + fr) * 132 + k0), q1 = *(const LAS f32x4*)(QD + (16 * I + fr) * 132 + k0 + 4);
                    const f32x4 x0 = *(const LAS f32x4*)(tx + k0), x1 = *(const LAS f32x4*)(tx + k0 + 4);
                    const h16x8 bb = *(const LAS h16x8*)(KS + (16 * J + fr) * 136 + k0);
                    h16x8 a;
#pragma unroll
                    for (int j = 0; j < 4; ++j) { a[j] = (half_t)(q0[j] * x0[j]); a[4 + j] = (half_t)(q1[j] * x1[j]); }
                    acc = MFMA16(a, bb, acc);
                }
#pragma unroll
                for (int r = 0; r < 4; ++r) At[(16 * I + 4 * fq + r) * 72 + 16 * J + fr] = (half_t)acc[r];
            }
        }
        const int mt = w >> 1, nh = w & 1;
        f32x4 oacc[4];
#pragma unroll
        for (int n = 0; n < 4; ++n) oacc[n] = (f32x4){0.f, 0.f, 0.f, 0.f};
        half_t gt[4][4];
#pragma unroll
        for (int n = 0; n < 4; ++n)
#pragma unroll
            for (int r = 0; r < 4; ++r) gt[n][r] = Z[(row0 + 16 * mt + 4 * fq + r) * ldz + 6144 + hd * 128 + 64 * nh + 16 * n + fr];
#pragma unroll
        for (int ks = 0; ks < 4; ++ks) {
            const int k0 = 32 * ks + 8 * fq;
            const f32x4 q0 = *(const LAS f32x4*)(QD + (16 * mt + fr) * 132 + k0), q1 = *(const LAS f32x4*)(QD + (16 * mt + fr) * 132 + k0 + 4);
            const f32x4 x0 = *(const LAS f32x4*)(TE + mt * 128 + k0), x1 = *(const LAS f32x4*)(TE + mt * 128 + k0 + 4);
            h16x8 a;
#pragma unroll
            for (int j = 0; j < 4; ++j) { a[j] = (half_t)(q0[j] * x0[j]); a[4 + j] = (half_t)(q1[j] * x1[j]); }
#pragma unroll
            for (int n = 0; n < 4; ++n) { const h16x8 sb = *(const LAS h16x8*)(St + (64 * nh + 16 * n + fr) * 136 + k0); oacc[n] = MFMA16(a, sb, oacc[n]); }
        }
        LDS_BARRIER();
#pragma unroll
        for (int ks = 0; ks < 2; ++ks) {
            const h16x8 a = *(const LAS h16x8*)(At + (16 * mt + fr) * 72 + 32 * ks + 8 * fq);
#pragma unroll
            for (int n = 0; n < 4; ++n) oacc[n] = MFMA16(a, hgrn_vfrag(Vr, fr, fq, ks, 4 * nh + n), oacc[n]);
        }
        {
            float ssq[4];
#pragma unroll
            for (int r = 0; r < 4; ++r) { float s_ = 0.f;
#pragma unroll
                for (int n = 0; n < 4; ++n) s_ += oacc[n][r] * oacc[n][r];
                ssq[r] = rsum16(s_); }
            if (fr == 0) {
#pragma unroll
                for (int r = 0; r < 4; ++r) RS[(16 * mt + 4 * fq + r) * 2 + nh] = ssq[r];
            }
            LDS_BARRIER();
#pragma unroll
            for (int r = 0; r < 4; ++r) {
                const int t = 16 * mt + 4 * fq + r;
                const float rn = rsqrtf((RS[t * 2] + RS[t * 2 + 1]) * (1.f / 128.f) + RMS_EPS);
                half_t* op = O + (row0 + t) * D + hd * 128 + 64 * nh + fr;
#pragma unroll
                for (int n = 0; n < 4; ++n) { const float gv = (float)gt[n][r]; op[16 * n] = (half_t)(oacc[n][r] * rn * ng[64 * nh + 16 * n + fr] * (gv * fsigm(gv))); }
            }
        }
    }
#undef HC_LOAD
    LDS_BARRIER();
}

}

namespace fp {
constexpr int N_PHASES = 41;
#ifndef PROBE_MASK
#define PROBE_MASK 0
#endif
#define FP_PHASE_G(id, grp, ...) do { if (lo <= (id) && (id) < hi) { \
        if constexpr (((PROBE_MASK) >> (grp)) & 1) { _Pragma("unroll 1") for (int rep_ = 0; rep_ < 2; ++rep_) { asm volatile("" : "+s"(rep_)); __VA_ARGS__; if (rep_ == 0) xcd_barrier(bar); } } \
        else { __VA_ARGS__; } \
        if ((id) + 1 < hi) { xcd_barrier(bar); if constexpr (((PROBE_MASK) >> 10) & 1) xcd_barrier(bar); } } } while (0)
#define FP_PHASE(id, ...) FP_PHASE_G(id, 31, __VA_ARGS__)

template <int L>
__device__ __forceinline__ void layer_phases(const Ctx& c, const Params& p, const XcdBarrier& bar, int lo, int hi) {
    constexpr int KIND = L % 4, PB = 1 + 10 * L;
    constexpr int NIN = KIND == 0 ? SWA_IN : KIND == 1 ? DIFF_IN : KIND == 2 ? HGRN_IN : DSA_MAIN;
    constexpr size_t WIN_OFF = KIND == 0 ? WS_WIN0 : KIND == 1 ? WS_WIN1 : KIND == 2 ? WS_WIN2 : WS_WIN3;
    unsigned char* ws = p.ws;
    half_t* H = (half_t*)(ws + WS_X16); float* RS = (float*)(ws + WS_RS); half_t* ZU = (half_t*)(ws + WS_ZU); half_t* O = (half_t*)(ws + WS_O); float* MF = (float*)(ws + WS_MF); half_t* ACT = (half_t*)(ws + WS_ACT);
    const float* ng = p.in[3] + (size_t)L * 4 * D;
    const float* bias = p.in[1];
    FP_PHASE_G(PB + 0, 0, { if constexpr (KIND == 3) dsa_kiwi_phase(c, H, RS, (const half_t*)(ws + WS_WIN3), (half_t*)(ws + WS_KW));
                       pg8::Gemm g{H, (const half_t*)(ws + WIN_OFF), M, NIN, D}; pg8::StaticOrder so; so.init(M, NIN, c.G, (int)blockIdx.x); pg8::EpiH16T<true> E{ZU, NIN, RS};
                       pg8::gemm_phase<pg8::EpiH16T<true>, pg8::StaticOrder, true, true>(c.lds, g, so, E);
                       if constexpr (L == 0) { if (c.G == 256 && (int)blockIdx.x >= so.nwg - c.G) spare_slot_convert(c, p, 1, 0, DEFER_G1, (int)blockIdx.x - (so.nwg - c.G)); } });
    if constexpr (KIND == 0) {
        FP_PHASE_G(PB + 1, 1, gqa_phase<0>(c, ZU, SWA_IN, 2048, 2560, bias, p.in[9], nullptr, O));
    } else if constexpr (KIND == 1) {
        FP_PHASE_G(PB + 1, 2, diff_phase(c, ZU, bias, p.in[12], p.in[13], 0.8f - 0.6f * 0.74081822068f  , O));
    } else if constexpr (KIND == 2) {
        FP_PHASE_G(PB + 1, 3, hgrn_local_phase(c, ZU, p.in[2], (half_t*)(ws + WS_HUT), (float*)(ws + WS_HDEC)));
        FP_PHASE_G(PB + 2, 7, hgrn_carry_phase(c, (const half_t*)(ws + WS_HUT), (const float*)(ws + WS_HDEC), (half_t*)MF));
        FP_PHASE_G(PB + 3, 3, hgrn_out_phase(c, ZU, p.in[2], (const half_t*)MF, p.in[16], O));
    } else {
        FP_PHASE_G(PB + 1, 8, dsa_score_phase(c, ZU, (const half_t*)(ws + WS_KW), (float*)(ws + WS_ACT)));
        FP_PHASE_G(PB + 2, 9, dsa_select_phase(c, (const float*)(ws + WS_ACT), (unsigned*)(ws + WS_MBITS)));
        FP_PHASE_G(PB + 3, 4, gqa_phase<1>(c, ZU, DSA_MAIN, 2048, 2560, bias, nullptr, (const unsigned*)(ws + WS_MBITS), O));
    }
    FP_PHASE_G(PB + 4, 0, { pg8::Gemm g{O, (const half_t*)(ws + WS_WOUT + L * WOUT_STRIDE), M, D, D}; pg8::StaticOrder so; so.init(M, D, c.G, (int)blockIdx.x); pg8::EpiH16 E{(half_t*)MF, D};
                       pg8::gemm_phase<pg8::EpiH16, pg8::StaticOrder, true, true>(c.lds, g, so, E); });
    FP_PHASE(PB + 5, resnorm_phase(c, (half_t*)(ws + WS_X16), (const half_t*)MF, ng + D, RS, nullptr));
    FP_PHASE_G(PB + 6, 0, { constexpr int MT = (M + 253) / 254; pg8::Gemm g{H, (const half_t*)(ws + WS_WUP + L * WUP_STRIDE), MT * 256, NUP, D, 254, -2}; pg8::StaticOrder so; so.init(MT * 256, NUP, c.G, (int)blockIdx.x);
                       pg8::EpiConv E{ACT, p.in[5] + (size_t)L * 3 * NUP, (LAS float*)(c.lds + MISC_OFF + 256), M, S, DFF, NUP, RS};
                       pg8::gemm_phase<pg8::EpiConv, pg8::StaticOrder, true, true>(c.lds, g, so, E);
                       if constexpr (L < 3) { const int nfull = so.nwg % c.G;
                           if (c.G == 256 && nfull == 256 - 84 && (int)blockIdx.x >= nfull) spare_slot_convert(c, p, L + 1, L == 0 ? DEFER_G1 : 0, L == 0 ? FFN_TILES : DEFER_G3, (int)blockIdx.x - nfull); } });
    FP_PHASE_G(PB + 8, 0, { pg8::Gemm g{ACT, (const half_t*)(ws + WS_WDN + L * WDN_STRIDE), M, D, DFF}; pg8::StaticOrder so; so.init(M, D, c.G, (int)blockIdx.x); pg8::EpiH16 E{(half_t*)MF, D};
                       pg8::gemm_phase<pg8::EpiH16, pg8::StaticOrder, true, true>(c.lds, g, so, E); });
    FP_PHASE(PB + 9, resnorm_phase(c, (half_t*)(ws + WS_X16), (const half_t*)MF, ng + 3 * D, (L < 3) ? RS : (float*)nullptr, (L < 3) ? (float*)nullptr : p.out));
}

__global__ void __launch_bounds__(NTH, 2) fwd_kernel(Params p) {
    extern __shared__ __attribute__((aligned(16))) unsigned char lds_raw[];
    Ctx c;
    c.lds = (LAS unsigned char*)lds_raw;
    c.tid = threadIdx.x; c.lane = c.tid & 63; c.wave = __builtin_amdgcn_readfirstlane(c.tid >> 6);
    c.G = gridDim.x; { const int bx = blockIdx.x; c.vcu = (c.G % 8 == 0) ? (bx % 8) * (c.G / 8) + bx / 8 : bx; }
    volatile LAS unsigned* misc = (volatile LAS unsigned*)(c.lds + MISC_OFF);
    if (c.tid < 4) misc[c.tid] = 0u;
    __syncthreads();
    XcdBarrier bar = xcd_barrier_post((unsigned*)(p.ws + WS_CTL) + CW_BAR, misc);
    const int lo = p.ph_lo, hi = p.ph_hi;
    FP_PHASE_G(0, 6, prologue_phase(c, p));
#ifndef ONLY_LAYER
#define ONLY_LAYER -1
#endif
    if constexpr (ONLY_LAYER < 0 || ONLY_LAYER == 0) layer_phases<0>(c, p, bar, lo, hi);
    if constexpr (ONLY_LAYER < 0 || ONLY_LAYER == 1) layer_phases<1>(c, p, bar, lo, hi);
    if constexpr (ONLY_LAYER < 0 || ONLY_LAYER == 2) layer_phases<2>(c, p, bar, lo, hi);
    if constexpr (ONLY_LAYER < 0 || ONLY_LAYER == 3) layer_phases<3>(c, p, bar, lo, hi);
}

static int g_grid = 0;
static int fast_setup() {
    if (g_grid == 0) {
        int dev = 0, cus = 0, per_cu = 0;
        if (hipGetDevice(&dev) != hipSuccess || hipDeviceGetAttribute(&cus, hipDeviceAttributeMultiprocessorCount, dev) != hipSuccess) { fprintf(stderr, "kernel_launch: device query failed\n"); g_grid = -1; return g_grid; }
        if (hipFuncSetAttribute((const void*)fwd_kernel, hipFuncAttributeMaxDynamicSharedMemorySize, LDS_BYTES) != hipSuccess) { fprintf(stderr, "kernel_launch: hipFuncSetAttribute failed\n"); g_grid = -1; return g_grid; }
        if (hipOccupancyMaxActiveBlocksPerMultiprocessor(&per_cu, (const void*)fwd_kernel, NTH, LDS_BYTES) != hipSuccess || per_cu < 1) fprintf(stderr, "kernel_launch: occupancy query says %d\n", per_cu);
        (void)hipGetLastError();
        g_grid = cus;
    }
    return g_grid;
}
static void fast_launch(void* const* d_in, void* d_out, void* d_ws, int lo, int hi, hipStream_t stream) {
    Params p{};
    for (int i = 0; i < 19; ++i) p.in[i] = (const float*)d_in[i];
    p.out = (float*)d_out; p.ws = (unsigned char*)d_ws; p.ph_lo = lo; p.ph_hi = hi;
#if MODE == 2
    (void)hipMemsetAsync((char*)d_ws + WS_CTL + CW_BAR * 4, 0, XCD_BAR_WORDS * 4, stream);
#endif
    hipLaunchKernelGGL(fwd_kernel, dim3(g_grid), dim3(NTH), LDS_BYTES, stream, p);
}
}

#if MODE == 0
extern "C" void kernel_launch(void* const* d_in, const int* in_sizes, int n_in, void* d_out, int out_size, void* d_ws, size_t ws_size, hipStream_t stream) {
    if (fp::fast_setup() <= 0) return;
    (void)hipMemsetAsync((char*)d_ws + fp::WS_CTL, 0, fp::CTL_BYTES, stream);
    fp::fast_launch(d_in, d_out, d_ws, 0, fp::N_PHASES, stream);
}
#endif

#if MODE == 2
namespace dbg {
using namespace cfg;
template <bool HALF>
__global__ void __launch_bounds__(256) cmp_kernel(const void* f, int ldf, const float* o, int ldo, int rows, int cols, float* sums) {
    float sd = 0.f, so = 0.f;
    const size_t n = (size_t)rows * cols;
    for (size_t i = (size_t)blockIdx.x * 256 + threadIdx.x; i < n; i += (size_t)gridDim.x * 256) {
        const int r = (int)(i / cols), cc = (int)(i % cols);
        const float fv = HALF ? (float)((const half_t*)f)[(size_t)r * ldf + cc] : ((const float*)f)[(size_t)r * ldf + cc];
        const float ov = o[(size_t)r * ldo + cc];
        const float d = fv - ov; sd += d * d; so += ov * ov;
    }
    for (int off = 32; off >= 1; off >>= 1) { sd += __shfl_xor(sd, off); so += __shfl_xor(so, off); }
    if ((threadIdx.x & 63) == 0) { atomicAdd(sums, sd); atomicAdd(sums + 1, so); }
}
__global__ void __launch_bounds__(256) report_kernel(const float* sums, int nck, float* out, size_t n) {
    int bad = 0; float V = 0.f;
    for (int k = 0; k < nck; ++k) {
        const float sd = sums[2 * k], so = sums[2 * k + 1];
        if (so == 0.f && sd == 0.f) continue;
        const float rvr = sd / so;
        const float tol = (k == 23) ? 2e-2f : (k > 23) ? 5e-3f : 3e-4f;
        if (!(rvr < tol)) {
            int e = 15;
            if (rvr == rvr) { e = (int)floorf(1.f - log10f(rvr)); e = e < 0 ? 0 : (e > 12 ? 12 : e); }
            V = (float)(10 + k + 1) * powf(10.f, (float)(4 + e)); bad = 1; break;
        }
    }
    if (!bad) return;
    for (size_t i = (size_t)blockIdx.x * 256 + threadIdx.x; i < n; i += (size_t)gridDim.x * 256) out[i] = (i == 0) ? V : 0.f;
}
}

extern "C" void kernel_launch(void* const* d_in, const int* in_sizes, int n_in, void* d_out, int out_size, void* d_ws, size_t ws_size, hipStream_t stream) {
    using namespace cfg;
    if (fp::fast_setup() <= 0) return;
    unsigned char* ws = (unsigned char*)d_ws;
    (void)hipMemsetAsync(ws + fp::WS_CTL, 0, fp::CTL_BYTES, stream);
    float* sums = (float*)(ws + fp::WS_CTL) + fp::CW_CK;
    constexpr size_t MiB = 1u << 20;
    size_t off = fp::WS_FAST_END + 2 * MiB;
    orc::Bufs bf;
    bf.X = (float*)(ws + off); off += 64 * MiB;
    bf.O = (float*)(ws + off); off += 64 * MiB;
    bf.MF = (float*)(ws + off); off += 64 * MiB;
    bf.H = (float*)(ws + off); off += 16 * MiB;
    bf.Z = (float*)(ws + off); off += 64 * MiB;
    bf.U = (float*)(ws + off); off += 88 * MiB;
    bf.A = (float*)(ws + off); off += 44 * MiB;
    if (off > ws_size) { fprintf(stderr, "kernel_launch: workspace too small (%zu > %zu)\n", off, ws_size); return; }
    (void)hipMemcpyAsync(bf.X, d_in[0], (size_t)M * D * 4, hipMemcpyDeviceToDevice, stream);
    half_t* fZU = (half_t*)(ws + fp::WS_ZU); half_t* fO = (half_t*)(ws + fp::WS_O); half_t* fACT = (half_t*)(ws + fp::WS_ACT);
    float* fX = (float*)d_out;
    fp::fast_launch(d_in, d_out, d_ws, 0, 1, stream);
    for (int L = 0; L < 4; ++L) {
        const int kind = L % 4, PB = 1 + 10 * L;
        const int nin = kind == 0 ? SWA_IN : kind == 1 ? DIFF_IN : kind == 2 ? HGRN_IN : DSA_IN;
        const int ninp = kind == 3 ? fp::DSA_MAIN : nin;
        float* ck = sums + 2 * 7 * L;
        fp::fast_launch(d_in, d_out, d_ws, PB, PB + 1, stream);
        for (int b = 0; b < B; ++b)
            orc::run_mixer(bf, d_in, L, b, 1, stream, [&](int stage) {
                if (b != 0) return;
                if (stage == 1) dbg::cmp_kernel<true><<<1024, 256, 0, stream>>>(fZU, ninp, bf.Z, nin, S, nin < ninp ? nin : ninp, ck + 2);
            });
        fp::fast_launch(d_in, d_out, d_ws, PB + 1, PB + 4, stream);
        dbg::cmp_kernel<true><<<1024, 256, 0, stream>>>(fO, D, bf.O, D, M, D, ck + 4);
        fp::fast_launch(d_in, d_out, d_ws, PB + 4, PB + 5, stream);
        fp::fast_launch(d_in, d_out, d_ws, PB + 5, PB + 6, stream);
        dbg::cmp_kernel<true><<<1024, 256, 0, stream>>>(ws + fp::WS_X16, D, bf.X, D, M, D, ck + 6);
        fp::fast_launch(d_in, d_out, d_ws, PB + 6, PB + 7, stream);
        for (int b = 0; b < B; ++b)
            orc::run_ffn(bf, d_in, L, b, 1, stream, [&](int stage) {
                if (b != 0) return;
                if (stage == 2) { (void)fZU; }
                if (stage == 3) dbg::cmp_kernel<true><<<1024, 256, 0, stream>>>(fACT, DFF, bf.A, DFF, S, DFF, ck + 10);
            });
        fp::fast_launch(d_in, d_out, d_ws, PB + 8, PB + 9, stream);
        fp::fast_launch(d_in, d_out, d_ws, PB + 9, PB + 10, stream);
        if (L < 3) dbg::cmp_kernel<true><<<1024, 256, 0, stream>>>(ws + fp::WS_X16, D, bf.X, D, M, D, ck + 12);
        else dbg::cmp_kernel<false><<<1024, 256, 0, stream>>>(fX, D, bf.X, D, M, D, ck + 12);
    }
    dbg::report_kernel<<<1024, 256, 0, stream>>>(sums, 28, fX, (size_t)M * D);
}
#endif
#endif
#if MODE == 1
extern "C" void kernel_launch(void* const* d_in, const int* in_sizes, int n_in, void* d_out, int out_size, void* d_ws, size_t ws_size, hipStream_t stream) {
    using namespace cfg;
    float* ws = (float*)d_ws;
    orc::Bufs bf;
    bf.X = (float*)d_out;
    size_t off = 0;
    bf.H = ws + off; off += (size_t)M * D;
    bf.O = ws + off; off += (size_t)M * D;
    bf.MF = ws + off; off += (size_t)M * D;
    bf.Z = ws + off; off += (size_t)M * 8192;
    bf.U = ws + off; off += (size_t)M * NUP;
    bf.A = ws + off; off += (size_t)M * DFF;
    hipMemcpyAsync(bf.X, d_in[0], (size_t)M * D * 4, hipMemcpyDeviceToDevice, stream);
    for (int layer = 0; layer < 4; ++layer) {
        orc::run_mixer(bf, d_in, layer, 0, B, stream, orc::NoHook());
        orc::run_ffn(bf, d_in, layer, 0, B, stream, orc::NoHook());
    }
}
#endif
```
